# Optimizing an MI355X kernel written in HIP

```python
import math
import jax
import jax.numpy as jnp
from jax import lax
import numpy as np

D_MODEL = 1024
BATCH = 16
SEQ = 2048
DEPTH = 2

GRID_W = 64
CTX_LEN = 256
RMS_EPS = 1e-6

DN_HEADS = 4
DN_DK = 128
DN_DV = 128
DN_CHUNK = 64
QKV_CONV = 3
SC_WIDTH = 512
SC_CONV = 3
DN_QK_W = DN_HEADS * DN_DK
DN_V_W = DN_HEADS * DN_DV
QKV_W = 2 * DN_QK_W + DN_V_W
C_GATE = QKV_W
C_ALPHA = C_GATE + DN_V_W
C_BETA = C_ALPHA + 2 * DN_HEADS
C_SC = C_BETA + 2 * DN_HEADS
IN0_COLS = C_SC + 3 * SC_WIDTH
MIX0_WIDTH = DN_V_W + SC_WIDTH
ATT_HEADS = 16
ATT_KV_HEADS = 4
GQA_GROUP = ATT_HEADS // ATT_KV_HEADS
ATT_HD = 64
WINDOW = 128
Q_BLOCK = 128
ROPE_BASE = 10000.0
IN1_COLS = (ATT_HEADS + 2 * ATT_KV_HEADS) * ATT_HD
MIX1_WIDTH = ATT_HEADS * ATT_HD
N_GROUPS = 4
EXPERTS_PER_GROUP = 8
N_EXPERTS = N_GROUPS * EXPERTS_PER_GROUP
TOP_K = 2
D_EXPERT = 512
MOE_BLOCK = 128

N_EVEN = (DEPTH + 1) // 2
N_ODD = DEPTH // 2

kernel_name = 'hybrid_deltanet_shortconv_swa_hmoe_prefix_dit'

F32 = jnp.float32


def rmsnorm(x, w):
    xf = x.astype(F32)
    y = xf * lax.rsqrt(jnp.mean(xf * xf, axis=-1, keepdims=True) + RMS_EPS)
    return (y * w.astype(F32)).astype(x.dtype)


def modulate(h, shift, scale):
    return h * (1.0 + scale) + shift


def l2norm(t):
    tf = t.astype(F32)
    return tf * lax.rsqrt(jnp.sum(tf * tf, axis=-1, keepdims=True) + RMS_EPS)


def dwconv_centred(x, w):
    taps = w.shape[0]
    p = taps // 2
    L = x.shape[1]
    xp = jnp.pad(x, ((0, 0), (p, p), (0, 0)))
    out = xp[:, 0:L] * w[0]
    for i in range(1, taps):
        out = out + xp[:, i:i + L] * w[i]
    return out


def gated_delta_rule(q, k, v, log_a, beta, s0):
    Bn, L, H, dk = q.shape
    dv = v.shape[-1]
    n = L // DN_CHUNK

    def to_chunks(t):
        t = t.astype(F32).reshape((Bn, n, DN_CHUNK, H) + t.shape[3:])
        return jnp.moveaxis(t, (1, 3), (0, 2))

    qc = to_chunks(q) * (dk ** -0.5)
    kc = to_chunks(k)
    vc = to_chunks(v)
    g = jnp.cumsum(to_chunks(log_a), axis=-1)
    bc = to_chunks(beta)
    idx = jnp.arange(DN_CHUNK)
    incl = idx[:, None] >= idx[None, :]
    strict = idx[:, None] > idx[None, :]
    decay = jnp.exp(jnp.where(incl, g[..., :, None] - g[..., None, :], -jnp.inf))
    kb = kc * bc[..., None]
    a_mat = jnp.where(strict, jnp.einsum('nbhid,nbhjd->nbhij', kb, kc) * decay, 0.0)
    eye = jnp.eye(DN_CHUNK, dtype=F32)
    t_mat = lax.linalg.triangular_solve(eye + a_mat, jnp.broadcast_to(eye, a_mat.shape),
                                        left_side=True, lower=True, unit_diagonal=True)
    u = jnp.einsum('nbhij,nbhjd->nbhid', t_mat, vc * bc[..., None])
    w = jnp.einsum('nbhij,nbhjd->nbhid', t_mat, kb * jnp.exp(g)[..., None])
    qk = jnp.where(incl, jnp.einsum('nbhid,nbhjd->nbhij', qc, kc) * decay, 0.0)
    q_dec = qc * jnp.exp(g)[..., None]
    k_dec = kc * jnp.exp(g[..., -1:] - g)[..., None]
    g_last = jnp.exp(g[..., -1])

    def step(s, inp):
        qd, kd, uc, wc, qkc, gl = inp
        v_new = uc - jnp.einsum('bhcd,bhde->bhce', wc, s)
        o = jnp.einsum('bhcd,bhde->bhce', qd, s) + jnp.einsum('bhij,bhje->bhie', qkc, v_new)
        s = s * gl[..., None, None] + jnp.einsum('bhcd,bhce->bhde', kd, v_new)
        return s, o

    s_fin, o = lax.scan(step, s0.astype(F32), (q_dec, k_dec, u, w, qk, g_last))
    o = jnp.moveaxis(o, (0, 2), (1, 3)).reshape(Bn, L, H, dv)
    return o, s_fin


def mixer_ab(a, s0_fwd, s0_bwd, w_in, conv_qkv, conv_sc, a_log, dt_bias, out_norm, w_out):
    B, L, _ = a.shape
    z = a @ w_in
    qkv, gate, a_in, b_in, sc = jnp.split(z, [C_GATE, C_ALPHA, C_BETA, C_SC], axis=-1)
    qkv = jax.nn.silu(dwconv_centred(qkv, conv_qkv))
    q, k, v = jnp.split(qkv, [DN_QK_W, 2 * DN_QK_W], axis=-1)
    q = l2norm(q.reshape(B, L, DN_HEADS, DN_DK))
    k = l2norm(k.reshape(B, L, DN_HEADS, DN_DK))
    v = v.reshape(B, L, DN_HEADS, DN_DV)
    log_a = -jnp.exp(a_log.astype(F32)) * jax.nn.softplus(
        a_in.astype(F32).reshape(B, L, 2, DN_HEADS) + dt_bias.astype(F32))
    beta = jax.nn.sigmoid(b_in.astype(F32)).reshape(B, L, 2, DN_HEADS)
    o_f, s_f = gated_delta_rule(q, k, v, log_a[:, :, 0], beta[:, :, 0], s0_fwd)
    rev = lambda t: jnp.flip(t, axis=1)
    o_b, s_b = gated_delta_rule(rev(q), rev(k), rev(v), rev(log_a[:, :, 1]), rev(beta[:, :, 1]), s0_bwd)
    o = (o_f + rev(o_b)).astype(a.dtype)
    o = rmsnorm(o, out_norm) * jax.nn.silu(gate.reshape(B, L, DN_HEADS, DN_DV))
    b_g, c_g, h_in = jnp.split(sc, 3, axis=-1)
    y_sc = b_g * dwconv_centred(c_g * h_in, conv_sc)
    y = jnp.concatenate([o.reshape(B, L, DN_V_W), y_sc], axis=-1) @ w_out
    return y, s_f, s_b


def axial_rope(t, rows, cols):
    half = t.shape[-1] // 2
    nf = half // 2
    inv = jnp.power(ROPE_BASE, -jnp.arange(nf, dtype=F32) / nf)
    bshape = (1, t.shape[1]) + (1,) * (t.ndim - 3) + (nf,)

    def rot(u, pos):
        ang = (pos.astype(F32)[:, None] * inv).reshape(bshape)
        cos, sin = jnp.cos(ang), jnp.sin(ang)
        u1, u2 = u[..., :nf].astype(F32), u[..., nf:].astype(F32)
        return jnp.concatenate([u1 * cos - u2 * sin, u1 * sin + u2 * cos], axis=-1)

    return jnp.concatenate([rot(t[..., :half], rows), rot(t[..., half:], cols)], axis=-1).astype(t.dtype)


def split_qkv(z):
    B, L, _ = z.shape
    q, k, v = jnp.split(z, [MIX1_WIDTH, MIX1_WIDTH + ATT_KV_HEADS * ATT_HD], axis=-1)
    return (q.reshape(B, L, ATT_KV_HEADS, GQA_GROUP, ATT_HD),
            k.reshape(B, L, ATT_KV_HEADS, ATT_HD),
            v.reshape(B, L, ATT_KV_HEADS, ATT_HD))


def sink_attend(q, k_parts, v_parts, masks, sink_g):
    scale = ATT_HD ** -0.5
    logits = []
    for kp, m in zip(k_parts, masks):
        s = jnp.einsum('bqkgd,bskd->bkgqs', q, kp).astype(F32) * scale
        if m is not None:
            s = jnp.where(m, s, -jnp.inf)
        logits.append(s)
    B, Q = q.shape[:2]
    sink_col = jnp.broadcast_to(sink_g.astype(F32)[None, :, :, None, None], (B, ATT_KV_HEADS, GQA_GROUP, Q, 1))
    p = jax.nn.softmax(jnp.concatenate(logits + [sink_col], axis=-1), axis=-1)
    out = None
    off = 0
    for vp in v_parts:
        n = vp.shape[1]
        term = jnp.einsum('bkgqs,bskd->bqkgd', p[..., off:off + n].astype(vp.dtype), vp)
        out = term if out is None else out + term
        off += n
    return out


def mixer_c(a_lat, a_ctx, rows, cols, w_in, sink, w_out, ctx_out):
    B, L, _ = a_lat.shape
    Lc = a_ctx.shape[1]
    sink_g = sink.reshape(ATT_KV_HEADS, GQA_GROUP)
    q, k, v = split_qkv(a_lat @ w_in)
    qc, kc, vc = split_qkv(a_ctx @ w_in)
    q = axial_rope(q, rows, cols)
    k = axial_rope(k, rows, cols)
    pad = ((0, 0), (WINDOW, WINDOW), (0, 0), (0, 0))
    kp = jnp.pad(k, pad)
    vp = jnp.pad(v, pad)
    span = Q_BLOCK + 2 * WINDOW
    offs_q = jnp.arange(Q_BLOCK)
    offs_k = jnp.arange(span) - WINDOW

    def block(start):
        qb = lax.dynamic_slice_in_dim(q, start, Q_BLOCK, axis=1)
        kb = lax.dynamic_slice_in_dim(kp, start, span, axis=1)
        vb = lax.dynamic_slice_in_dim(vp, start, span, axis=1)
        qpos = start + offs_q
        kpos = start + offs_k
        valid = ((jnp.abs(qpos[:, None] - kpos[None, :]) <= WINDOW)
                 & (kpos[None, :] >= 0) & (kpos[None, :] < L))
        return sink_attend(qb, (kb, kc), (vb, vc), (valid, None), sink_g)

    o = lax.map(block, jnp.arange(L // Q_BLOCK) * Q_BLOCK)
    y_lat = jnp.moveaxis(o, 0, 1).reshape(B, L, MIX1_WIDTH) @ w_out
    if not ctx_out:
        return y_lat, None
    oc = sink_attend(qc, (kc,), (vc,), (None,), sink_g)
    y_ctx = oc.reshape(B, Lc, MIX1_WIDTH) @ w_out
    return y_lat, y_ctx


def expert_ffn_sorted(x, expert_id, weights, w1, w3, w2):
    T, D = x.shape
    A = T * TOP_K
    e_flat = expert_id.reshape(A)
    tok = jnp.repeat(jnp.arange(T, dtype=jnp.int32), TOP_K)
    order = jnp.argsort(e_flat)
    e_sorted = e_flat[order]
    tok_sorted = tok[order]
    counts = jnp.zeros((N_EXPERTS,), jnp.int32).at[e_flat].add(1)
    padded = ((counts + MOE_BLOCK - 1) // MOE_BLOCK) * MOE_BLOCK
    start = jnp.cumsum(counts) - counts
    pend = jnp.cumsum(padded)
    pstart = pend - padded
    dest = pstart[e_sorted] + (jnp.arange(A, dtype=jnp.int32) - start[e_sorted])
    n_blocks = -(-A // MOE_BLOCK) + N_EXPERTS
    rows_total = n_blocks * MOE_BLOCK
    buf = jnp.zeros((rows_total, D), x.dtype).at[dest].set(x[tok_sorted])
    blk_start = jnp.arange(n_blocks, dtype=jnp.int32) * MOE_BLOCK
    blk_expert = jnp.minimum(jnp.searchsorted(pend, blk_start, side='right'), N_EXPERTS - 1)

    def run(args):
        xb, e = args
        h = jax.nn.silu(xb @ w1[e]) * (xb @ w3[e])
        return h @ w2[e]

    y = lax.map(run, (buf.reshape(n_blocks, MOE_BLOCK, D), blk_expert)).reshape(rows_total, D)
    contrib = y[dest] * weights.reshape(A)[order][:, None].astype(y.dtype)
    return jnp.zeros((T, D), x.dtype).at[tok_sorted].add(contrib)


def hier_moe(x, w_group, w_expert, w1, w3, w2):
    T = x.shape[0]
    g_logits = (x @ w_group).astype(F32)
    g_prob = jax.nn.softmax(g_logits, axis=-1)
    g_sel = jnp.argmax(g_logits, axis=-1).astype(jnp.int32)
    p_group = jnp.take_along_axis(g_prob, g_sel[:, None], axis=-1)
    e_logits = (x @ w_expert).astype(F32).reshape(T, N_GROUPS, EXPERTS_PER_GROUP)
    e_in = jnp.take_along_axis(e_logits, g_sel[:, None, None], axis=1)[:, 0]
    top_p, top_i = lax.top_k(jax.nn.softmax(e_in, axis=-1), TOP_K)
    weights = p_group * top_p / jnp.sum(top_p, axis=-1, keepdims=True)
    expert_id = g_sel[:, None] * EXPERTS_PER_GROUP + top_i.astype(jnp.int32)
    return expert_ffn_sorted(x, expert_id, weights, w1, w3, w2)


def setup_inputs(seed: int = 0) -> dict:
    key = jax.random.key(seed)
    ks = jax.random.split(key, 24)
    D = D_MODEL

    def nrm(k, shape, fan):
        return jax.random.normal(k, shape, F32) * (fan ** -0.5)

    def std(k, shape):
        return jax.random.normal(k, shape, F32)

    dt = jnp.exp(jax.random.uniform(ks[13], (N_EVEN, 2, DN_HEADS), F32,
                                    minval=math.log(1e-3), maxval=math.log(1e-1)))
    return {
        'x': std(ks[0], (BATCH, SEQ, D)),
        'c': std(ks[1], (BATCH, D)),
        'ctx': std(ks[2], (BATCH, CTX_LEN, D)),
        'c_ctx': std(ks[3], (D,)),
        'ada_w': nrm(ks[4], (DEPTH, D, 6 * D), D),
        'ada_b': 0.02 * std(ks[5], (DEPTH, 6 * D)),
        'norm_mix': 1.0 + 0.1 * std(ks[6], (DEPTH, D)),
        'norm_ffn': 1.0 + 0.1 * std(ks[7], (DEPTH, D)),
        'norm_final': 1.0 + 0.1 * std(ks[8], (D,)),
        'ab_w_in': nrm(ks[9], (N_EVEN, D, IN0_COLS), D),
        'ab_conv_qkv': nrm(ks[10], (N_EVEN, QKV_CONV, QKV_W), QKV_CONV),
        'ab_conv_sc': nrm(ks[11], (N_EVEN, SC_CONV, SC_WIDTH), SC_CONV),
        'ab_a_log': jnp.log(jax.random.uniform(ks[12], (N_EVEN, 2, DN_HEADS), F32, minval=1.0, maxval=16.0)),
        'ab_dt_bias': dt + jnp.log(-jnp.expm1(-dt)),
        'ab_out_norm': 1.0 + 0.1 * std(ks[14], (N_EVEN, DN_DV)),
        'ab_w_out': nrm(ks[15], (N_EVEN, MIX0_WIDTH, D), MIX0_WIDTH),
        'at_w_in': nrm(ks[16], (N_ODD, D, IN1_COLS), D),
        'at_sink': 0.5 * std(ks[17], (N_ODD, ATT_HEADS)),
        'at_w_out': nrm(ks[18], (N_ODD, MIX1_WIDTH, D), MIX1_WIDTH),
        'moe_w_group': nrm(ks[19], (DEPTH, D, N_GROUPS), D),
        'moe_w_expert': nrm(ks[20], (DEPTH, D, N_EXPERTS), D),
        'moe_w1': nrm(ks[21], (DEPTH, N_EXPERTS, D, D_EXPERT), D),
        'moe_w3': nrm(ks[22], (DEPTH, N_EXPERTS, D, D_EXPERT), D),
        'moe_w2': nrm(ks[23], (DEPTH, N_EXPERTS, D_EXPERT, D), D_EXPERT),
    }


def reference(x, c, ctx, c_ctx, ada_w, ada_b, norm_mix, norm_ffn, norm_final,
              ab_w_in, ab_conv_qkv, ab_conv_sc, ab_a_log, ab_dt_bias, ab_out_norm, ab_w_out,
              at_w_in, at_sink, at_w_out,
              moe_w_group, moe_w_expert, moe_w1, moe_w3, moe_w2):
    B, L, D = x.shape
    Lc = ctx.shape[1]
    n_rows = L // GRID_W
    rows = jnp.repeat(jnp.arange(n_rows, dtype=jnp.int32), GRID_W)
    cols = jnp.tile(jnp.arange(GRID_W, dtype=jnp.int32), n_rows)
    s_zero = jnp.zeros((B, DN_HEADS, DN_DK, DN_DV), F32)

    h_lat, h_ctx = x, ctx
    sc_lat = jax.nn.silu(c)
    sc_ctx = jax.nn.silu(c_ctx)
    for l in range(DEPTH):
        last = l == DEPTH - 1
        i = l // 2
        mod_lat = (sc_lat @ ada_w[l] + ada_b[l])[:, None, :]
        mod_ctx = sc_ctx @ ada_w[l] + ada_b[l]
        sh1, s1, g1, sh2, s2, g2 = jnp.split(mod_lat, 6, axis=-1)
        csh1, cs1, cg1, csh2, cs2, cg2 = jnp.split(mod_ctx, 6, axis=-1)

        a_lat = modulate(rmsnorm(h_lat, norm_mix[l]), sh1, s1)
        a_ctx = modulate(rmsnorm(h_ctx, norm_mix[l]), csh1, cs1)
        if l % 2 == 0:
            y_ctx, s_f, s_b = mixer_ab(a_ctx, s_zero, s_zero, ab_w_in[i], ab_conv_qkv[i], ab_conv_sc[i],
                                       ab_a_log[i], ab_dt_bias[i], ab_out_norm[i], ab_w_out[i])
            y_lat, _, _ = mixer_ab(a_lat, s_f, s_b, ab_w_in[i], ab_conv_qkv[i], ab_conv_sc[i],
                                   ab_a_log[i], ab_dt_bias[i], ab_out_norm[i], ab_w_out[i])
        else:
            y_lat, y_ctx = mixer_c(a_lat, a_ctx, rows, cols, at_w_in[i], at_sink[i], at_w_out[i],
                                   not last)
        h_lat = h_lat + g1 * y_lat

        f_lat = modulate(rmsnorm(h_lat, norm_ffn[l]), sh2, s2)
        if last:
            out = hier_moe(f_lat.reshape(B * L, D), moe_w_group[l], moe_w_expert[l],
                           moe_w1[l], moe_w3[l], moe_w2[l])
            h_lat = h_lat + g2 * out.reshape(B, L, D)
        else:
            h_ctx = h_ctx + cg1 * y_ctx
            f_ctx = modulate(rmsnorm(h_ctx, norm_ffn[l]), csh2, cs2)
            tokens = jnp.concatenate([f_ctx.reshape(B * Lc, D), f_lat.reshape(B * L, D)], axis=0)
            out = hier_moe(tokens, moe_w_group[l], moe_w_expert[l], moe_w1[l], moe_w3[l], moe_w2[l])
            h_ctx = h_ctx + cg2 * out[:B * Lc].reshape(B, Lc, D)
            h_lat = h_lat + g2 * out[B * Lc:].reshape(B, L, D)
    return rmsnorm(h_lat, norm_final)
```

```cpp
#include <hip/hip_runtime.h>
#include <cstdio>
#include <cstdint>
namespace pg8 {
#define PG8_LAS __attribute__((address_space(3)))
typedef unsigned short bf16_t;
typedef short bf16x8 __attribute__((ext_vector_type(8)));
typedef float f32x4 __attribute__((ext_vector_type(4)));
typedef unsigned u32x4 __attribute__((ext_vector_type(4)));
typedef unsigned u32x2 __attribute__((ext_vector_type(2)));
__device__ __forceinline__ void st16_wt(void* p, const u32x4 v) { asm volatile("global_store_dwordx4 %0, %1, off sc1\n\ts_nop 1" :: "v"(p), "v"(v)); }
__device__ __forceinline__ void st8_wt(void* p, const u32x2 v) { asm volatile("global_store_dwordx2 %0, %1, off sc1\n\ts_nop 1" :: "v"(p), "v"(v)); }
constexpr int BM = 256, BK = 64, HALF = 128, HTB = HALF * BK * 2  , STAGE_BYTES = 8 * HTB, NXCD = 8, WGM = 8;

__host__ __device__ __forceinline__ int lds_byte(int r, int c) { const int st = (r >> 4) * 2 + (c >> 5), rr = r & 15, cc = c & 31, ob = rr * 64 + cc * 2; return st * 1024 + (ob ^ (((ob >> 9) & 1) << 5)); }
__host__ __device__ __forceinline__ void stage_rc(int b, int& R, int& C) { const int st = b / 1024, sb = b % 1024, swz = sb ^ (((sb >> 9) & 1) << 5); R = (st >> 1) * 16 + swz / 64; C = (st & 1) * 32 + (swz % 64) / 2; }
__host__ __device__ __forceinline__ int perm32(int rho) { const int n = rho >> 4, i = rho & 15; return 8 * (i >> 2) + 4 * n + (i & 3); }

struct Unit { int pm, pn; };
struct Gemm { const bf16_t* A; const bf16_t* Bt; int M, N, K; };

struct StaticOrder {
    int nM, nN, nwg, G, c;
    __host__ __device__ void init(int M, int N, int G_, int c_) { nM = M / BM; nN = N / BM; nwg = nM * nN; G = G_; c = c_; }
    __host__ __device__ bool next(int i, Unit& u) const {
        const long L = (long)i * G + c; if (L >= nwg) return false;
        int wgid = (int)L; { const int q = nwg / NXCD, r = nwg % NXCD, xcd = wgid % NXCD, off = wgid / NXCD; wgid = (xcd < r ? xcd * (q + 1) : r * (q + 1) + (xcd - r) * q) + off; }
        const int nig = WGM * nN, gid = wgid / nig, fm = gid * WGM, gsz = (nM - fm) < WGM ? (nM - fm) : WGM;
        u.pm = fm + ((wgid % nig) % gsz); u.pn = (wgid % nig) / gsz; return true;
    }
    __device__ __forceinline__ void a_ready(const Unit&) const {}
    __device__ __forceinline__ void done(const Unit&) const {}
};

typedef float f32x2c __attribute__((ext_vector_type(2)));
typedef __bf16 bf16x2c __attribute__((ext_vector_type(2)));
__device__ __forceinline__ unsigned cvt_pk_bf16(float lo, float hi) { const f32x2c v = {lo, hi}; const bf16x2c b = __builtin_convertvector(v, bf16x2c); return __builtin_bit_cast(unsigned, b); }
__device__ __forceinline__ float silu_f(float x) { return x * __builtin_amdgcn_rcpf(1.0f + __expf(-x)); }

struct EpiBf16N {
    static constexpr bool PERM = true, AFTER_DRAIN = false;
    bf16_t* O; int ldc; int pnmask;
    __device__ __forceinline__ void operator()(const f32x4 (&acc)[2][2][4][2], const Unit& u, int wr, int wc, int fr, int fq) const {
        const int row0 = u.pm * BM + wr * 64 + fr; const int col0 = (u.pn & pnmask) * BM + wc * 32 + 8 * fq;
#pragma unroll
        for (int ai = 0; ai < 2; ++ai)
#pragma unroll
            for (int m = 0; m < 4; ++m) { bf16_t* rowp = O + (size_t)(row0 + ai * HALF + m * 16) * ldc + col0;
#pragma unroll
                for (int bj = 0; bj < 2; ++bj) { const f32x4 v0 = acc[ai][bj][m][0], v1 = acc[ai][bj][m][1];
                    u32x4 w; w.x = cvt_pk_bf16(v0[0], v0[1]); w.y = cvt_pk_bf16(v0[2], v0[3]); w.z = cvt_pk_bf16(v1[0], v1[1]); w.w = cvt_pk_bf16(v1[2], v1[3]);
                    st16_wt(rowp + bj * HALF, w); } }
    }
};
struct EpiSwiGLU {
    static constexpr bool PERM = true, AFTER_DRAIN = false;
    bf16_t* O;
    __device__ __forceinline__ void operator()(const f32x4 (&acc)[2][2][4][2], const Unit& u, int wr, int wc, int fr, int fq) const {
        const int row0 = u.pm * BM + wr * 64 + fr; const int col0 = (u.pn & 3) * 128 + wc * 16 + 4 * fq;
#pragma unroll
        for (int ai = 0; ai < 2; ++ai)
#pragma unroll
            for (int m = 0; m < 4; ++m) { bf16_t* rowp = O + (size_t)(row0 + ai * HALF + m * 16) * 512 + col0;
#pragma unroll
                for (int bj = 0; bj < 2; ++bj) { const f32x4 a = acc[ai][bj][m][0], b = acc[ai][bj][m][1];
                    u32x2 w; w.x = cvt_pk_bf16(silu_f(a[0]) * b[0], silu_f(a[1]) * b[1]); w.y = cvt_pk_bf16(silu_f(a[2]) * b[2], silu_f(a[3]) * b[3]);
                    st8_wt(rowp + bj * 64, w); } }
    }
};
struct EpiResid {
    static constexpr bool PERM = false, AFTER_DRAIN = false;
    const float* resid_ctx; const float* resid_lat; float* out_ctx; float* out_lat; const float* mod; int ctx_rows;
    __device__ __forceinline__ void operator()(const f32x4 (&acc)[2][2][4][2], const Unit& u, int wr, int wc, int fr, int fq) const {
        const int rt = u.pm * BM; const float* rs; float* op; const float* gp; int rbase;
        if (rt < ctx_rows) { rs = resid_ctx; op = out_ctx; gp = mod + 16 * 6144; rbase = rt; }
        else { rbase = rt - ctx_rows; rs = resid_lat; op = out_lat; gp = mod + (size_t)(rbase >> 11) * 6144; }
        const int col0 = u.pn * BM + wc * 32 + 4 * fq;
        f32x4 gv[2][2];
#pragma unroll
        for (int bj = 0; bj < 2; ++bj)
#pragma unroll
            for (int n = 0; n < 2; ++n) gv[bj][n] = *(const f32x4*)(gp + col0 + bj * HALF + n * 16);
#pragma unroll
        for (int ai = 0; ai < 2; ++ai)
#pragma unroll
            for (int m = 0; m < 4; ++m) { const size_t off = (size_t)(rbase + wr * 64 + fr + ai * HALF + m * 16) * 1024 + col0;
#pragma unroll
                for (int bj = 0; bj < 2; ++bj)
#pragma unroll
                    for (int n = 0; n < 2; ++n) { const f32x4 r = *(const f32x4*)(rs + off + bj * HALF + n * 16);
                        *(f32x4*)(op + off + bj * HALF + n * 16) = r + gv[bj][n] * acc[ai][bj][m][n]; } }
    }
};
struct EpiRope {
    static constexpr bool PERM = false, AFTER_DRAIN = false;
    bf16_t* Q; bf16_t* K; bf16_t* V; const float* ctab; const float* stab;
    __device__ __forceinline__ void operator()(const f32x4 (&acc)[2][2][4][2], const Unit& u, int wr, int wc, int fr, int fq) const {
        const int rt = u.pm * BM; const bool lat = rt >= 4096;
#pragma unroll
        for (int ai = 0; ai < 2; ++ai)
#pragma unroll
            for (int m = 0; m < 4; ++m) { const int r = rt + ai * HALF + wr * 64 + m * 16 + fr;
                f32x4 cs = (f32x4){1.f, 1.f, 1.f, 1.f}, sn = (f32x4){0.f, 0.f, 0.f, 0.f};
                if (lat && u.pn < 5) { const int t = (r - 4096) & 2047; const int pos = (wc & 1) ? (t & 63) : (t >> 6);
                    cs = *(const f32x4*)(ctab + pos * 16 + 4 * fq); sn = *(const f32x4*)(stab + pos * 16 + 4 * fq); }
#pragma unroll
                for (int bj = 0; bj < 2; ++bj) { const f32x4 u1 = acc[ai][bj][m][0], u2 = acc[ai][bj][m][1];
                    f32x4 o1 = u1 * cs - u2 * sn, o2 = u1 * sn + u2 * cs;
                    const int lc = bj * HALF + wc * 32 + 4 * fq; bf16_t* p;
                    if (u.pn < 4) { o1 = o1 * 0.18033688011112042f; o2 = o2 * 0.18033688011112042f;     p = Q + (size_t)(r - 4096) * 1024 + u.pn * BM + lc; }
                    else if (u.pn == 4) p = K + (size_t)r * 256 + lc;
                    else p = V + (size_t)r * 256 + lc;
                    u32x2 w1, w2; w1.x = cvt_pk_bf16(o1[0], o1[1]); w1.y = cvt_pk_bf16(o1[2], o1[3]); w2.x = cvt_pk_bf16(o2[0], o2[1]); w2.y = cvt_pk_bf16(o2[2], o2[3]);
                    st8_wt(p, w1); st8_wt(p + 16, w2); } }
    }
};
struct MoeOrder {
    const PG8_LAS int* tab; int nT, G, c; const int* rowse;
    int cap;
    __device__ __forceinline__ bool next(int i, Unit& u) const { const long L = (long)i * G + c; if (L >= (long)nT * 4) return false; const int pm = (int)(L >> 2); u.pm = pm; u.pn = tab[128 + pm] * 4 + (int)(L & 3); return true; }
    __device__ __forceinline__ int row(int pm, int r) const { const int e = tab[128 + pm], idx = pm * 256 - tab[32 + e] + r; return rowse[(size_t)e * cap + (idx < tab[e] ? idx : 0)]; }
    __device__ __forceinline__ void a_ready(const Unit&) const {}
    __device__ __forceinline__ void done(const Unit&) const {}
};
struct QkvOrder {
    int G, c;
    __device__ __forceinline__ bool next(int i, Unit& u) const { const long L = (long)i * G + c; if (L < 768) { u.pm = 16 + (int)(L / 6); u.pn = (int)(L % 6); return true; }
        if (L < 800) { u.pm = (int)(L - 768) >> 1; u.pn = 4 + ((int)(L - 768) & 1); return true; } return false; }
    __device__ __forceinline__ void a_ready(const Unit&) const {}
    __device__ __forceinline__ void done(const Unit&) const {}
};
struct LatOrder {
    int nM, nN, G, c;
    __device__ __forceinline__ bool next(int i, Unit& u) const { const long L = (long)i * G + c; if (L >= (long)nM * nN) return false; u.pm = (int)(L / nN); u.pn = (int)(L % nN); return true; }
    __device__ __forceinline__ void a_ready(const Unit&) const {}
    __device__ __forceinline__ void done(const Unit&) const {}
};
template <class Epi, class Sched, bool ALIGN_EPI = false, bool SP2 = false, bool GATHER = false>
__device__ __forceinline__ void gemm_phase(PG8_LAS unsigned char* lds, const Gemm g, const Sched& S, const Epi& E) {
    int tid_ = threadIdx.x; asm volatile("" : "+v"(tid_));
    const int tid = tid_, wid = __builtin_amdgcn_readfirstlane(tid >> 6), lane = tid & 63, wr = wid >> 2, wc = wid & 3, fr = lane & 15, fq = lane >> 4;
    const int K = g.K, nt = K / BK;
    unsigned voffA[2], voffB[2];
#pragma unroll
    for (int i = 0; i < 2; ++i) { int R, C; stage_rc(tid * 16 + i * 8192, R, C); const int Rb = Epi::PERM ? ((R & ~31) + perm32(R & 31)) : R;
        voffA[i] = (unsigned)(R * K + C) * 2u; voffB[i] = (unsigned)(Rb * K + C) * 2u; }
    const size_t kstep = (size_t)(BK * 2);
    const size_t hstep = (size_t)HALF * K * 2;
    const size_t tstep = 2 * hstep;
    const size_t hstepA = GATHER ? 0 : hstep;
    const unsigned ldsw = (unsigned)wid * 1024u;
    const int aoff = lds_byte(wr * 64 + fr, fq * 8), boff = lds_byte(wc * 32 + fr, fq * 8);
#define PG8_SA(b, h) (((b) * 2 + (h)) * HTB)
#define PG8_SB(b, h) ((4 + (b) * 2 + (h)) * HTB)
#define PG8_STAGE(bufoff, gbase, voff) do { _Pragma("unroll") for (int _i = 0; _i < 2; ++_i) \
        __builtin_amdgcn_global_load_lds((const unsigned*)((const char*)(gbase) + (voff)[_i]), (PG8_LAS unsigned*)(lds + (bufoff) + ldsw + _i * 8192), 16, 0, 0); } while (0)
#define PG8_LDA(dst, b, h) do { _Pragma("unroll") for (int m = 0; m < 4; ++m) _Pragma("unroll") for (int k = 0; k < 2; ++k) dst[m][k] = *(const PG8_LAS bf16x8*)(lds + PG8_SA(b, h) + aoff + m * 2048 + k * 1024); } while (0)
#define PG8_LDB(dst, b, h) do { _Pragma("unroll") for (int n = 0; n < 2; ++n) _Pragma("unroll") for (int k = 0; k < 2; ++k) dst[n][k] = *(const PG8_LAS bf16x8*)(lds + PG8_SB(b, h) + boff + n * 2048 + k * 1024); } while (0)
#define PG8_MMA(ai, bj, At, Bt) do { __builtin_amdgcn_s_setprio(1); _Pragma("unroll") for (int m = 0; m < 4; ++m) _Pragma("unroll") for (int n = 0; n < 2; ++n) _Pragma("unroll") for (int k = 0; k < 2; ++k) \
        acc[ai][bj][m][n] = __builtin_amdgcn_mfma_f32_16x16x32_bf16(Bt[n][k], At[m][k], acc[ai][bj][m][n], 0, 0, 0); __builtin_amdgcn_s_setprio(0); } while (0)
#define PG8_WAIT_V(n) asm volatile("s_waitcnt vmcnt(" #n ")" ::: "memory")
#define PG8_WAIT_L(n) asm volatile("s_waitcnt lgkmcnt(" #n ")" ::: "memory")
#define PG8_BAR __builtin_amdgcn_s_barrier()
#define PG8_SCHED __builtin_amdgcn_sched_barrier(0)
    Unit cur, nxt; int ui = 0;
    if (!S.next(0, cur)) return;
    f32x4 acc[2][2][4][2];
#pragma unroll
    for (int a = 0; a < 2; ++a)
#pragma unroll
        for (int b = 0; b < 2; ++b)
#pragma unroll
            for (int m = 0; m < 4; ++m)
#pragma unroll
                for (int n = 0; n < 2; ++n) acc[a][b][m][n] = (f32x4){0.f, 0.f, 0.f, 0.f};
    bf16x8 At[4][2], B0[2][2], B1[2][2];
    const char* cA = (const char*)g.A + (GATHER ? (size_t)0 : (size_t)cur.pm * tstep); const char* cB = (const char*)g.Bt + (size_t)cur.pn * tstep;
    unsigned vC[2][2], vN[2][2], v2[2][2];
    int RA[2], CA[2];
#pragma unroll
    for (int i = 0; i < 2; ++i) stage_rc(tid * 16 + i * 8192, RA[i], CA[i]);
    PG8_LAS int* lrows = (PG8_LAS int*)(lds + STAGE_BYTES);
    if constexpr (GATHER) {
        Unit uu; for (int i = 0; i < 8 && S.next(i, uu); ++i) { if (tid < 256) lrows[i * 256 + tid] = S.row(uu.pm, tid); }
        __syncthreads();
#pragma unroll
        for (int h = 0; h < 2; ++h)
#pragma unroll
            for (int i = 0; i < 2; ++i) vC[h][i] = (unsigned)lrows[h * 128 + RA[i]] * (unsigned)(K * 2) + (unsigned)(CA[i] * 2);
    } else {
#pragma unroll
        for (int h = 0; h < 2; ++h)
#pragma unroll
            for (int i = 0; i < 2; ++i) vC[h][i] = voffA[i];
    }
#pragma unroll
    for (int h = 0; h < 2; ++h)
#pragma unroll
        for (int i = 0; i < 2; ++i) { vN[h][i] = vC[h][i]; v2[h][i] = vC[h][i]; }
    S.a_ready(cur);
    if constexpr (SP2) {
        PG8_STAGE(PG8_SB(0, 0), cB, voffB); PG8_STAGE(PG8_SB(0, 1), cB + hstep, voffB); PG8_STAGE(PG8_SA(0, 0), cA, vC[0]); PG8_STAGE(PG8_SA(0, 1), cA + hstepA, vC[1]);
        if (wr == 1) PG8_BAR;
        PG8_WAIT_V(2); PG8_BAR;
        PG8_STAGE(PG8_SB(1, 0), cB + kstep, voffB); PG8_STAGE(PG8_SA(1, 0), cA + kstep, vC[0]); PG8_STAGE(PG8_SB(1, 1), cB + hstep + kstep, voffB);
        PG8_WAIT_V(6); PG8_BAR;
    } else {
        PG8_STAGE(PG8_SB(0, 0), cB, voffB); PG8_STAGE(PG8_SA(0, 0), cA, vC[0]); PG8_STAGE(PG8_SB(0, 1), cB + hstep, voffB); PG8_STAGE(PG8_SA(0, 1), cA + hstepA, vC[1]);
        if (wr == 1) PG8_BAR;
        PG8_WAIT_V(4); PG8_BAR;
        PG8_STAGE(PG8_SB(1, 0), cB + kstep, voffB); PG8_STAGE(PG8_SA(1, 0), cA + kstep, vC[0]); PG8_STAGE(PG8_SB(1, 1), cB + hstep + kstep, voffB);
        PG8_WAIT_V(6); PG8_BAR;
    }
    for (;;) {
        const bool has_next = S.next(ui + 1, nxt);
        const char* nA = (has_next && !GATHER) ? (const char*)g.A + (size_t)nxt.pm * tstep : cA; const char* nB = has_next ? (const char*)g.Bt + (size_t)nxt.pn * tstep : cB;
        if constexpr (GATHER) { if (has_next) {
#pragma unroll
            for (int h = 0; h < 2; ++h)
#pragma unroll
                for (int i = 0; i < 2; ++i) vN[h][i] = (unsigned)lrows[(ui + 1) * 256 + h * 128 + RA[i]] * (unsigned)(K * 2) + (unsigned)(CA[i] * 2); } }
        for (int t = 0; t < nt; t += 2) {
            const bool last = (t == nt - 2);
            const char* a1 = cA + (size_t)(t + 1) * kstep;
            const char* a2 = last ? nA : cA + (size_t)(t + 2) * kstep; const char* b2 = last ? nB : cB + (size_t)(t + 2) * kstep;
            const char* a3 = a2 + kstep; const char* b3 = b2 + kstep;
            if constexpr (GATHER) {
#pragma unroll
                for (int h = 0; h < 2; ++h)
#pragma unroll
                    for (int i = 0; i < 2; ++i) v2[h][i] = (last && has_next) ? vN[h][i] : vC[h][i]; }
            if (last && has_next) S.a_ready(nxt);
            if constexpr (SP2) {
            PG8_LDB(B0, 0, 0); PG8_LDB(B1, 0, 1); PG8_SCHED; PG8_LDA(At, 0, 0); PG8_STAGE(PG8_SA(1, 1), a1 + hstepA, vC[1]);
            PG8_WAIT_V(8); PG8_WAIT_L(0); PG8_BAR; PG8_MMA(0, 0, At, B0); PG8_MMA(0, 1, At, B1); PG8_BAR; PG8_SCHED;
            PG8_LDA(At, 0, 1); PG8_STAGE(PG8_SB(0, 0), b2, voffB); PG8_STAGE(PG8_SB(0, 1), b2 + hstep, voffB); PG8_STAGE(PG8_SA(0, 0), a2, v2[0]);
            PG8_WAIT_V(8); PG8_WAIT_L(0); PG8_BAR; PG8_MMA(1, 0, At, B0); PG8_MMA(1, 1, At, B1); PG8_BAR; PG8_SCHED;
            PG8_LDB(B0, 1, 0); PG8_LDB(B1, 1, 1); PG8_SCHED; PG8_LDA(At, 1, 0); PG8_STAGE(PG8_SA(0, 1), a2 + hstepA, v2[1]);
            PG8_WAIT_V(8); PG8_WAIT_L(0); PG8_BAR; PG8_MMA(0, 0, At, B0); PG8_MMA(0, 1, At, B1); PG8_BAR; PG8_SCHED;
            PG8_LDA(At, 1, 1); PG8_STAGE(PG8_SB(1, 0), b3, voffB); PG8_STAGE(PG8_SB(1, 1), b3 + hstep, voffB); PG8_STAGE(PG8_SA(1, 0), a3, v2[0]);
            PG8_WAIT_V(8); PG8_WAIT_L(0); PG8_BAR; PG8_MMA(1, 0, At, B0); PG8_MMA(1, 1, At, B1); PG8_BAR; PG8_SCHED;
            } else {
            PG8_LDB(B0, 0, 0); PG8_SCHED; PG8_LDA(At, 0, 0); PG8_STAGE(PG8_SA(1, 1), a1 + hstepA, vC[1]);
            PG8_WAIT_L(8); PG8_BAR; PG8_WAIT_L(0); PG8_MMA(0, 0, At, B0); PG8_BAR; PG8_SCHED;
            PG8_LDB(B1, 0, 1); PG8_STAGE(PG8_SB(0, 0), b2, voffB);
            PG8_BAR; PG8_WAIT_L(0); PG8_MMA(0, 1, At, B1); PG8_BAR;
            PG8_LDA(At, 0, 1); PG8_STAGE(PG8_SA(0, 0), a2, v2[0]);
            PG8_BAR; PG8_WAIT_L(0); PG8_MMA(1, 0, At, B0); PG8_BAR; PG8_SCHED;
            PG8_STAGE(PG8_SB(0, 1), b2 + hstep, voffB);
            PG8_WAIT_V(6); PG8_BAR; PG8_MMA(1, 1, At, B1); PG8_BAR;
            PG8_LDB(B0, 1, 0); PG8_SCHED; PG8_LDA(At, 1, 0); PG8_STAGE(PG8_SA(0, 1), a2 + hstepA, v2[1]);
            PG8_WAIT_L(8); PG8_BAR; PG8_WAIT_L(0); PG8_MMA(0, 0, At, B0); PG8_BAR; PG8_SCHED;
            PG8_LDB(B1, 1, 1); PG8_STAGE(PG8_SB(1, 0), b3, voffB);
            PG8_BAR; PG8_WAIT_L(0); PG8_MMA(0, 1, At, B1); PG8_BAR;
            PG8_LDA(At, 1, 1); PG8_STAGE(PG8_SA(1, 0), a3, v2[0]);
            PG8_BAR; PG8_WAIT_L(0); PG8_MMA(1, 0, At, B0); PG8_BAR; PG8_SCHED;
            PG8_STAGE(PG8_SB(1, 1), b3 + hstep, voffB);
            PG8_WAIT_V(6); PG8_BAR; PG8_MMA(1, 1, At, B1); PG8_BAR;
            }
        }
        if constexpr (ALIGN_EPI) { if (wr == 0) PG8_BAR; }
        if constexpr (!Epi::AFTER_DRAIN) { E(acc, cur, wr, wc, fr, fq); S.done(cur); }
        if (!has_next) break;
#pragma unroll
        for (int a = 0; a < 2; ++a)
#pragma unroll
            for (int b = 0; b < 2; ++b)
#pragma unroll
                for (int m = 0; m < 4; ++m)
#pragma unroll
                    for (int n = 0; n < 2; ++n) acc[a][b][m][n] = (f32x4){0.f, 0.f, 0.f, 0.f};
        cur = nxt; cA = nA; cB = nB; ++ui;
        if constexpr (GATHER) {
#pragma unroll
            for (int h = 0; h < 2; ++h)
#pragma unroll
                for (int i = 0; i < 2; ++i) vC[h][i] = vN[h][i]; }
        if constexpr (ALIGN_EPI) { if (wr == 1) PG8_BAR; }
    }
    PG8_WAIT_V(0);
    if constexpr (!ALIGN_EPI) { if (wr == 0) PG8_BAR; }
    PG8_BAR;
    if constexpr (Epi::AFTER_DRAIN) { E.fused(acc, cur, wr, wc, fr, fq, lds, wid, lane); S.done(cur); }
#undef PG8_SA
#undef PG8_SB
#undef PG8_STAGE
#undef PG8_LDA
#undef PG8_LDB
#undef PG8_MMA
#undef PG8_WAIT_V
#undef PG8_WAIT_L
#undef PG8_BAR
#undef PG8_SCHED
}
}

constexpr int NWAVES = 8, NTHR = 512;
constexpr int D = 1024, NB = 16, SEQ = 2048, LCTX = 256;
constexpr int RC = NB * LCTX;
constexpr int RL = NB * SEQ;
constexpr int RT = RC + RL;
constexpr int NZ = 3584;
constexpr int NUNIT = (RT / 64) * 8;
constexpr float EPS = 1e-6f;

constexpr size_t MiB = 1u << 20;
constexpr size_t WS_CTL = 0, CTL_ZERO_BYTES = 1 * MiB;
constexpr size_t WS_MOD = 1 * MiB;
constexpr size_t WS_TAB = 2 * MiB;
constexpr size_t WS_COS = WS_TAB, WS_SIN = WS_TAB + 4096, WS_WAB = WS_TAB + 65536  , WS_WR = WS_TAB + 131072  , WS_TILE = WS_TAB + 131072 + 393216  ;
constexpr size_t WS_LA = 3 * MiB, WS_BT = 5 * MiB;
constexpr size_t WS_WIN0 = 8 * MiB, WS_WOUT0 = 15 * MiB, WS_WIN1 = 17 * MiB, WS_WOUT1 = 20 * MiB;
constexpr size_t WS_HCTX = 22 * MiB;
constexpr size_t WS_AB = 38 * MiB;
constexpr size_t WS_ASG = 41 * MiB;
constexpr size_t WS_ROWSE = 540 * MiB;
constexpr size_t WS_GL = 43 * MiB;
constexpr size_t WS_GE = 44 * MiB;
constexpr size_t WS_WUP = 48 * MiB, WS_WDN = 112 * MiB;
constexpr size_t WS_A = 144 * MiB;
constexpr size_t WS_Z = 216 * MiB;
constexpr size_t WS_U = 144 * MiB, WS_W = 216 * MiB, WS_QD = 288 * MiB, WS_KD = 360 * MiB, WS_QK = 432 * MiB;
constexpr size_t WS_Y = 380 * MiB;
constexpr size_t WS_MIX = 468 * MiB;
constexpr size_t WS_XG = 216 * MiB, WS_HG = 376 * MiB, WS_YG = 216 * MiB;
constexpr size_t WS_Q1 = 216 * MiB, WS_K1 = 280 * MiB, WS_V1 = 298 * MiB, WS_O1 = 316 * MiB;
constexpr size_t WS_END = 545 * MiB;
constexpr int CW_TMO = 0, CW_BAR = 4096, CW_CNT = 8192;

constexpr int RING_OFF = 0, RING_BYTES = 131072;
constexpr int LDS_BYTES = 163840;
constexpr int LDSCTL_OFF = LDS_BYTES - 128, MISC_OFF = LDSCTL_OFF;

#define GAS __attribute__((address_space(1)))
#define LAS __attribute__((address_space(3)))
typedef unsigned short bf16;
typedef unsigned u32x4 __attribute__((ext_vector_type(4)));
typedef unsigned u32x2 __attribute__((ext_vector_type(2)));
typedef float f32x4 __attribute__((ext_vector_type(4)));
typedef GAS unsigned gu32;
#define RLX_AGENT __ATOMIC_RELAXED, __HIP_MEMORY_SCOPE_AGENT
__device__ __forceinline__ unsigned f2bf(float f) { unsigned u = __builtin_bit_cast(unsigned, f); return (u + 0x7fffu + ((u >> 16) & 1u)) >> 16; }
__device__ __forceinline__ unsigned pk2(float lo, float hi) { return pg8::cvt_pk_bf16(lo, hi); }
__device__ __forceinline__ float bflo(unsigned w) { return __uint_as_float(w << 16); }
__device__ __forceinline__ float bfhi(unsigned w) { return __uint_as_float(w & 0xffff0000u); }
__device__ __forceinline__ float bf2f(bf16 v) { return __uint_as_float((unsigned)v << 16); }
__device__ __forceinline__ void unpack8(const u32x4 v, float (&f)[8]) { f[0] = bflo(v.x); f[1] = bfhi(v.x); f[2] = bflo(v.y); f[3] = bfhi(v.y); f[4] = bflo(v.z); f[5] = bfhi(v.z); f[6] = bflo(v.w); f[7] = bfhi(v.w); }
__device__ __forceinline__ u32x4 pack8(const float (&f)[8]) { u32x4 w; w.x = pk2(f[0], f[1]); w.y = pk2(f[2], f[3]); w.z = pk2(f[4], f[5]); w.w = pk2(f[6], f[7]); return w; }
template <int CTRL> __device__ __forceinline__ float dppf(float x) { return __builtin_bit_cast(float, __builtin_amdgcn_mov_dpp(__builtin_bit_cast(int, x), CTRL, 0xf, 0xf, true)); }
constexpr int DPP_XOR1 = 0xB1, DPP_XOR2 = 0x4E, DPP_HMIR = 0x141, DPP_ROR8 = 0x128, DPP_REV4 = 0x1B;
__device__ __forceinline__ float row16_sum(float x) { x += dppf<DPP_XOR1>(x); x += dppf<DPP_XOR2>(x); x += dppf<DPP_HMIR>(x); x += dppf<DPP_ROR8>(x); return x; }
__device__ __forceinline__ float row16_max(float x) { x = fmaxf(x, dppf<DPP_XOR1>(x)); x = fmaxf(x, dppf<DPP_XOR2>(x)); x = fmaxf(x, dppf<DPP_HMIR>(x)); x = fmaxf(x, dppf<DPP_ROR8>(x)); return x; }
__device__ __forceinline__ float xor16_sum(float x) { auto s = __builtin_amdgcn_permlane16_swap(__float_as_uint(x), __float_as_uint(x), false, false); return __uint_as_float(s[0]) + __uint_as_float(s[1]); }
__device__ __forceinline__ float xor32_sum(float x) { auto s = __builtin_amdgcn_permlane32_swap(__float_as_uint(x), __float_as_uint(x), false, false); return __uint_as_float(s[0]) + __uint_as_float(s[1]); }
__device__ __forceinline__ float xor16_max(float x) { auto s = __builtin_amdgcn_permlane16_swap(__float_as_uint(x), __float_as_uint(x), false, false); return fmaxf(__uint_as_float(s[0]), __uint_as_float(s[1])); }
__device__ __forceinline__ float xor32_max(float x) { auto s = __builtin_amdgcn_permlane32_swap(__float_as_uint(x), __float_as_uint(x), false, false); return fmaxf(__uint_as_float(s[0]), __uint_as_float(s[1])); }
__device__ __forceinline__ float lane_xor16(float x, int lane) { auto s = __builtin_amdgcn_permlane16_swap(__float_as_uint(x), __float_as_uint(x), false, false); return __uint_as_float((lane & 16) ? s[0] : s[1]); }
__device__ __forceinline__ float lane_xor32(float x, int lane) { auto s = __builtin_amdgcn_permlane32_swap(__float_as_uint(x), __float_as_uint(x), false, false); return __uint_as_float((lane & 32) ? s[0] : s[1]); }
__device__ __forceinline__ float wave_sum(float v) { return xor32_sum(xor16_sum(row16_sum(v))); }
__device__ __forceinline__ float wave_max(float v) { return xor32_max(xor16_max(row16_max(v))); }
__device__ __forceinline__ float silu(float x) { return x * __builtin_amdgcn_rcpf(1.0f + __expf(-x)); }
__device__ __forceinline__ void row_info(int m, int& modrow, int& t, int& L) { if (m < RC) { modrow = 16; t = m & 255; L = LCTX; } else { const int mm = m - RC; modrow = mm >> 11; t = mm & 2047; L = SEQ; } }

#define XB_TMO      128
#define XB_XCNT(j)  (256  + 64 * (j))
#define XB_XSUB(j)  (1280 + 64 * (j))
#define XB_XGEN(j)  (2304 + 64 * (j))
#define XB_TOP      3328
#define XB_TOPGEN   3392
#define XCD_BAR_WORDS 3456
#define XB_SPIN_CAP (1u << 18)
__device__ __forceinline__ unsigned xb_ld(unsigned* p)              { return __hip_atomic_load(p, __ATOMIC_RELAXED, __HIP_MEMORY_SCOPE_AGENT); }
__device__ __forceinline__ unsigned xb_add(unsigned* p, unsigned v) { return __hip_atomic_fetch_add(p, v, __ATOMIC_RELAXED, __HIP_MEMORY_SCOPE_AGENT); }
__device__ __forceinline__ unsigned xb_xcc_id() { return (unsigned)__builtin_amdgcn_s_getreg((3 << 11) | 20) & 0xFu; }
#define XB_SPIN(cond, bar) do { unsigned _sp = 0; while (cond) { __builtin_amdgcn_s_sleep(1); \
    if ((++_sp & 255u) == 0u) { if (xb_ld(&(bar)[XB_TMO])) break; if (_sp > XB_SPIN_CAP) { atomicAdd(&(bar)[XB_TMO], 1u); break; } } } } while (0)
struct XcdBarrier { unsigned* bar; unsigned x; volatile LAS unsigned* st; };
__device__ __forceinline__ XcdBarrier xcd_barrier_post(unsigned* bar, volatile LAS unsigned* st) {
    XcdBarrier b; b.bar = bar; b.x = xb_xcc_id(); b.st = st;
    if (threadIdx.x == 0) (void)xb_add(&bar[XB_XCNT(b.x)], 1u);
    return b;
}
__device__ __forceinline__ void xcd_barrier_complete(unsigned* bar, unsigned x, unsigned& nloc, unsigned& nx) {
    const unsigned G = gridDim.x * gridDim.y * gridDim.z;
    unsigned sum, cnt, mine, sp = 0u;
    for (;;) {
        sum = 0u; cnt = 0u; mine = 0u;
#pragma unroll
        for (unsigned j = 0; j < 16; ++j) { const unsigned c = xb_ld(&bar[XB_XCNT(j)]); sum += c; cnt += (c > 0u) ? 1u : 0u; mine = (j == x) ? c : mine; }
        if (sum == G) break;
        __builtin_amdgcn_s_sleep(1);
        if ((++sp & 255u) == 0u) { if (xb_ld(&bar[XB_TMO])) break; if (sp > XB_SPIN_CAP) { atomicAdd(&bar[XB_TMO], 1u); break; } }
    }
    nloc = mine > 0u ? mine : 1u; nx = cnt > 0u ? cnt : 1u;
}
__device__ __forceinline__ void xcd_barrier(const XcdBarrier& b) {
    asm volatile("s_waitcnt vmcnt(0)" ::: "memory");
    __syncthreads();
    if (threadIdx.x == 0) {
        unsigned* bar = b.bar;
        __builtin_amdgcn_s_waitcnt(0);
        unsigned nloc = b.st[0], nx = b.st[1];
        if (nloc == 0u) { xcd_barrier_complete(bar, b.x, nloc, nx); b.st[0] = nloc; b.st[1] = nx; }
        const unsigned old = xb_add(&bar[XB_XSUB(b.x)], 1u);
        const unsigned gen = old / nloc;
        if (old + 1u == (gen + 1u) * nloc) {
            __builtin_amdgcn_fence(__ATOMIC_RELEASE, "agent");
            asm volatile("s_waitcnt vmcnt(0)" ::: "memory");
            const unsigned og = xb_add(&bar[XB_TOP], 1u);
            const unsigned tg = og / nx;
            if (og + 1u == (tg + 1u) * nx) xb_add(&bar[XB_TOPGEN], 1u);
            else XB_SPIN(xb_ld(&bar[XB_TOPGEN]) == tg, bar);
            __builtin_amdgcn_fence(__ATOMIC_ACQUIRE, "agent");
            xb_add(&bar[XB_XGEN(b.x)], 1u);
            asm volatile("s_waitcnt vmcnt(0)" ::: "memory");
        } else {
            XB_SPIN(xb_ld(&bar[XB_XGEN(b.x)]) == gen, bar);
            __builtin_amdgcn_fence(__ATOMIC_ACQUIRE, "agent");
            asm volatile("s_waitcnt vmcnt(0)" ::: "memory");
        }
    }
    __syncthreads();
}

struct Args {
    const float *x, *c, *ctx, *c_ctx, *ada_w, *ada_b, *norm_mix, *norm_ffn, *norm_final;
    const float *ab_w_in, *ab_conv_qkv, *ab_conv_sc, *ab_a_log, *ab_dt_bias, *ab_out_norm, *ab_w_out;
    const float *at_w_in, *at_sink, *at_w_out;
    const float *moe_w_group, *moe_w_expert, *moe_w1, *moe_w3, *moe_w2;
    float* out; unsigned char* ws;
    int ph_lo, ph_hi;
};
struct Ctx {
    LAS unsigned char* lds; int tid, lane, wave, G, bid, gw, ngw;
    int vcu;
};

__device__ __forceinline__ void transpose_item(const float* W, int ldw, int k0, int srccol, bf16* WT, int K, int dstrow0, bool il, LAS float* scr, int lane) {
    { float tv[32];
      const float* wp_ = W + (size_t)(k0 + (lane >> 5)) * ldw + srccol + (lane & 31);
#pragma unroll
      for (int i = 0; i < 32; ++i) tv[i] = wp_[(size_t)(2 * i) * ldw];
#pragma unroll
      for (int i = 0; i < 32; ++i) scr[(2 * i + (lane >> 5)) * 33 + (lane & 31)] = tv[i]; }
    asm volatile("s_waitcnt lgkmcnt(0)" ::: "memory");
    const int c = lane & 7;
#pragma unroll
    for (int j = 0; j < 4; ++j) { const int n = (lane >> 3) + 8 * j; const LAS float* s = scr + (8 * c) * 33 + n;
        u32x4 o; o.x = pk2(s[0 * 33], s[1 * 33]); o.y = pk2(s[2 * 33], s[3 * 33]); o.z = pk2(s[4 * 33], s[5 * 33]); o.w = pk2(s[6 * 33], s[7 * 33]);
        const int drow = dstrow0 + (il ? (8 * (n >> 2) + (n & 3)) : n);
        *(u32x4*)(WT + (size_t)drow * K + k0 + 8 * c) = o; }
    asm volatile("s_waitcnt lgkmcnt(0)" ::: "memory");
}
__device__ __forceinline__ void moe_convert(const Args& a, const Ctx& C, int l, int blk0) {
    LAS float* scr = (LAS float*)(C.lds + C.wave * 8448);
    bf16* WUP = (bf16*)(a.ws + WS_WUP); bf16* WDN = (bf16*)(a.ws + WS_WDN);
    if (C.bid < blk0) return;
    for (int it = (C.bid - blk0) * NWAVES + C.wave; it < 32 * 768; it += (C.G - blk0) * NWAVES) {
        const int e = it / 768, r = it % 768;
        if (r < 512) { const int rr = r & 255, kb = rr >> 4, nb = rr & 15; const float* src = (r < 256 ? a.moe_w1 : a.moe_w3) + (size_t)(l * 32 + e) * 1024 * 512;
            transpose_item(src, 512, 64 * kb, 32 * nb, WUP + (size_t)e * 1024 * 1024, 1024, 64 * nb + (r < 256 ? 0 : 4), true, scr, C.lane); }
        else { const int rr = r - 512, kb = rr >> 5, nb = rr & 31;
            transpose_item(a.moe_w2 + (size_t)(l * 32 + e) * 512 * 1024, 1024, 64 * kb, 32 * nb, WDN + (size_t)e * 1024 * 512, 512, 32 * nb, false, scr, C.lane); }
    }
}
__device__ __forceinline__ void norm_mod(const float* hrow, const float* nw, const float* shift, const float* scale, int lane, f32x4 (&v)[4]) {
    const f32x4* xr = (const f32x4*)hrow + lane; float s = 0.f;
#pragma unroll
    for (int j = 0; j < 4; ++j) { v[j] = xr[64 * j]; s += (v[j].x * v[j].x + v[j].y * v[j].y) + (v[j].z * v[j].z + v[j].w * v[j].w); }
    const float rstd = 1.0f / sqrtf(wave_sum(s) * (1.0f / D) + EPS);
#pragma unroll
    for (int j = 0; j < 4; ++j) { const f32x4 w = ((const f32x4*)nw)[lane + 64 * j], sc = ((const f32x4*)scale)[lane + 64 * j], sh = ((const f32x4*)shift)[lane + 64 * j];
        v[j] = v[j] * rstd * w * (sc + 1.0f) + sh; }
}
__device__ __forceinline__ void store_row_bf16(bf16* orow, int lane, const f32x4 (&v)[4]) {
    u32x2* o = (u32x2*)orow + lane;
#pragma unroll
    for (int j = 0; j < 4; ++j) { u32x2 w; w.x = pk2(v[j].x, v[j].y); w.y = pk2(v[j].z, v[j].w); o[64 * j] = w; }
}

__device__ __forceinline__ void phase_prologue(const Args& a, const Ctx& C) {
    LAS float* scr = (LAS float*)(C.lds + C.wave * 8448);
    bf16* WIN0 = (bf16*)(a.ws + WS_WIN0); bf16* WOUT0 = (bf16*)(a.ws + WS_WOUT0); bf16* WIN1 = (bf16*)(a.ws + WS_WIN1); bf16* WOUT1 = (bf16*)(a.ws + WS_WOUT1);
    for (int it0 = C.gw; it0 < 3584; it0 += C.ngw) {
        int it = it0;
        if (it < 1792) { const int kb = it / 112, nb = it % 112, n0 = 32 * nb; transpose_item(a.ab_w_in, 3600, 64 * kb, n0 < 2048 ? n0 : n0 + 16, WIN0, 1024, n0, false, scr, C.lane); continue; } it -= 1792;
        if (it < 512) { const int kb = it >> 5, nb = it & 31; transpose_item(a.ab_w_out, 1024, 64 * kb, 32 * nb, WOUT0, 1024, 32 * nb, false, scr, C.lane); continue; } it -= 512;
        if (it < 768) { const int kb = it / 48, nb = it % 48; transpose_item(a.at_w_in, 1536, 64 * kb, 32 * nb, WIN1, 1024, 32 * nb, false, scr, C.lane); continue; } it -= 768;
        { const int kb = it >> 5, nb = it & 31; transpose_item(a.at_w_out, 1024, 64 * kb, 32 * nb, WOUT1, 1024, 32 * nb, false, scr, C.lane); }
    }
    const int gt = C.bid * NTHR + C.tid, ngt = C.G * NTHR;
    float* ctab = (float*)(a.ws + WS_COS); float* stab = (float*)(a.ws + WS_SIN); float* wab = (float*)(a.ws + WS_WAB); float* wr = (float*)(a.ws + WS_WR);
    for (int i = gt; i < 1024; i += ngt) { const int pos = i >> 4, f = i & 15; const float inv = powf(10000.0f, -(float)f / 16.0f); const float ang = (float)pos * inv; ctab[i] = cosf(ang); stab[i] = sinf(ang); }
    for (int i = gt; i < 16384; i += ngt) { const int j = i >> 10, k = i & 1023; wab[i] = a.ab_w_in[(size_t)k * 3600 + 2048 + j]; }
    for (int i = gt; i < 2 * 49152; i += ngt) { const int l = i / 49152, r = i % 49152, k = r / 48, cc = r % 48;
        wr[i] = cc < 4 ? a.moe_w_group[(size_t)(l * 1024 + k) * 4 + cc] : (cc < 36 ? a.moe_w_expert[(size_t)(l * 1024 + k) * 32 + cc - 4] : 0.f); }
    __syncthreads();
    typedef float f32x16p __attribute__((ext_vector_type(16)));
    LAS float* sc = (LAS float*)C.lds;
    LAS float* red = (LAS float*)(C.lds + 70144);
    float* MOD = (float*)(a.ws + WS_MOD);
    if (C.bid < 192) {
        { f32x4 cv[9];
#pragma unroll
          for (int u = 0; u < 9; ++u) { const int i4 = C.tid + NTHR * u; cv[u] = i4 < 4096 ? ((const f32x4*)a.c)[i4] : (i4 < 4352 ? ((const f32x4*)a.c_ctx)[i4 - 4096] : (f32x4){0.f, 0.f, 0.f, 0.f}); }
#pragma unroll
          for (int u = 0; u < 9; ++u) { const int i4 = C.tid + NTHR * u; if (i4 < 4352) *(LAS f32x4*)(sc + (i4 >> 8) * 1028 + 4 * (i4 & 255)) = (f32x4){silu(cv[u].x), silu(cv[u].y), silu(cv[u].z), silu(cv[u].w)}; } }
        __syncthreads();
        for (int item = C.bid; item < 192; item += C.G) {
            const int l = item / 96, cg = item % 96, ks = C.wave, n = C.lane & 31, kh = C.lane >> 5, mrow = n < 17 ? n : 16;
            const float* wp = a.ada_w + (size_t)l * 1024 * 6144 + (size_t)(128 * ks + 64 * kh) * 6144 + cg * 64 + n;
            const LAS float* ap = sc + mrow * 1028 + 128 * ks + 64 * kh;
            f32x16p acc0, acc1;
#pragma unroll
            for (int i = 0; i < 16; ++i) { acc0[i] = 0.f; acc1[i] = 0.f; }
#pragma unroll 1
            for (int hs = 0; hs < 64; hs += 16) {
                float b0[16], b1[16]; f32x4 av[4];
#pragma unroll
                for (int u = 0; u < 16; ++u) { b0[u] = wp[(size_t)(hs + u) * 6144]; b1[u] = wp[(size_t)(hs + u) * 6144 + 32]; }
#pragma unroll
                for (int j = 0; j < 4; ++j) av[j] = *(const LAS f32x4*)(ap + hs + 4 * j);
#pragma unroll
                for (int u = 0; u < 16; ++u) { acc0 = __builtin_amdgcn_mfma_f32_32x32x2f32(av[u >> 2][u & 3], b0[u], acc0, 0, 0, 0); acc1 = __builtin_amdgcn_mfma_f32_32x32x2f32(av[u >> 2][u & 3], b1[u], acc1, 0, 0, 0); }
            }
#pragma unroll
            for (int i = 0; i < 16; ++i) { const int row = 8 * (i >> 2) + 4 * kh + (i & 3); if (row < 17) { red[(ks * 17 + row) * 64 + n] = acc0[i]; red[(ks * 17 + row) * 64 + 32 + n] = acc1[i]; } }
            __syncthreads();
            for (int i = C.tid; i < 17 * 64; i += NTHR) { const int r = i >> 6, cc = i & 63; float s = 0.f;
#pragma unroll
                for (int q = 0; q < 8; ++q) s += red[(q * 17 + r) * 64 + cc];
                MOD[(size_t)(l * 17 + r) * 6144 + cg * 64 + cc] = s + a.ada_b[l * 6144 + cg * 64 + cc]; }
            __syncthreads();
        }
    }
}
__device__ __forceinline__ float reduce16(float (&p)[16], int lane) {
    float q8[8], q4[4], q2[2];
#pragma unroll
    for (int i = 0; i < 8; ++i) { const bool up = lane & 32; const float keep = up ? p[i + 8] : p[i], send = up ? p[i] : p[i + 8]; q8[i] = keep + lane_xor32(send, lane); }
#pragma unroll
    for (int i = 0; i < 4; ++i) { const bool up = lane & 16; const float keep = up ? q8[i + 4] : q8[i], send = up ? q8[i] : q8[i + 4]; q4[i] = keep + lane_xor16(send, lane); }
#pragma unroll
    for (int i = 0; i < 2; ++i) { const bool up = lane & 8; const float keep = up ? q4[i + 2] : q4[i], send = up ? q4[i] : q4[i + 2]; q2[i] = keep + dppf<DPP_ROR8>(send); }
    float r; { const bool up = lane & 4; const float keep = up ? q2[1] : q2[0], send = up ? q2[0] : q2[1]; r = keep + dppf<DPP_REV4>(dppf<DPP_HMIR>(send)); }
    r += dppf<DPP_XOR2>(r); r += dppf<DPP_XOR1>(r);
    return r;
}
__device__ __forceinline__ void phase_norm0(const Args& a, const Ctx& C) {
    LAS float* wab = (LAS float*)C.lds;
    const float* gw_ = (const float*)(a.ws + WS_WAB);
    for (int i = C.tid; i < 16384; i += NTHR) wab[i] = gw_[i];
    __syncthreads();
    const float* MOD = (const float*)(a.ws + WS_MOD); bf16* A = (bf16*)(a.ws + WS_A); float* AB = (float*)(a.ws + WS_AB);
    const int per = (RT + C.ngw - 1) / C.ngw, mbeg = C.gw * per, mend = mbeg + per < RT ? mbeg + per : RT;
    if (mbeg >= mend) return;
    f32x4 nwv[4], scv[4], shv[4], raw[2][4]; int curmod = -1;
#pragma unroll
    for (int j = 0; j < 4; ++j) nwv[j] = ((const f32x4*)a.norm_mix)[C.lane + 64 * j];
#define N0_LOAD(k_, m_) do { const int mc_ = (m_) < mend ? (m_) : mend - 1; const float* src_ = mc_ < RC ? a.ctx + (size_t)mc_ * D : a.x + (size_t)(mc_ - RC) * D; \
        _Pragma("unroll") for (int j_ = 0; j_ < 4; ++j_) raw[k_][j_] = ((const f32x4*)src_)[C.lane + 64 * j_]; } while (0)
    N0_LOAD(0, mbeg); N0_LOAD(1, mbeg + 1);
    for (int mp = mbeg; mp < mend; mp += 2) {
        asm volatile("" ::: "memory");
        f32x4 v[2][4];
#pragma unroll
        for (int k = 0; k < 2; ++k) { const int m = mp + k < mend ? mp + k : mend - 1; int modrow, t, L; row_info(m, modrow, t, L);
            if (modrow != curmod) { curmod = modrow; const float* md = MOD + (size_t)modrow * 6144;
#pragma unroll
                for (int j = 0; j < 4; ++j) { shv[j] = ((const f32x4*)md)[C.lane + 64 * j]; scv[j] = ((const f32x4*)(md + 1024))[C.lane + 64 * j]; } }
            float ss = 0.f;
#pragma unroll
            for (int j = 0; j < 4; ++j) { v[k][j] = raw[k][j]; ss += (v[k][j].x * v[k][j].x + v[k][j].y * v[k][j].y) + (v[k][j].z * v[k][j].z + v[k][j].w * v[k][j].w); }
            N0_LOAD(k, mp + 2 + k);
            const float rstd = 1.0f / sqrtf(wave_sum(ss) * (1.0f / D) + EPS);
#pragma unroll
            for (int j = 0; j < 4; ++j) v[k][j] = v[k][j] * rstd * nwv[j] * (scv[j] + 1.0f) + shv[j];
            if (mp + k < mend) store_row_bf16(A + (size_t)m * D, C.lane, v[k]); }
        float p0[16], p1[16];
#pragma unroll
        for (int q = 0; q < 16; ++q) { float s0 = 0.f, s1 = 0.f;
#pragma unroll
            for (int j = 0; j < 4; ++j) { const f32x4 w = *(const LAS f32x4*)(wab + q * 1024 + 4 * C.lane + 256 * j);
                s0 += (v[0][j].x * w.x + v[0][j].y * w.y) + (v[0][j].z * w.z + v[0][j].w * w.w); s1 += (v[1][j].x * w.x + v[1][j].y * w.y) + (v[1][j].z * w.z + v[1][j].w * w.w); }
            p0[q] = s0; p1[q] = s1; }
        const float r0 = reduce16(p0, C.lane), r1 = reduce16(p1, C.lane);
        if ((C.lane & 3) == 0) { const int idx = ((C.lane >> 5) & 1) * 8 + ((C.lane >> 4) & 1) * 4 + ((C.lane >> 3) & 1) * 2 + ((C.lane >> 2) & 1);
            AB[(size_t)mp * 16 + idx] = r0; if (mp + 1 < mend) AB[(size_t)(mp + 1) * 16 + idx] = r1; }
    }
#undef N0_LOAD
}
__device__ __forceinline__ void phase_conv(const Args& a, const Ctx& C) {
    const bf16* Z = (const bf16*)(a.ws + WS_Z); bf16* QKV = (bf16*)a.out; bf16* MIX = (bf16*)(a.ws + WS_MIX);
    const float* AB = (const float*)(a.ws + WS_AB); float* LA = (float*)(a.ws + WS_LA); float* BT = (float*)(a.ws + WS_BT);
    const u32x4 zero4 = (u32x4){0u, 0u, 0u, 0u};
    const int lane = C.lane;
    for (int task = C.gw; task < (RT / 32) * 5; task += C.ngw) {
        const int strip = task / 5, sl = task % 5, m0 = strip * 32;
        int modrow, t0, L; row_info(m0, modrow, t0, L);
        if (sl == 3) {
            float abv[8];
#pragma unroll
            for (int u = 0; u < 8; ++u) abv[u] = AB[(size_t)m0 * 16 + lane + 64 * u];
            const float dtb = a.ab_dt_bias[lane & 7], alg = a.ab_a_log[lane & 7];
            for (int rb = 0; rb < 32; rb += 8) { u32x4 gg[8];
#pragma unroll
                for (int u = 0; u < 8; ++u) gg[u] = *(const u32x4*)(Z + (size_t)(m0 + rb + u) * NZ + 1536 + lane * 8);
#pragma unroll
                for (int u = 0; u < 8; ++u) { float g[8], y[8]; unpack8(gg[u], g);
#pragma unroll
                    for (int e = 0; e < 8; ++e) y[e] = silu(g[e]);
                    *(u32x4*)(MIX + (size_t)(m0 + rb + u) * D + lane * 8) = pack8(y); } }
#pragma unroll
            for (int u = 0; u < 8; ++u) { const int i = lane + 64 * u, m = m0 + (i >> 4), c = i & 15; const float xx = abv[u];
                if (c < 8) { const float x2 = xx + dtb; const float sp = x2 > 20.f ? x2 : log1pf(expf(x2)); LA[(size_t)m * 8 + c] = -expf(alg) * sp; }
                else BT[(size_t)m * 8 + c - 8] = 1.0f / (1.0f + expf(-xx)); }
            continue;
        }
        if (sl < 3) {
            const int col = sl * 512 + lane * 8; float w0[8], w1[8], w2[8];
#pragma unroll
            for (int e = 0; e < 8; ++e) { w0[e] = a.ab_conv_qkv[col + e]; w1[e] = a.ab_conv_qkv[1536 + col + e]; w2[e] = a.ab_conv_qkv[3072 + col + e]; }
            const bf16* zp = Z + (size_t)m0 * NZ + col;
            u32x4 prev = t0 > 0 ? *(const u32x4*)(zp - NZ) : zero4, cur = *(const u32x4*)zp;
            u32x4 nb[2][8];
#define CV_LOAD(set, rb_) do { _Pragma("unroll") for (int u_ = 0; u_ < 8; ++u_) { const bool in_ = t0 + (rb_) + u_ + 1 < L; nb[set][u_] = *(const u32x4*)(zp + (size_t)(in_ ? (rb_) + u_ + 1 : (rb_) + u_) * NZ); } } while (0)
#define CV_ROWS(set, rb_) do { _Pragma("unroll") for (int u_ = 0; u_ < 8; ++u_) { const bool in_ = t0 + (rb_) + u_ + 1 < L; const u32x4 nxt_ = in_ ? nb[set][u_] : zero4; \
                float fa[8], fc[8], fb[8], y[8]; unpack8(prev, fa); unpack8(cur, fc); unpack8(nxt_, fb); \
                float ss = 0.f; \
                _Pragma("unroll") for (int e = 0; e < 8; ++e) { const float s_ = fa[e] * w0[e] + fc[e] * w1[e] + fb[e] * w2[e]; y[e] = silu(s_); ss += y[e] * y[e]; } \
                if (sl < 2) { ss = row16_sum(ss); \
                    const float sc_ = __builtin_amdgcn_rsqf(ss + EPS) * (sl == 0 ? 0.08838834764831845f : 1.0f); \
                    _Pragma("unroll") for (int e = 0; e < 8; ++e) y[e] *= sc_; } \
                *(u32x4*)(QKV + (size_t)(m0 + (rb_) + u_) * 1536 + col) = pack8(y); \
                prev = cur; cur = nxt_; } } while (0)
            CV_LOAD(0, 0);
            CV_LOAD(1, 8);  CV_ROWS(0, 0);
            CV_LOAD(0, 16); CV_ROWS(1, 8);
            CV_LOAD(1, 24); CV_ROWS(0, 16);
            CV_ROWS(1, 24);
#undef CV_LOAD
#undef CV_ROWS
        } else {
            const int col = lane * 8; float w0[8], w1[8], w2[8];
#pragma unroll
            for (int e = 0; e < 8; ++e) { w0[e] = a.ab_conv_sc[col + e]; w1[e] = a.ab_conv_sc[512 + col + e]; w2[e] = a.ab_conv_sc[1024 + col + e]; }
            const bf16* zp = Z + (size_t)m0 * NZ + col;
            float pp[8], pc[8];
            { float c_[8], h_[8];
              if (t0 > 0) { unpack8(*(const u32x4*)(zp - NZ + 2560), c_); unpack8(*(const u32x4*)(zp - NZ + 3072), h_);
#pragma unroll
                  for (int e = 0; e < 8; ++e) pp[e] = c_[e] * h_[e]; }
              else {
#pragma unroll
                  for (int e = 0; e < 8; ++e) pp[e] = 0.f; }
              unpack8(*(const u32x4*)(zp + 2560), c_); unpack8(*(const u32x4*)(zp + 3072), h_);
#pragma unroll
              for (int e = 0; e < 8; ++e) pc[e] = c_[e] * h_[e]; }
            for (int rb = 0; rb < 32; rb += 4) { u32x4 lc[4], lh[4], lgt[4];
#pragma unroll
                for (int u = 0; u < 4; ++u) { const bool in = t0 + rb + u + 1 < L; const size_t ro = (size_t)(in ? rb + u + 1 : rb + u) * NZ;
                    lc[u] = *(const u32x4*)(zp + ro + 2560); lh[u] = *(const u32x4*)(zp + ro + 3072); lgt[u] = *(const u32x4*)(zp + (size_t)(rb + u) * NZ + 2048); }
#pragma unroll
                for (int u = 0; u < 4; ++u) { float c_[8], h_[8], bg[8], y[8], pn[8]; const bool in = t0 + rb + u + 1 < L;
                    unpack8(lc[u], c_); unpack8(lh[u], h_); unpack8(lgt[u], bg);
#pragma unroll
                    for (int e = 0; e < 8; ++e) { pn[e] = in ? c_[e] * h_[e] : 0.f; y[e] = bg[e] * (pp[e] * w0[e] + pc[e] * w1[e] + pn[e] * w2[e]); pp[e] = pc[e]; pc[e] = pn[e]; }
                    *(u32x4*)(MIX + (size_t)(m0 + rb + u) * D + 512 + col) = pack8(y); } }
        }
    }
}
__device__ __forceinline__ void phase_dn_combine(const Args& a, const Ctx& C) {
    const bf16* OF = (const bf16*)(a.ws + WS_QD); const bf16* OB = OF + (size_t)RT * 512; bf16* MIX = (bf16*)(a.ws + WS_MIX);
    float on[8];
#pragma unroll
    for (int e = 0; e < 8; ++e) on[e] = a.ab_out_norm[(C.lane & 15) * 8 + e];
    for (int mb = C.gw; mb < RT; mb += 2 * C.ngw) {
      u32x4 lf[2], lb[2], lg[2];
#pragma unroll
      for (int k = 0; k < 2; ++k) { const int m = (mb + k * C.ngw < RT) ? mb + k * C.ngw : mb; lf[k] = *(const u32x4*)(OF + (size_t)m * 512 + C.lane * 8); lb[k] = *(const u32x4*)(OB + (size_t)m * 512 + C.lane * 8); lg[k] = *(const u32x4*)(MIX + (size_t)m * D + C.lane * 8); }
#pragma unroll
      for (int k = 0; k < 2; ++k) { const int m = mb + k * C.ngw; if (m >= RT) continue;
        float f[8], b[8], g[8], y[8]; unpack8(lf[k], f); unpack8(lb[k], b); unpack8(lg[k], g);
        float ss = 0.f;
#pragma unroll
        for (int e = 0; e < 8; ++e) { f[e] += b[e]; ss += f[e] * f[e]; }
        ss = row16_sum(ss);
        const float rstd = 1.0f / sqrtf(ss * (1.0f / 128.0f) + EPS);
#pragma unroll
        for (int e = 0; e < 8; ++e) y[e] = f[e] * rstd * on[e] * g[e];
        *(u32x4*)(MIX + (size_t)m * D + C.lane * 8) = pack8(y);
      }
    }
}
typedef float f32x4v __attribute__((ext_vector_type(4)));
__device__ __forceinline__ void phase_ffn_norm_route(const Args& a, const Ctx& C, int l) {
    LAS float* fsb = (LAS float*)C.lds;
    LAS float* redb = (LAS float*)(C.lds + 131584);
    LAS float* lgw = (LAS float*)(C.lds + 156160);
    LAS int* le = (LAS int*)(C.lds + 159232);
    LAS int* lr = le + 320;
    LAS int* hist = lr + 320;
    LAS int* base = hist + 32;
    const float* MOD = (const float*)(a.ws + WS_MOD) + (size_t)l * 17 * 6144;
    const float* wr = (const float*)(a.ws + WS_WR) + (size_t)l * 49152;
    const float* nw = a.norm_ffn + l * D;
    float* hctx = (float*)(a.ws + WS_HCTX); bf16* F = (bf16*)(a.ws + WS_A); int* ASG = (int*)(a.ws + WS_ASG);
    unsigned* cnt = (unsigned*)(a.ws + WS_CTL) + CW_CNT + 64 * l;
    if (C.tid < 32) hist[C.tid] = 0;
    const int g0 = l == 0 ? 0 : RC / 16, ngroups = RT / 16;
    const int gper = (ngroups - g0 + C.G - 1) / C.G, gfirst = g0 + C.bid * gper;
    const int n = gfirst < ngroups ? (ngroups - gfirst < gper ? ngroups - gfirst : gper) : 0;
    __syncthreads();
    if (C.wave >= 4) {
        const int rw = C.wave - 4;
        f32x4 pr[4][4]; u32x2 py[4][4];
        f32x4 mg[4], msc[4], msh[4], nwv[4];
#pragma unroll
        for (int j = 0; j < 4; ++j) nwv[j] = ((const f32x4*)nw)[C.lane + 64 * j];
        int curmod = -1;
#define P8_LOAD(g_) do { { int mr_, t_, L_; row_info((g_) * 16, mr_, t_, L_); if (mr_ != curmod) { curmod = mr_; const float* md_ = MOD + (size_t)mr_ * 6144; \
        _Pragma("unroll") for (int j_ = 0; j_ < 4; ++j_) { mg[j_] = ((const f32x4*)(md_ + 2048))[C.lane + 64 * j_]; msc[j_] = ((const f32x4*)(md_ + 4096))[C.lane + 64 * j_]; msh[j_] = ((const f32x4*)(md_ + 3072))[C.lane + 64 * j_]; } } } \
        _Pragma("unroll") for (int q_ = 0; q_ < 4; ++q_) { const int m_ = (g_) * 16 + 4 * rw + q_; \
        const float* rsd_ = l == 0 ? (m_ < RC ? a.ctx + (size_t)m_ * D : a.x + (size_t)(m_ - RC) * D) : a.out + (size_t)(m_ - RC) * D; \
        const bf16* yrow_ = (const bf16*)(a.ws + WS_Y) + (size_t)(l == 0 ? m_ : m_ - RC) * D; \
        _Pragma("unroll") for (int j_ = 0; j_ < 4; ++j_) { pr[q_][j_] = ((const f32x4*)rsd_)[C.lane + 64 * j_]; py[q_][j_] = ((const u32x2*)yrow_)[C.lane + 64 * j_]; } } } while (0)
        if (n > 0) P8_LOAD(gfirst);
        for (int i = 0; i < n + 2; ++i) {
            if (i < n) { const int g = gfirst + i; LAS float* fs = fsb + (i & 1) * (16 * 1028);
#pragma unroll
                for (int q = 0; q < 4; ++q) { const int r = 4 * rw + q, m = g * 16 + r; int modrow, t, L; row_info(m, modrow, t, L);
                    float* hdst = m < RC ? (float*)hctx + (size_t)m * D : a.out + (size_t)(m - RC) * D;
                    f32x4 v[4]; float ss = 0.f;
#pragma unroll
                    for (int j = 0; j < 4; ++j) { const f32x4 r4 = pr[q][j], g4 = mg[j]; const u32x2 yy = py[q][j];
                        v[j] = r4 + g4 * (f32x4){bflo(yy.x), bfhi(yy.x), bflo(yy.y), bfhi(yy.y)}; ((f32x4*)hdst)[C.lane + 64 * j] = v[j];
                        ss += (v[j].x * v[j].x + v[j].y * v[j].y) + (v[j].z * v[j].z + v[j].w * v[j].w); }
                    { const float rstd = 1.0f / sqrtf(wave_sum(ss) * (1.0f / D) + EPS);
#pragma unroll
                      for (int j = 0; j < 4; ++j) v[j] = v[j] * rstd * nwv[j] * (msc[j] + 1.0f) + msh[j]; }
                    store_row_bf16(F + (size_t)m * D, C.lane, v);
#pragma unroll
                    for (int j = 0; j < 4; ++j) *(LAS f32x4*)(fs + r * 1028 + 4 * C.lane + 256 * j) = v[j]; }
                if (i + 1 < n) P8_LOAD(g + 1);
            }
            __syncthreads();
        }
#undef P8_LOAD
    } else {
        int ln_ = C.lane; asm volatile("" : "+v"(ln_));
        const int kk = ln_ >> 4, rr = ln_ & 15, w = C.wave;
        float Bf[3][64];
#pragma unroll
        for (int ct = 0; ct < 3; ++ct)
#pragma unroll
            for (int s = 0; s < 64; ++s) Bf[ct][s] = wr[(size_t)(256 * w + 64 * kk + s) * 48 + 16 * ct + rr];
        for (int i = 0; i < n + 2; ++i) {
            if (i >= 2) {
                const int gi = i - 2, g = gfirst + gi; const LAS float* red = redb + (gi & 1) * (4 * 16 * 48);
                { const int r4 = ln_ >> 4, c = ln_ & 15;
#pragma unroll
                  for (int ct = 0; ct < 3; ++ct) { const int col = 16 * ct + c; float sum = 0.f;
#pragma unroll
                      for (int w2 = 0; w2 < 4; ++w2) sum += red[(w2 * 16 + 4 * w + r4) * 48 + col];
                      lgw[(w * 4 + r4) * 48 + col] = sum; } }
                asm volatile("s_waitcnt lgkmcnt(0)" ::: "memory");
                if (ln_ < 4) { const int r = 4 * w + ln_, m = g * 16 + r; const LAS float* lp = lgw + (w * 4 + ln_) * 48;
                    int gs = 0; float gm = lp[0];
#pragma unroll
                    for (int i2 = 1; i2 < 4; ++i2) if (lp[i2] > gm) { gm = lp[i2]; gs = i2; }
                    float gsum = 0.f;
#pragma unroll
                    for (int i2 = 0; i2 < 4; ++i2) gsum += expf(lp[i2] - gm);
                    const float pg = 1.0f / gsum;
                    const LAS float* ep = lp + 4 + gs * 8; float em = ep[0];
#pragma unroll
                    for (int i2 = 1; i2 < 8; ++i2) em = fmaxf(em, ep[i2]);
                    float pe[8], esum = 0.f;
#pragma unroll
                    for (int i2 = 0; i2 < 8; ++i2) { pe[i2] = expf(ep[i2] - em); esum += pe[i2]; }
                    int t0 = 0; float p0 = pe[0] / esum;
                    float pn[8];
#pragma unroll
                    for (int i2 = 0; i2 < 8; ++i2) pn[i2] = pe[i2] / esum;
#pragma unroll
                    for (int i2 = 1; i2 < 8; ++i2) if (pn[i2] > p0) { p0 = pn[i2]; t0 = i2; }
                    int t1 = -1; float p1 = -1.f;
#pragma unroll
                    for (int i2 = 0; i2 < 8; ++i2) if (i2 != t0 && pn[i2] > p1) { p1 = pn[i2]; t1 = i2; }
                    if (t1 < 0) t1 = (t0 == 0) ? 1 : 0;
                    const float w0 = pg * p0 / (p0 + p1), w1 = pg * p1 / (p0 + p1);
                    const int e0 = gs * 8 + t0, e1 = gs * 8 + t1;
                    const int r0 = atomicAdd((int*)&hist[e0], 1), r1 = atomicAdd((int*)&hist[e1], 1);
                    le[(gi * 16 + r) * 2] = e0; le[(gi * 16 + r) * 2 + 1] = e1; lr[(gi * 16 + r) * 2] = r0; lr[(gi * 16 + r) * 2 + 1] = r1;
                    int* ag = ASG + (size_t)m * 8; ag[0] = e0; ag[1] = e1; ag[4] = __float_as_int(w0); ag[5] = __float_as_int(w1);
                }
            }
            if (i >= 1 && i <= n) {
                const int gi = i - 1; const LAS float* fs = fsb + (gi & 1) * (16 * 1028); LAS float* red = redb + (gi & 1) * (4 * 16 * 48);
                f32x4v acc[3];
#pragma unroll
                for (int ct = 0; ct < 3; ++ct) acc[ct] = (f32x4v){0.f, 0.f, 0.f, 0.f};
                const LAS float* ab = fs + rr * 1028 + 256 * w + 64 * kk;
#pragma unroll
                for (int s4 = 0; s4 < 16; ++s4) { const f32x4 a4 = *(const LAS f32x4*)(ab + 4 * s4);
#pragma unroll
                    for (int e = 0; e < 4; ++e)
#pragma unroll
                        for (int ct = 0; ct < 3; ++ct) acc[ct] = __builtin_amdgcn_mfma_f32_16x16x4f32(a4[e], Bf[ct][4 * s4 + e], acc[ct], 0, 0, 0); }
#pragma unroll
                for (int ct = 0; ct < 3; ++ct)
#pragma unroll
                    for (int q = 0; q < 4; ++q) red[(w * 16 + 4 * kk + q) * 48 + 16 * ct + rr] = acc[ct][q];
            }
            __syncthreads();
        }
    }
    const int li = n;
    __syncthreads();
    if (C.tid < 32) base[C.tid] = (int)__hip_atomic_fetch_add(cnt + C.tid, (unsigned)hist[C.tid], RLX_AGENT);
    __syncthreads();
    int* ROWSE = (int*)(a.ws + WS_ROWSE);
    for (int i = C.tid; i < li * 16; i += NTHR) { const int gi = i >> 4, r = i & 15, m = (gfirst + gi) * 16 + r; int* ag = ASG + (size_t)m * 8;
        const int e0 = le[i * 2], e1 = le[i * 2 + 1], p0 = base[e0] + lr[i * 2], p1 = base[e1] + lr[i * 2 + 1];
        ag[2] = p0; ag[3] = p1; ROWSE[(size_t)e0 * RT + p0] = m; ROWSE[(size_t)e1 * RT + p1] = m; }
}
__device__ __forceinline__ int moe_tables(const Args& a, const Ctx& C, int l, int tabofs) {
    LAS int* tab = (LAS int*)(C.lds + tabofs);
    const unsigned* cnt = (const unsigned*)(a.ws + WS_CTL) + CW_CNT + 64 * l;
    if (C.tid < 32) tab[C.tid] = (int)cnt[C.tid];
    __syncthreads();
    if (C.tid == 0) { int acc = 0; for (int e = 0; e < 32; ++e) { const int c = tab[e]; tab[32 + e] = acc; acc += (c + 255) & ~255; } tab[64] = acc; }
    __syncthreads();
    const int nT = tab[64] >> 8;
    for (int ti = C.tid; ti < nT; ti += NTHR) { int e = 0; for (int q = 0; q < 32; ++q) if (tab[32 + q] <= ti * 256 && ti * 256 < tab[32 + q] + ((tab[q] + 255) & ~255)) e = q; tab[128 + ti] = e; }
    __syncthreads();
    return nT;
}
struct CombAsg { int e0, e1, p0, p1, w0, w1; };
__device__ __forceinline__ void phase_moe_combine(const Args& a, const Ctx& C, int l) {
    const float* MOD = (const float*)(a.ws + WS_MOD); const bf16* YG = (const bf16*)(a.ws + WS_YG); const int* ASG = (const int*)(a.ws + WS_ASG);
    float* hctx = (float*)(a.ws + WS_HCTX); bf16* A = (bf16*)(a.ws + WS_A);
    const int m0 = l == 0 ? 0 : RC;
    (void)moe_tables(a, C, l, 0); const LAS int* tab = (const LAS int*)C.lds;
    const int per = (RT - m0 + C.ngw - 1) / C.ngw, mbeg = m0 + C.gw * per, mend = mbeg + per < RT ? mbeg + per : RT;
    if (mbeg >= mend) return;
    f32x4 g2v[4], nwv[4], scv[4], shv[4]; int curmod = -1;
#pragma unroll
    for (int j = 0; j < 4; ++j) nwv[j] = ((const f32x4*)(l == 0 ? a.norm_mix + D : a.norm_final))[C.lane + 64 * j];
    u32x2 y0[2][4], y1[2][4]; f32x4 hv[2][4]; float cw0[2], cw1[2];
    CombAsg q0, q1;
#define CB_ASG(dst, m_) do { const int mc_ = (m_) < mend ? (m_) : mend - 1; const int* ag_ = ASG + (size_t)mc_ * 8; dst.e0 = ag_[0]; dst.e1 = ag_[1]; dst.p0 = ag_[2]; dst.p1 = ag_[3]; dst.w0 = ag_[4]; dst.w1 = ag_[5]; } while (0)
#define CB_ROWS(set, src, m_) do { const int mc_ = (m_) < mend ? (m_) : mend - 1; const int d0_ = tab[32 + src.e0] + src.p0, d1_ = tab[32 + src.e1] + src.p1; cw0[set] = __int_as_float(src.w0); cw1[set] = __int_as_float(src.w1); \
        const float* hr_ = mc_ < RC ? hctx + (size_t)mc_ * D : a.out + (size_t)(mc_ - RC) * D; \
        _Pragma("unroll") for (int j_ = 0; j_ < 4; ++j_) { y0[set][j_] = ((const u32x2*)(YG + (size_t)d0_ * D))[C.lane + 64 * j_]; y1[set][j_] = ((const u32x2*)(YG + (size_t)d1_ * D))[C.lane + 64 * j_]; hv[set][j_] = ((const f32x4*)hr_)[C.lane + 64 * j_]; } } while (0)
#define CB_ROW(set, m_) do { const int m = (m_); int modrow, t_, L_; row_info(m, modrow, t_, L_); \
        if (modrow != curmod) { curmod = modrow; const float* g2_ = MOD + (size_t)(l * 17 + modrow) * 6144 + 5120; const float* md_ = MOD + (size_t)(17 + modrow) * 6144; \
            _Pragma("unroll") for (int j_ = 0; j_ < 4; ++j_) { g2v[j_] = ((const f32x4*)g2_)[C.lane + 64 * j_]; if (l == 0) { scv[j_] = ((const f32x4*)(md_ + 1024))[C.lane + 64 * j_]; shv[j_] = ((const f32x4*)md_)[C.lane + 64 * j_]; } } } \
        float* hrow = m < RC ? hctx + (size_t)m * D : a.out + (size_t)(m - RC) * D; const float w0 = cw0[set], w1 = cw1[set]; \
        f32x4 v[4]; float ss = 0.f; \
        _Pragma("unroll") for (int j = 0; j < 4; ++j) { const u32x2 p0 = y0[set][j], p1 = y1[set][j]; \
            f32x4 y; y.x = w0 * bflo(p0.x) + w1 * bflo(p1.x); y.y = w0 * bfhi(p0.x) + w1 * bfhi(p1.x); y.z = w0 * bflo(p0.y) + w1 * bflo(p1.y); y.w = w0 * bfhi(p0.y) + w1 * bfhi(p1.y); \
            v[j] = hv[set][j] + g2v[j] * y; ss += (v[j].x * v[j].x + v[j].y * v[j].y) + (v[j].z * v[j].z + v[j].w * v[j].w); } \
          \
        if (m + 2 < mend) { if (set == 0) { CB_ROWS(0, q0, m + 2); CB_ASG(q0, m + 4); } else { CB_ROWS(1, q1, m + 2); CB_ASG(q1, m + 4); } } \
        const float rstd = 1.0f / sqrtf(wave_sum(ss) * (1.0f / D) + EPS); \
        if (l == 0) { \
            if (m >= RC) { _Pragma("unroll") for (int j = 0; j < 4; ++j) ((f32x4*)hrow)[C.lane + 64 * j] = v[j]; } \
            _Pragma("unroll") for (int j = 0; j < 4; ++j) v[j] = v[j] * rstd * nwv[j] * (scv[j] + 1.0f) + shv[j]; \
            store_row_bf16(A + (size_t)m * D, C.lane, v); \
        } else { _Pragma("unroll") for (int j = 0; j < 4; ++j) ((f32x4*)hrow)[C.lane + 64 * j] = v[j] * rstd * nwv[j]; } } while (0)
    CB_ASG(q0, mbeg); CB_ASG(q1, mbeg + 1);
    CB_ROWS(0, q0, mbeg); CB_ROWS(1, q1, mbeg + 1);
    CB_ASG(q0, mbeg + 2); CB_ASG(q1, mbeg + 3);
    for (int mi = mbeg; mi < mend; mi += 2) {
        CB_ROW(0, mi);
        if (mi + 1 < mend) CB_ROW(1, mi + 1);
    }
#undef CB_ASG
#undef CB_ROWS
#undef CB_ROW
}
__device__ __forceinline__ void phase_attn_naive(const Args& a, const Ctx& C) {
    LAS float* ps = (LAS float*)(C.lds + C.wave * 9472);
    LAS float* qs = ps + 4 * 528;
    const bf16* Q1 = (const bf16*)(a.ws + WS_Q1); const bf16* K1 = (const bf16*)(a.ws + WS_K1); const bf16* V1 = (const bf16*)(a.ws + WS_V1); bf16* O1 = (bf16*)(a.ws + WS_O1);
    for (int task = C.gw; task < RL * 4; task += C.ngw) {
        const int kvh = task & 3, bt = task >> 2, b = bt >> 11, t = bt & 2047;
        { const u32x2 qv = *((const u32x2*)(Q1 + (size_t)bt * 1024 + kvh * 256) + C.lane); qs[4 * C.lane] = bflo(qv.x); qs[4 * C.lane + 1] = bfhi(qv.x); qs[4 * C.lane + 2] = bflo(qv.y); qs[4 * C.lane + 3] = bfhi(qv.y); }
        const int lo = t - 128 < 0 ? 0 : t - 128, hi = t + 128 > SEQ - 1 ? SEQ - 1 : t + 128, nk = 256 + hi - lo + 1;
        float sc[4][9];
#pragma unroll
        for (int i = 0; i < 9; ++i) { const int kx = C.lane + 64 * i;
            if (kx < nk) { const int row = kx < 256 ? b * 256 + kx : RC + b * SEQ + lo + (kx - 256); const u32x4* kp = (const u32x4*)(K1 + (size_t)row * 256 + kvh * 64);
                float s0 = 0.f, s1 = 0.f, s2 = 0.f, s3 = 0.f;
#pragma unroll
                for (int c8 = 0; c8 < 8; ++c8) { float kf[8]; unpack8(kp[c8], kf);
#pragma unroll
                    for (int e = 0; e < 8; ++e) { const int dd = c8 * 8 + e; s0 += qs[dd] * kf[e]; s1 += qs[64 + dd] * kf[e]; s2 += qs[128 + dd] * kf[e]; s3 += qs[192 + dd] * kf[e]; } }
                sc[0][i] = s0; sc[1][i] = s1; sc[2][i] = s2; sc[3][i] = s3; }
            else { sc[0][i] = -INFINITY; sc[1][i] = -INFINITY; sc[2][i] = -INFINITY; sc[3][i] = -INFINITY; } }
#pragma unroll
        for (int g = 0; g < 4; ++g) { const float sink = a.at_sink[kvh * 4 + g]; float mx = sc[g][0];
#pragma unroll
            for (int i = 1; i < 9; ++i) mx = fmaxf(mx, sc[g][i]);
            mx = fmaxf(wave_max(mx), sink); float sum = 0.f, p[9];
#pragma unroll
            for (int i = 0; i < 9; ++i) { p[i] = __expf(sc[g][i] - mx); sum += p[i]; }
            sum = wave_sum(sum) + __expf(sink - mx); const float inv = 1.0f / sum;
#pragma unroll
            for (int i = 0; i < 9; ++i) { const int kx = C.lane + 64 * i; if (kx < 528) ps[g * 528 + kx] = p[i] * inv; } }
        float o0 = 0.f, o1 = 0.f, o2 = 0.f, o3 = 0.f;
        for (int kx = 0; kx < nk; ++kx) { const int row = kx < 256 ? b * 256 + kx : RC + b * SEQ + lo + (kx - 256); const float v = bf2f(V1[(size_t)row * 256 + kvh * 64 + C.lane]);
            o0 += ps[kx] * v; o1 += ps[528 + kx] * v; o2 += ps[1056 + kx] * v; o3 += ps[1584 + kx] * v; }
        bf16* op = O1 + (size_t)bt * 1024 + kvh * 256 + C.lane;
        op[0] = (bf16)f2bf(o0); op[64] = (bf16)f2bf(o1); op[128] = (bf16)f2bf(o2); op[192] = (bf16)f2bf(o3);
    }
}
typedef float f32x16 __attribute__((ext_vector_type(16)));
typedef short s16x8 __attribute__((ext_vector_type(8)));
typedef short s16x4 __attribute__((ext_vector_type(4)));
template <bool MASK>
__device__ __forceinline__ void attn_tile(const s16x8 (&kf)[4], const s16x8 (&qf)[4], float& m_run, float& l_run, f32x16& Oa, f32x16& Ob, unsigned va, int start, int tq, int h) {
    f32x16 S = __builtin_amdgcn_mfma_f32_32x32x16_bf16(kf[0], qf[0], (f32x16){0.f, 0.f, 0.f, 0.f, 0.f, 0.f, 0.f, 0.f, 0.f, 0.f, 0.f, 0.f, 0.f, 0.f, 0.f, 0.f}, 0, 0, 0);
#pragma unroll
    for (int s = 1; s < 4; ++s) S = __builtin_amdgcn_mfma_f32_32x32x16_bf16(kf[s], qf[s], S, 0, 0, 0);
    if constexpr (MASK) {
#pragma unroll
        for (int i = 0; i < 16; ++i) { const int key = start + (i & 3) + 8 * (i >> 2) + 4 * h; const int dl = tq - key; if (dl > 128 || dl < -128) S[i] = -INFINITY; } }
    float tmax = S[0];
#pragma unroll
    for (int i = 1; i < 16; ++i) tmax = fmaxf(tmax, S[i]);
    tmax = xor32_max(tmax);
    const float m_new = fmaxf(m_run, tmax), alpha = __builtin_amdgcn_exp2f(m_run - m_new);
    float psum = 0.f;
#pragma unroll
    for (int i = 0; i < 16; ++i) { S[i] = __builtin_amdgcn_exp2f(S[i] - m_new); psum += S[i]; }
    psum = xor32_sum(psum);
    l_run = l_run * alpha + psum; m_run = m_new;
#pragma unroll
    for (int i = 0; i < 16; ++i) { Oa[i] *= alpha; Ob[i] *= alpha; }
    s16x8 pf[2];
#pragma unroll
    for (int s = 0; s < 2; ++s) { u32x4 w; w.x = pk2(S[8 * s], S[8 * s + 1]); w.y = pk2(S[8 * s + 2], S[8 * s + 3]); w.z = pk2(S[8 * s + 4], S[8 * s + 5]); w.w = pk2(S[8 * s + 6], S[8 * s + 7]); pf[s] = __builtin_bit_cast(s16x8, w); }
    u32x2 v000, v010, v100, v110, v001, v011, v101, v111;
    asm volatile("ds_read_b64_tr_b16 %0, %8\n\tds_read_b64_tr_b16 %1, %8 offset:1024\n\tds_read_b64_tr_b16 %2, %8 offset:2048\n\tds_read_b64_tr_b16 %3, %8 offset:3072\n\t"
                 "ds_read_b64_tr_b16 %4, %8 offset:64\n\tds_read_b64_tr_b16 %5, %8 offset:1088\n\tds_read_b64_tr_b16 %6, %8 offset:2112\n\tds_read_b64_tr_b16 %7, %8 offset:3136\n\ts_waitcnt lgkmcnt(0)"
                 : "=&v"(v000), "=&v"(v010), "=&v"(v100), "=&v"(v110), "=&v"(v001), "=&v"(v011), "=&v"(v101), "=&v"(v111) : "v"(va) : "memory");
    { u32x4 w; w.x = v000.x; w.y = v000.y; w.z = v010.x; w.w = v010.y; Oa = __builtin_amdgcn_mfma_f32_32x32x16_bf16(__builtin_bit_cast(s16x8, w), pf[0], Oa, 0, 0, 0); }
    { u32x4 w; w.x = v100.x; w.y = v100.y; w.z = v110.x; w.w = v110.y; Oa = __builtin_amdgcn_mfma_f32_32x32x16_bf16(__builtin_bit_cast(s16x8, w), pf[1], Oa, 0, 0, 0); }
    { u32x4 w; w.x = v001.x; w.y = v001.y; w.z = v011.x; w.w = v011.y; Ob = __builtin_amdgcn_mfma_f32_32x32x16_bf16(__builtin_bit_cast(s16x8, w), pf[0], Ob, 0, 0, 0); }
    { u32x4 w; w.x = v101.x; w.y = v101.y; w.z = v111.x; w.w = v111.y; Ob = __builtin_amdgcn_mfma_f32_32x32x16_bf16(__builtin_bit_cast(s16x8, w), pf[1], Ob, 0, 0, 0); }
}
__device__ __forceinline__ void phase_attn(const Args& a, const Ctx& C) {
    LAS unsigned char* vl = C.lds;
    LAS unsigned char* kl = C.lds + 73728;
    const unsigned vl_addr = (unsigned)(uintptr_t)vl;
    const bf16* Q1 = (const bf16*)(a.ws + WS_Q1); const bf16* K1 = (const bf16*)(a.ws + WS_K1); const bf16* V1 = (const bf16*)(a.ws + WS_V1); bf16* O1 = (bf16*)(a.ws + WS_O1);
    const int lane = C.lane, r = lane & 31, h = lane >> 5, g = C.wave >> 1, qh = C.wave & 1;
    const unsigned lane_off = (unsigned)((4 * h + ((lane & 15) >> 2)) * 128 + (16 * ((lane >> 4) & 1) + 4 * (lane & 3)) * 2);
    const LAS unsigned char* kbase = kl + r * 128; const int swz = (r >> 1) & 7;
    u32x4 vreg[9], kreg[9];
#define ATT_KVLOAD(u_) do { const int qb_ = (u_) & 31, kvh_ = ((u_) >> 5) & 3, b_ = (u_) >> 7, q0_ = qb_ * 64; _Pragma("unroll") for (int k_ = 0; k_ < 9; ++k_) { const int idx_ = C.tid + NTHR * k_, row_ = idx_ >> 3, ch_ = idx_ & 7; \
            int grow_; bool ok_ = true; if (row_ < 256) grow_ = b_ * 256 + row_; else { const int kp_ = q0_ - 128 + (row_ - 256); ok_ = kp_ >= 0 && kp_ < SEQ; grow_ = RC + b_ * SEQ + (ok_ ? kp_ : 0); } \
            vreg[k_] = *(const u32x4*)(V1 + (size_t)grow_ * 256 + kvh_ * 64 + ch_ * 8); kreg[k_] = *(const u32x4*)(K1 + (size_t)grow_ * 256 + kvh_ * 64 + ch_ * 8); } } while (0)
#define ATT_KVSTORE() do { _Pragma("unroll") for (int k_ = 0; k_ < 9; ++k_) { const int idx_ = C.tid + NTHR * k_, row_ = idx_ >> 3, ch_ = idx_ & 7; *(LAS u32x4*)(vl + row_ * 128 + ch_ * 16) = vreg[k_]; \
            *(LAS u32x4*)(kl + row_ * 128 + ((ch_ ^ ((row_ >> 1) & 7)) * 16)) = kreg[k_]; } } while (0)
    if (C.vcu < 2048) { ATT_KVLOAD(C.vcu); ATT_KVSTORE(); }
    __syncthreads();
    for (int unit = C.vcu; unit < 2048; unit += C.G) {
        const int qb = unit & 31, kvh = (unit >> 5) & 3, b = unit >> 7, q0 = qb * 64;
        if (unit + C.G < 2048) ATT_KVLOAD(unit + C.G);
        const int tq0 = q0 + 32 * qh, tq = tq0 + r, head = kvh * 4 + g;
        s16x8 qf[4];
        { const bf16* qp = Q1 + (size_t)(b * SEQ + tq) * 1024 + head * 64 + 8 * h;
#pragma unroll
          for (int s = 0; s < 4; ++s) qf[s] = *(const s16x8*)(qp + 16 * s); }
        float m_run = a.at_sink[head] * 1.4426950408889634f, l_run = 1.0f;
        f32x16 Oa, Ob;
#pragma unroll
        for (int i = 0; i < 16; ++i) { Oa[i] = 0.f; Ob[i] = 0.f; }
        const int i_lo = tq0 < 128 ? (128 - tq0) >> 5 : 0, i_hi = (SEQ - 32 - (tq0 - 128)) >> 5 > 8 ? 8 : (SEQ - 32 - (tq0 - 128)) >> 5, ntile = 8 + i_hi - i_lo + 1;
#define ATT_LT(tn_) ((tn_) < 8 ? (tn_) : 8 + i_lo + (tn_) - 8 + qh)
#define ATT_KLOAD(kf_, tn_) do { const LAS unsigned char* kp_ = kbase + ATT_LT(tn_) * 4096; _Pragma("unroll") for (int s_ = 0; s_ < 4; ++s_) kf_[s_] = *(const LAS s16x8*)(kp_ + (((h + 2 * s_) ^ swz) * 16)); } while (0)
#define ATT_TILE(kf_, tj_) do { const int tj__ = (tj_); const bool lat_ = tj__ >= 8; const int i_ = i_lo + tj__ - 8; const int start_ = lat_ ? tq0 - 128 + 32 * i_ : 0; const int ltile_ = lat_ ? 8 + i_ + qh : tj__; \
            const unsigned va_ = vl_addr + (unsigned)ltile_ * 4096u + lane_off; \
            if (lat_ && (i_ == 0 || i_ == 8)) attn_tile<true>(kf_, qf, m_run, l_run, Oa, Ob, va_, start_, tq, h); else attn_tile<false>(kf_, qf, m_run, l_run, Oa, Ob, va_, start_, tq, h); } while (0)
        s16x8 kA[4], kB[4];
        ATT_KLOAD(kA, 0);
        int tj = 0;
        for (; tj + 1 < ntile; tj += 2) {
            ATT_KLOAD(kB, tj + 1);
            ATT_TILE(kA, tj);
            if (tj + 2 < ntile) ATT_KLOAD(kA, tj + 2);
            ATT_TILE(kB, tj + 1);
        }
        if (tj < ntile) ATT_TILE(kA, tj);
#undef ATT_KLOAD
#undef ATT_TILE
#undef ATT_LT
        const float inv = 1.0f / l_run;
        bf16* ob = O1 + (size_t)(b * SEQ + tq) * 1024 + head * 64 + 8 * h;
#pragma unroll
        for (int j = 0; j < 2; ++j) {
            u32x2 a0, b0, a1, b1;
            a0.x = pk2(Oa[8 * j] * inv, Oa[8 * j + 1] * inv); a0.y = pk2(Oa[8 * j + 2] * inv, Oa[8 * j + 3] * inv); b0.x = pk2(Oa[8 * j + 4] * inv, Oa[8 * j + 5] * inv); b0.y = pk2(Oa[8 * j + 6] * inv, Oa[8 * j + 7] * inv);
            a1.x = pk2(Ob[8 * j] * inv, Ob[8 * j + 1] * inv); a1.y = pk2(Ob[8 * j + 2] * inv, Ob[8 * j + 3] * inv); b1.x = pk2(Ob[8 * j + 4] * inv, Ob[8 * j + 5] * inv); b1.y = pk2(Ob[8 * j + 6] * inv, Ob[8 * j + 7] * inv);
            const auto sx0 = __builtin_amdgcn_permlane32_swap(a0.x, b0.x, false, false), sy0 = __builtin_amdgcn_permlane32_swap(a0.y, b0.y, false, false);
            const auto sx1 = __builtin_amdgcn_permlane32_swap(a1.x, b1.x, false, false), sy1 = __builtin_amdgcn_permlane32_swap(a1.y, b1.y, false, false);
            *(u32x4*)(ob + 16 * j) = (u32x4){sx0[0], sy0[0], sx0[1], sy0[1]};
            *(u32x4*)(ob + 32 + 16 * j) = (u32x4){sx1[0], sy1[0], sx1[1], sy1[1]};
        }
        __syncthreads();
        if (unit + C.G < 2048) ATT_KVSTORE();
        __syncthreads();
    }
#undef ATT_KVLOAD
#undef ATT_KVSTORE
}
#define RMAP(tile, r) (32 * ((tile) >> 1) + 8 * ((r) >> 2) + ((r) & 3) + 4 * ((tile) & 1))
constexpr int SB_WN = 0, SB_QD = 17408, SB_KDT = 34816, SB_QK = 53248, SB_UT = 62464, SB_BYTES = 71680;
__device__ __forceinline__ s16x8 afrag16(const LAS unsigned char* p) { return *(const LAS s16x8*)p; }
__device__ __forceinline__ s16x8 afrag(const LAS unsigned char* p) { const u32x2 lo = *(const LAS u32x2*)p, hi = *(const LAS u32x2*)(p + 32); u32x4 w; w.x = lo.x; w.y = lo.y; w.z = hi.x; w.w = hi.y; return __builtin_bit_cast(s16x8, w); }
__device__ __forceinline__ s16x8 pack_acc2(const f32x4 a, const f32x4 b) { u32x4 w; w.x = pk2(a.x, a.y); w.y = pk2(a.z, a.w); w.z = pk2(b.x, b.y); w.w = pk2(b.z, b.w); return __builtin_bit_cast(s16x8, w); }
__device__ __forceinline__ int scan_unit(int step, int b, int h, int d, int& cg) { if (step < 4) cg = b * 4 + (d ? 3 - step : step); else { const int n = step - 4; cg = 64 + b * 32 + (d ? 31 - n : n); } return (cg * 4 + h) * 2 + d; }
__device__ __forceinline__ void phase_dn_scan(const Args& a, const Ctx& C) {
    const unsigned char* gW = a.ws + WS_W; const unsigned char* gQ = (const unsigned char*)a.out; const unsigned char* gQK = a.ws + WS_QK; const unsigned char* gU = a.ws + WS_U;
    const float* GL = (const float*)(a.ws + WS_GL);
    const float* GE = (const float*)(a.ws + WS_GE);
    bf16* OF = (bf16*)(a.ws + WS_QD); bf16* OB = OF + (size_t)RT * 512;
    const int tid = C.tid;
    const int lt = tid & 255;
    const unsigned sd_wq = (unsigned)((lt >> 4) * 272 + (lt & 15) * 16), sd_k = (unsigned)(((lt >> 4) >> 1) * 528 + ((lt >> 4) & 1) * 8 + ((lt >> 4) >> 3) * 64 + (lt & 15) * 32), sd_g = (unsigned)((lt >> 3) * 144 + (lt & 7) * 16);
    for (int work = C.vcu; work < 256; work += C.G) {
        const int half = work & 1, d = (work >> 1) & 1, h = (work >> 2) & 3, b = work >> 4;
        const int qoff0 = (d ? 63 - (lt >> 4) : (lt >> 4)) * 3072 + h * 256 + (lt & 15) * 16, qstep = d ? -16 * 3072 : 16 * 3072;
#define SCAN_LOAD(st, step_) do { int cg_; const size_t ub = (size_t)scan_unit((step_), b, h, d, cg_); \
            _Pragma("unroll") for (int i_ = 0; i_ < 4; ++i_) { st[i_] = *(const u32x4*)(gW + ub * 16384 + (size_t)(lt + 256 * i_) * 16); st[4 + i_] = *(const u32x4*)(gQ + (size_t)cg_ * (64 * 3072) + (unsigned)(qoff0 + i_ * qstep)); \
                st[8 + i_] = *(const u32x4*)(gQ + (size_t)cg_ * (64 * 3072) + (unsigned)(qoff0 + 1024 + i_ * qstep)); } \
            _Pragma("unroll") for (int i_ = 0; i_ < 2; ++i_) { st[12 + i_] = *(const u32x4*)(gQK + ub * 8192 + (size_t)(lt + 256 * i_) * 16); st[14 + i_] = *(const u32x4*)(gU + ub * 16384 + (size_t)half * 8192 + (size_t)(lt + 256 * i_) * 16); } } while (0)
#define SCAN_STORE(st, bufoff) do { _Pragma("unroll") for (int i_ = 0; i_ < 4; ++i_) { *(LAS u32x4*)(C.lds + (bufoff) + SB_WN + sd_wq + i_ * 4352) = st[i_]; *(LAS u32x4*)(C.lds + (bufoff) + SB_QD + sd_wq + i_ * 4352) = st[4 + i_]; \
                LAS unsigned char* kp_ = C.lds + (bufoff) + SB_KDT + sd_k + i_ * 4352; *(LAS u32x2*)kp_ = (u32x2){st[8 + i_].x, st[8 + i_].y}; *(LAS u32x2*)(kp_ + 16) = (u32x2){st[8 + i_].z, st[8 + i_].w}; } \
            _Pragma("unroll") for (int i_ = 0; i_ < 2; ++i_) { *(LAS u32x4*)(C.lds + (bufoff) + SB_QK + sd_g + i_ * 4608) = st[12 + i_]; *(LAS u32x4*)(C.lds + (bufoff) + SB_UT + sd_g + i_ * 4608) = st[14 + i_]; } } while (0)
#define SCAN_FLUSH(sp) do { int cgp_; (void)scan_unit((sp), b, h, d, cgp_); _Pragma("unroll") for (int k_ = 0; k_ < 2; ++k_) { const int c_ = lt + 256 * k_, rr_ = c_ >> 3, ch_ = c_ & 7; \
            const u32x4 v_ = *(const LAS u32x4*)(C.lds + 2 * SB_BYTES + ((sp) & 1) * 9216 + rr_ * 144 + ch_ * 16); const int m_ = cgp_ * 64 + (d ? 63 - rr_ : rr_); \
            *(u32x4*)((d ? OB : OF) + (size_t)m_ * 512 + h * 128 + half * 64 + ch_ * 8) = v_; } } while (0)
        if (C.wave >= 4) {
            u32x4 sa[16], sb[16];
            SCAN_LOAD(sa, 0); SCAN_STORE(sa, 0); SCAN_LOAD(sb, 1); SCAN_LOAD(sa, 2);
            __syncthreads();
            for (int step = 0; step < 36; step += 2) {
                SCAN_STORE(sb, SB_BYTES); if (step + 3 < 36) SCAN_LOAD(sb, step + 3);
                if (step > 0) SCAN_FLUSH(step - 1);
                __syncthreads();
                if (step + 2 < 36) SCAN_STORE(sa, 0); if (step + 4 < 36) SCAN_LOAD(sa, step + 4);
                SCAN_FLUSH(step);
                __syncthreads();
            }
            SCAN_FLUSH(35);
        } else {
        int ln_ = C.lane; asm volatile("" : "+v"(ln_)); const int fr = ln_ & 15, q = ln_ >> 4;
        f32x4 S[8];
#pragma unroll
        for (int t = 0; t < 8; ++t) S[t] = (f32x4){0.f, 0.f, 0.f, 0.f};
        f32x4 egn[4], gkn[4];
        { int cg0_; const int u0_ = scan_unit(0, b, h, d, cg0_);
#pragma unroll
          for (int i = 0; i < 4; ++i) { egn[i] = *(const f32x4*)(GE + (size_t)u0_ * 128 + RMAP(i, 4 * q)); gkn[i] = *(const f32x4*)(GE + (size_t)u0_ * 128 + 64 + RMAP(i, 4 * q)); } }
        const unsigned ktr_lane = (unsigned)(q * 2176 + (fr >> 3) * 528 + ((fr >> 2) & 1) * 8 + (fr & 3) * 32);
        __syncthreads();
        for (int step = 0; step < 36; ++step) {
            int cg; const int ucur = scan_unit(step, b, h, d, cg);
            {
                f32x4 eg[4], gk[4];
#pragma unroll
                for (int i = 0; i < 4; ++i) { eg[i] = egn[i]; gk[i] = gkn[i]; }
                if (step + 1 < 36) { int cgn_; const int un_ = scan_unit(step + 1, b, h, d, cgn_);
#pragma unroll
                    for (int i = 0; i < 4; ++i) { egn[i] = *(const f32x4*)(GE + (size_t)un_ * 128 + RMAP(i, 4 * q)); gkn[i] = *(const f32x4*)(GE + (size_t)un_ * 128 + 64 + RMAP(i, 4 * q)); } }

                const LAS unsigned char* B0 = C.lds + (step & 1) * SB_BYTES;
                const float gl = GL[ucur];
                s16x8 Sb[4];
#pragma unroll
                for (int s = 0; s < 4; ++s) Sb[s] = pack_acc2(S[2 * s], S[2 * s + 1]);
                f32x4 vn[4], o[4];
                s16x8 wf[2][4], qf[2][4];
#define SCAN_LDWQ(buf, i) do { _Pragma("unroll") for (int s_ = 0; s_ < 4; ++s_) { wf[buf][s_] = afrag16(B0 + SB_WN + RMAP(i, fr) * 272 + (32 * s_ + 8 * q) * 2); qf[buf][s_] = afrag16(B0 + SB_QD + RMAP(i, fr) * 272 + (32 * s_ + 8 * q) * 2); } } while (0)
                SCAN_LDWQ(0, 0);
#pragma unroll
                for (int i = 0; i < 4; ++i) {
                    const u32x2 uu = *(const LAS u32x2*)(B0 + SB_UT + (16 * C.wave + fr) * 144 + RMAP(i, 4 * q) * 2);
                    if (i < 3) { if (i & 1) SCAN_LDWQ(0, i + 1); else SCAN_LDWQ(1, i + 1); }
                    __builtin_amdgcn_sched_barrier(0);
                    vn[i] = (f32x4){bflo(uu.x), bfhi(uu.x), bflo(uu.y), bfhi(uu.y)}; o[i] = (f32x4){0.f, 0.f, 0.f, 0.f};
#pragma unroll
                    for (int s = 0; s < 4; ++s) { vn[i] = __builtin_amdgcn_mfma_f32_16x16x32_bf16(wf[i & 1][s], Sb[s], vn[i], 0, 0, 0); o[i] = __builtin_amdgcn_mfma_f32_16x16x32_bf16(qf[i & 1][s], Sb[s], o[i], 0, 0, 0); }
                    __builtin_amdgcn_sched_barrier(0);
                }
#undef SCAN_LDWQ
#pragma unroll
                for (int i = 0; i < 4; ++i) o[i] = o[i] * eg[i];
                s16x8 gf[2][4];
#define SCAN_LDG(buf, g) do { if ((g) < 2) { _Pragma("unroll") for (int j_ = 0; j_ < 4; ++j_) gf[buf][j_] = afrag16(B0 + SB_QK + RMAP(2 * (g) + (j_ >> 1), fr) * 144 + (32 * (j_ & 1) + 8 * q) * 2); } \
                    else { _Pragma("unroll") for (int j_ = 0; j_ < 4; ++j_) { const int t_ = 2 * ((g) - 2) + (j_ >> 1); const LAS unsigned char* p_ = B0 + SB_KDT + ktr_lane + (j_ & 1) * 8704 + (8 * (t_ >> 1) + (t_ & 1)) * 16; \
                        const s16x4 lo_ = __builtin_amdgcn_ds_read_tr16_b64_v4i16((LAS s16x4*)p_), hi_ = __builtin_amdgcn_ds_read_tr16_b64_v4i16((LAS s16x4*)(p_ + 1056)); \
                        gf[buf][j_] = __builtin_shufflevector(lo_, hi_, 0, 1, 2, 3, 4, 5, 6, 7); } } } while (0)
                SCAN_LDG(0, 0);
                s16x8 vb[2], vbk[2];
#pragma unroll
                for (int s = 0; s < 2; ++s) { vb[s] = pack_acc2(vn[2 * s], vn[2 * s + 1]); vbk[s] = pack_acc2(vn[2 * s] * gk[2 * s], vn[2 * s + 1] * gk[2 * s + 1]); }
#pragma unroll
                for (int g = 0; g < 6; ++g) {
                    if (g < 5) { if (g & 1) SCAN_LDG(0, g + 1); else SCAN_LDG(1, g + 1); }
                    __builtin_amdgcn_sched_barrier(0);
                    if (g < 2) {
#pragma unroll
                        for (int j = 0; j < 4; ++j) o[2 * g + (j >> 1)] = __builtin_amdgcn_mfma_f32_16x16x32_bf16(gf[g & 1][j], vb[j & 1], o[2 * g + (j >> 1)], 0, 0, 0);
                    } else {
#pragma unroll
                        for (int j = 0; j < 4; ++j) { const int t = 2 * (g - 2) + (j >> 1); if ((j & 1) == 0) S[t] = S[t] * gl; S[t] = __builtin_amdgcn_mfma_f32_16x16x32_bf16(gf[g & 1][j], vbk[j & 1], S[t], 0, 0, 0); }
                    }
                    __builtin_amdgcn_sched_barrier(0);
                }
#undef SCAN_LDG
                LAS bf16* ob = (LAS bf16*)(C.lds + 2 * SB_BYTES + (step & 1) * 9216) + 16 * C.wave + fr;
#pragma unroll
                for (int i = 0; i < 4; ++i)
#pragma unroll
                    for (int e = 0; e < 4; ++e) ob[RMAP(i, 4 * q + e) * 72] = (bf16)f2bf(o[i][e]);
            }
            __syncthreads();
        }
        }
#undef SCAN_LOAD
#undef SCAN_STORE
#undef SCAN_FLUSH
    }
}
constexpr int IN_AT = 0, IN_TILE = 18432, IN_G = 18432 + 19456, IN_WAVE = 18432 + 19456 + 1024;
__device__ __forceinline__ unsigned tile_row(int row) { return (unsigned)(row * 288 + (row >> 3) * 128); }
__device__ __forceinline__ void phase_dn_intra(const Args& a, const Ctx& C) {
    if (C.wave >= 4) return;
    LAS unsigned char* wb = C.lds + C.wave * IN_WAVE;
    LAS float* AT = (LAS float*)(wb + IN_AT); LAS unsigned char* TU = wb + IN_AT; LAS unsigned char* TW = wb + IN_AT + 9216; LAS unsigned char* TL = wb + IN_TILE;
    LAS float* gs = (LAS float*)(wb + IN_G); LAS float* bs = gs + 64; LAS float* es = gs + 128; LAS float* ks = gs + 192;
    const unsigned tl_addr = (unsigned)(uintptr_t)TL;
    const bf16* QKV = (const bf16*)a.out; const float* LA = (const float*)(a.ws + WS_LA); const float* BT = (const float*)(a.ws + WS_BT);
    bf16* UT = (bf16*)(a.ws + WS_U); bf16* WN = (bf16*)(a.ws + WS_W); bf16* QK = (bf16*)(a.ws + WS_QK);
    float* GL = (float*)(a.ws + WS_GL); float* GE = (float*)(a.ws + WS_GE);
    const int wid = C.bid * 4 + C.wave, nw = C.G * 4;
    for (int unit = wid; unit < NUNIT; unit += nw) {
        int lane = C.lane; asm volatile("" : "+v"(lane));
        const int cg = unit >> 3, h = (unit >> 1) & 3, d = unit & 1;
        const size_t ub = (size_t)unit;
        u32x4 kst[16]; float la_n, b_n;
        { const int m = cg * 64 + (d ? 63 - lane : lane); la_n = LA[(size_t)m * 8 + d * 4 + h]; b_n = BT[(size_t)m * 8 + d * 4 + h];
          const unsigned char* kb_ = (const unsigned char*)(QKV + (size_t)cg * 64 * 1536 + 512 + h * 128);
#pragma unroll
          for (int c = 0; c < 16; ++c) { const int ch = c * 64 + lane, row = ch >> 4, cc = ch & 15; const unsigned off = (unsigned)((d ? 63 - row : row) * 3072 + cc * 16); kst[c] = *(const u32x4*)(kb_ + off); } }
        s16x8 Qall[4][4];
        { const int fr0 = lane & 15, q0_ = lane >> 4; const unsigned char* qb_ = (const unsigned char*)(QKV + (size_t)cg * 64 * 1536 + h * 128);
#pragma unroll
          for (int it = 0; it < 4; ++it) { const int i = 16 * it + fr0; const unsigned off = (unsigned)((d ? 63 - i : i) * 3072 + q0_ * 16);
#pragma unroll
              for (int s = 0; s < 4; ++s) Qall[it][s] = *(const s16x8*)(qb_ + off + 64 * s); } }
        { float g = la_n;
#pragma unroll
          for (int o = 1; o < 64; o <<= 1) { const float t = __int_as_float(__builtin_amdgcn_ds_bpermute(((lane - o) & 63) << 2, __float_as_int(g))); if (lane >= o) g += t; }
          const float g63 = __int_as_float(__builtin_amdgcn_readlane(__float_as_int(g), 63));
          const float eg_ = expf(g); gs[lane] = g; bs[lane] = b_n; const float kd_ = expf(g63 - g); es[lane] = eg_; ks[lane] = kd_; GE[ub * 128 + lane] = eg_; GE[ub * 128 + 64 + lane] = kd_;
          if (lane == 63) GL[unit] = expf(g); }
        asm volatile("s_waitcnt lgkmcnt(0)" ::: "memory");
        { int ln_ = lane; asm volatile("" : "+v"(ln_)); const int fr = ln_ & 15, q = ln_ >> 4;
#pragma unroll
        for (int c = 0; c < 16; ++c) { const int ch = c * 64 + lane, row = ch >> 4, cc = ch & 15; *(LAS u32x4*)(TL + tile_row(row) + cc * 16) = kst[c]; }
        asm volatile("s_waitcnt lgkmcnt(0)" ::: "memory");
#pragma unroll
        for (int it = 0; it < 4; ++it) {
            s16x8 Qf[4];
            {
#pragma unroll
              for (int s = 0; s < 4; ++s) Qf[s] = Qall[it][s]; }
#pragma unroll
            for (int jt = 0; jt < 4; ++jt) {
                if (jt <= it) {
                    f32x4 dk = (f32x4){0.f, 0.f, 0.f, 0.f}, dq = (f32x4){0.f, 0.f, 0.f, 0.f};
#pragma unroll
                    for (int s = 0; s < 4; ++s) { const s16x8 ki = *(const LAS s16x8*)(TL + tile_row(16 * it + fr) + (32 * s + 8 * q) * 2), kj = *(const LAS s16x8*)(TL + tile_row(16 * jt + fr) + (32 * s + 8 * q) * 2);
                        dk = __builtin_amdgcn_mfma_f32_16x16x32_bf16(ki, kj, dk, 0, 0, 0);
                        dq = __builtin_amdgcn_mfma_f32_16x16x32_bf16(kj, Qf[s], dq, 0, 0, 0); }
                    { const int j = 16 * jt + fr; const float gj = gs[j]; f32x4 av; const f32x4 gi4 = *(const LAS f32x4*)(gs + 16 * it + 4 * q), bi4 = *(const LAS f32x4*)(bs + 16 * it + 4 * q);
#pragma unroll
                      for (int e = 0; e < 4; ++e) { const int i = 16 * it + 4 * q + e; const float v = dk[e] * bi4[e] * __expf(fminf(gi4[e] - gj, 0.f)); av[e] = (i > j) ? v : 0.f; }
                      *(LAS f32x4*)(AT + j * 64 + 16 * it + 4 * q) = av; }
                    { const int i = 16 * it + fr; const float gi = gs[i]; float qv[4]; const f32x4 gj4 = *(const LAS f32x4*)(gs + 16 * jt + 4 * q);
#pragma unroll
                      for (int e = 0; e < 4; ++e) { const int j = 16 * jt + 4 * q + e; const float v = dq[e] * __expf(fminf(gi - gj4[e], 0.f)); qv[e] = (i >= j) ? v : 0.f; }
                      u32x2 w; w.x = pk2(qv[0], qv[1]); w.y = pk2(qv[2], qv[3]); *(u32x2*)(QK + ub * 4096 + i * 64 + 16 * jt + 4 * q) = w; }
                } else { const int i = 16 * it + fr; *(u32x2*)(QK + ub * 4096 + i * 64 + 16 * jt + 4 * q) = (u32x2){0u, 0u};
                    *(LAS f32x4*)(AT + (16 * jt + fr) * 64 + 16 * it + 4 * q) = (f32x4){0.f, 0.f, 0.f, 0.f}; }
                    }
        }
        }
        asm volatile("s_waitcnt lgkmcnt(0)" ::: "memory");
        u32x4 vst[16];
        f32x4 a21[2][2];
        { int ln_ = lane; asm volatile("" : "+v"(ln_)); const int hb = ln_ >> 5, r = ln_ & 31;
          const LAS float* ATb = AT + hb * (32 * 64 + 32);
          LAS float* trow = (LAS float*)(TL + 5120) + ln_ * 36;
#pragma unroll
          for (int k = 0; k < 8; ++k) *(LAS f32x4*)(trow + 4 * k) = (f32x4){0.f, 0.f, 0.f, 0.f};
          trow[31] = (r == 31) ? 1.f : 0.f;
#pragma unroll 1
          for (int cc = 30; cc >= 0; --cc) { float acc0 = (r == cc) ? 1.f : 0.f, acc1 = 0.f; const LAS float* ap = ATb + cc * 64;
              float acc2 = 0.f, acc3 = 0.f;
#pragma unroll
              for (int hq = 0; hq < 2; ++hq) { f32x4 av[4], tv[4];
#pragma unroll
                  for (int jq = 0; jq < 4; ++jq) { av[jq] = *(const LAS f32x4*)(ap + 16 * hq + 4 * jq); tv[jq] = *(const LAS f32x4*)(trow + 16 * hq + 4 * jq); }
#pragma unroll
                  for (int jq = 0; jq < 4; ++jq) { acc0 -= av[jq][0] * tv[jq][0]; acc1 -= av[jq][1] * tv[jq][1]; acc2 -= av[jq][2] * tv[jq][2]; acc3 -= av[jq][3] * tv[jq][3]; } }
              trow[cc] = (acc0 + acc1) + (acc2 + acc3); }
          { const int fr = ln_ & 15, q = ln_ >> 4;
#pragma unroll
            for (int t = 0; t < 2; ++t)
#pragma unroll
                for (int jt = 0; jt < 2; ++jt) a21[t][jt] = *(const LAS f32x4*)(AT + (16 * jt + fr) * 64 + 32 + 16 * t + 4 * q); }
          asm volatile("s_waitcnt lgkmcnt(0)" ::: "memory");
          { LAS unsigned char* dst = TL + hb * 2560 + r * 80;
#pragma unroll 1
            for (int c8 = 0; c8 < 4; ++c8) { float f[8], fu[8], fw[8]; const f32x4 t0 = *(const LAS f32x4*)(trow + 8 * c8), t1 = *(const LAS f32x4*)(trow + 8 * c8 + 4);
                const LAS float* bp = bs + 32 * hb + 8 * c8; const LAS float* ep = es + 32 * hb + 8 * c8;
                const f32x4 b0 = *(const LAS f32x4*)bp, b1 = *(const LAS f32x4*)(bp + 4), e0 = *(const LAS f32x4*)ep, e1 = *(const LAS f32x4*)(ep + 4);
#pragma unroll
                for (int e = 0; e < 4; ++e) { f[e] = t0[e]; f[4 + e] = t1[e]; fu[e] = t0[e] * b0[e]; fu[4 + e] = t1[e] * b1[e]; fw[e] = fu[e] * e0[e]; fw[4 + e] = fu[4 + e] * e1[e]; }
                *(LAS u32x4*)(dst + c8 * 16) = pack8(f);
                *(LAS u32x4*)(TU + ln_ * 144 + (4 * hb + c8) * 16) = pack8(fu); *(LAS u32x4*)(TW + ln_ * 144 + (4 * hb + c8) * 16) = pack8(fw);
                *(LAS u32x4*)(TU + ln_ * 144 + (4 * (1 - hb) + c8) * 16) = (u32x4){0u, 0u, 0u, 0u}; *(LAS u32x4*)(TW + ln_ * 144 + (4 * (1 - hb) + c8) * 16) = (u32x4){0u, 0u, 0u, 0u}; } }
        }
        asm volatile("s_waitcnt lgkmcnt(0)" ::: "memory");
        { int ln_ = lane; asm volatile("" : "+v"(ln_)); const int fr = ln_ & 15, q = ln_ >> 4;
          s16x8 t22f[2];
#pragma unroll
          for (int rt = 0; rt < 2; ++rt) t22f[rt] = afrag(TL + 2560 + (16 * rt + fr) * 80 + 8 * q);
          f32x4 zt[2][2];
#pragma unroll
          for (int jt = 0; jt < 2; ++jt) { const s16x8 af = pack_acc2(a21[0][jt], a21[1][jt]);
#pragma unroll
              for (int rt = 0; rt < 2; ++rt) zt[jt][rt] = __builtin_amdgcn_mfma_f32_16x16x32_bf16(af, t22f[rt], (f32x4){0.f, 0.f, 0.f, 0.f}, 0, 0, 0); }
#pragma unroll
          for (int ct = 0; ct < 2; ++ct) { u32x2 lo_, hi_; const unsigned ad_ = tl_addr + (unsigned)((4 * q + (fr >> 2)) * 80 + (16 * ct + 4 * (fr & 3)) * 2);
              asm volatile("ds_read_b64_tr_b16 %0, %2\n\tds_read_b64_tr_b16 %1, %2 offset:1280\n\ts_waitcnt lgkmcnt(0)" : "=&v"(lo_), "=&v"(hi_) : "v"(ad_) : "memory");
              u32x4 w_; w_.x = lo_.x; w_.y = lo_.y; w_.z = hi_.x; w_.w = hi_.y; const s16x8 t11f = __builtin_bit_cast(s16x8, w_);
              const f32x4 b4 = *(const LAS f32x4*)(bs + 16 * ct + 4 * q), e4 = *(const LAS f32x4*)(es + 16 * ct + 4 * q);
#pragma unroll
              for (int rt = 0; rt < 2; ++rt) { const f32x4 dd = __builtin_amdgcn_mfma_f32_16x16x32_bf16(t11f, pack_acc2(zt[0][rt], zt[1][rt]), (f32x4){0.f, 0.f, 0.f, 0.f}, 0, 0, 0);
                  float fu[4], fw[4];
#pragma unroll
                  for (int e = 0; e < 4; ++e) { fu[e] = -dd[e] * b4[e]; fw[e] = fu[e] * e4[e]; }
                  u32x2 wu, ww; wu.x = pk2(fu[0], fu[1]); wu.y = pk2(fu[2], fu[3]); ww.x = pk2(fw[0], fw[1]); ww.y = pk2(fw[2], fw[3]);
                  *(LAS u32x2*)(TU + (32 + 16 * rt + fr) * 144 + (16 * ct + 4 * q) * 2) = wu; *(LAS u32x2*)(TW + (32 + 16 * rt + fr) * 144 + (16 * ct + 4 * q) * 2) = ww; } }
          asm volatile("s_waitcnt lgkmcnt(0)" ::: "memory");
#pragma unroll
          for (int c = 0; c < 16; ++c) { const int ch = c * 64 + ln_, row = ch >> 4, cc = ch & 15; *(LAS u32x4*)(TL + tile_row(row) + cc * 16) = kst[c]; }
        }
        asm volatile("s_waitcnt lgkmcnt(0)" ::: "memory");
        { const unsigned char* vb_ = (const unsigned char*)(QKV + (size_t)cg * 64 * 1536 + 1024 + h * 128);
#pragma unroll
        for (int c = 0; c < 16; ++c) { const int ch = c * 64 + lane, row = ch >> 4, cc = ch & 15; const unsigned off = (unsigned)((d ? 63 - row : row) * 3072 + cc * 16); vst[c] = *(const u32x4*)(vb_ + off); } }
        { int ln_ = lane; asm volatile("" : "+v"(ln_)); const int fr = ln_ & 15, q = ln_ >> 4;
        const unsigned tr_lane = (unsigned)(((fr >> 2)) * 288 + (4 * (fr & 3)) * 2);
#define TR_FRAG(dst, ct, s) do { u32x2 lo_, hi_; const unsigned ad_ = tl_addr + tile_row(32 * (s) + 8 * q) + tr_lane + (unsigned)(ct) * 32u; \
            asm volatile("ds_read_b64_tr_b16 %0, %2\n\tds_read_b64_tr_b16 %1, %2 offset:1152\n\ts_waitcnt lgkmcnt(0)" : "=&v"(lo_), "=&v"(hi_) : "v"(ad_) : "memory"); \
            u32x4 w_; w_.x = lo_.x; w_.y = lo_.y; w_.z = hi_.x; w_.w = hi_.y; dst = __builtin_bit_cast(s16x8, w_); } while (0)
        s16x8 Tf[4][2];
#pragma unroll
        for (int it = 0; it < 4; ++it)
#pragma unroll
            for (int s = 0; s < 2; ++s) Tf[it][s] = *(const LAS s16x8*)(TW + (16 * it + fr) * 144 + (32 * s + 8 * q) * 2);
        asm volatile("s_waitcnt lgkmcnt(0)" ::: "memory");
#pragma unroll 1
        for (int hf = 0; hf < 2; ++hf) {
            s16x8 kfr[4][2];
#pragma unroll
            for (int c4 = 0; c4 < 4; ++c4) { TR_FRAG(kfr[c4][0], 4 * hf + c4, 0); TR_FRAG(kfr[c4][1], 4 * hf + c4, 1); }
#pragma unroll
            for (int c4 = 0; c4 < 4; ++c4)
#pragma unroll
                for (int it = 0; it < 4; ++it) { f32x4 acc = (f32x4){0.f, 0.f, 0.f, 0.f};
                    acc = __builtin_amdgcn_mfma_f32_16x16x32_bf16(kfr[c4][0], Tf[it][0], acc, 0, 0, 0); acc = __builtin_amdgcn_mfma_f32_16x16x32_bf16(kfr[c4][1], Tf[it][1], acc, 0, 0, 0);
                    u32x2 w; w.x = pk2(-acc[0], -acc[1]); w.y = pk2(-acc[2], -acc[3]); *(LAS u32x2*)(TW + (16 * it + fr) * 144 + (16 * c4 + 4 * q) * 2) = w; }
            asm volatile("s_waitcnt lgkmcnt(0)" ::: "memory");
#pragma unroll 4
            for (int c = 0; c < 8; ++c) { const int idx = c * 64 + ln_; *(u32x4*)(WN + ub * 8192 + (idx >> 3) * 128 + hf * 64 + (idx & 7) * 8) = *(const LAS u32x4*)(TW + (idx >> 3) * 144 + (idx & 7) * 16); }
            asm volatile("s_waitcnt lgkmcnt(0)" ::: "memory");
        }
        }
        { int ln_ = lane; asm volatile("" : "+v"(ln_)); const int fr = ln_ & 15, q = ln_ >> 4;
        const unsigned tr_lane = (unsigned)(((fr >> 2)) * 288 + (4 * (fr & 3)) * 2);
#pragma unroll
        for (int c = 0; c < 16; ++c) { const int ch = c * 64 + lane, row = ch >> 4, cc = ch & 15; *(LAS u32x4*)(TL + tile_row(row) + cc * 16) = vst[c]; }
        asm volatile("s_waitcnt lgkmcnt(0)" ::: "memory");
        s16x8 Tf[4][2];
#pragma unroll
        for (int it = 0; it < 4; ++it)
#pragma unroll
            for (int s = 0; s < 2; ++s) Tf[it][s] = *(const LAS s16x8*)(TU + (16 * it + fr) * 144 + (32 * s + 8 * q) * 2);
        asm volatile("s_waitcnt lgkmcnt(0)" ::: "memory");
#pragma unroll
        for (int ct = 0; ct < 8; ++ct) { s16x8 vf0, vf1; TR_FRAG(vf0, ct, 0); TR_FRAG(vf1, ct, 1);
#pragma unroll
            for (int it = 0; it < 4; ++it) { f32x4 acc = (f32x4){0.f, 0.f, 0.f, 0.f};
                acc = __builtin_amdgcn_mfma_f32_16x16x32_bf16(Tf[it][0], vf0, acc, 0, 0, 0); acc = __builtin_amdgcn_mfma_f32_16x16x32_bf16(Tf[it][1], vf1, acc, 0, 0, 0);
                u32x2 w; w.x = pk2(acc[0], acc[1]); w.y = pk2(acc[2], acc[3]); *(LAS u32x2*)(TU + (16 * ct + fr) * 144 + (16 * it + 4 * q) * 2) = w; } }
        asm volatile("s_waitcnt lgkmcnt(0)" ::: "memory");
#pragma unroll 4
        for (int c = 0; c < 16; ++c) { const int idx = c * 64 + ln_; *(u32x4*)(UT + ub * 8192 + idx * 8) = *(const LAS u32x4*)(TU + (idx >> 3) * 144 + (idx & 7) * 16); }
        asm volatile("s_waitcnt lgkmcnt(0)" ::: "memory");
        }
#undef TR_FRAG
    }
}

#ifndef MK_N_LAUNCHES
#define MK_N_LAUNCHES 1
#endif
constexpr int NPH = 21;
constexpr int MOE_TAB_OFF = 131072 + 8192;
#ifndef PG8_SP2
#define PG8_SP2 true
#endif
#ifndef PG8_ALIGN
#define PG8_ALIGN true
#endif
__global__ void __launch_bounds__(NTHR, 2) fwd(Args a) {
    extern __shared__ __attribute__((aligned(16))) unsigned char lds_raw[];
    Ctx C; C.lds = (LAS unsigned char*)lds_raw; C.tid = threadIdx.x; C.lane = C.tid & 63; C.wave = __builtin_amdgcn_readfirstlane(C.tid >> 6);
    C.G = gridDim.x; C.bid = blockIdx.x; C.gw = C.bid * NWAVES + C.wave; C.ngw = C.G * NWAVES;
    C.vcu = (C.G % 8 == 0) ? (C.bid % 8) * (C.G / 8) + C.bid / 8 : C.bid;
#define FRESH(Cn) Ctx Cn; { int t_ = threadIdx.x; asm volatile("" : "+v"(t_)); Cn.lds = C.lds; Cn.tid = t_; Cn.lane = t_ & 63; Cn.wave = __builtin_amdgcn_readfirstlane(t_ >> 6); Cn.G = C.G; Cn.bid = C.bid; Cn.vcu = C.vcu; Cn.gw = Cn.bid * NWAVES + Cn.wave; Cn.ngw = C.ngw; }
    volatile LAS unsigned* MISC = (volatile LAS unsigned*)(C.lds + MISC_OFF);
    for (int u = C.tid; u < (LDS_BYTES - LDSCTL_OFF) / 4; u += NTHR) ((LAS unsigned*)(C.lds + LDSCTL_OFF))[u] = 0u;
    __syncthreads();
    const int lo = a.ph_lo, hi = a.ph_hi;
    unsigned* ctl = (unsigned*)(a.ws + WS_CTL);
    XcdBarrier bar; bar.bar = ctl + CW_BAR; bar.x = 0; bar.st = nullptr;
    if (hi - lo > 1) bar = xcd_barrier_post(ctl + CW_BAR, MISC + 8);
#define IN(k) (lo <= (k) && (k) < hi)
#define SEAM(k) do { if (IN(k) && (k) + 1 < hi) xcd_barrier(bar); } while (0)
    PG8_LAS unsigned char* ring = (PG8_LAS unsigned char*)(C.lds + RING_OFF);
    const float* MOD = (const float*)(a.ws + WS_MOD);

    if (IN(0)) { FRESH(Cp) phase_prologue(a, Cp); } SEAM(0);
    if (IN(1)) { FRESH(Cp) phase_norm0(a, Cp); } SEAM(1);
    if (IN(2)) {
        pg8::Gemm g{(const bf16*)(a.ws + WS_A), (const bf16*)(a.ws + WS_WIN0), RT, NZ, D}; pg8::StaticOrder S; S.init(RT, NZ, C.G, C.bid);
        pg8::EpiBf16N E{(bf16*)(a.ws + WS_Z), NZ, 0xffff};
        pg8::gemm_phase<pg8::EpiBf16N, pg8::StaticOrder, PG8_ALIGN, PG8_SP2>(ring, g, S, E);
    } SEAM(2);
    if (IN(3)) { FRESH(Cp) phase_conv(a, Cp); } SEAM(3);
    if (IN(4)) { FRESH(Cp) phase_dn_intra(a, Cp); } SEAM(4);
    if (IN(5)) { FRESH(Cp) phase_dn_scan(a, Cp); } SEAM(5);
    if (IN(6)) { FRESH(Cp) phase_dn_combine(a, Cp); } SEAM(6);
    if (IN(7)) {
        pg8::Gemm g{(const bf16*)(a.ws + WS_MIX), (const bf16*)(a.ws + WS_WOUT0), RT, D, D}; pg8::StaticOrder S; S.init(RT, D, C.G, C.bid);
        pg8::EpiBf16N E{(bf16*)(a.ws + WS_Y), D, 0xffff};
        pg8::gemm_phase<pg8::EpiBf16N, pg8::StaticOrder, PG8_ALIGN, PG8_SP2>(ring, g, S, E);
        { FRESH(Cp) moe_convert(a, Cp, 0, C.G == 256 ? 64 : 0); }
    } SEAM(7);
    if (IN(8)) { FRESH(Cp) phase_ffn_norm_route(a, Cp, 0); } SEAM(8);
    if (IN(10)) {
        int nT; { FRESH(Cp) nT = moe_tables(a, Cp, 0, MOE_TAB_OFF); }
        pg8::Gemm g{(const bf16*)(a.ws + WS_A), (const bf16*)(a.ws + WS_WUP), 0, 0, D}; pg8::MoeOrder S{(const PG8_LAS int*)(C.lds + MOE_TAB_OFF), nT, C.G, C.vcu, (const int*)(a.ws + WS_ROWSE), RT};
        pg8::EpiSwiGLU E{(bf16*)(a.ws + WS_HG)};
        pg8::gemm_phase<pg8::EpiSwiGLU, pg8::MoeOrder, PG8_ALIGN, PG8_SP2, true>(ring, g, S, E);
    } SEAM(10);
    if (IN(11)) {
        int nT; { FRESH(Cp) nT = moe_tables(a, Cp, 0, MOE_TAB_OFF); }
        pg8::Gemm g{(const bf16*)(a.ws + WS_HG), (const bf16*)(a.ws + WS_WDN), 0, 0, 512}; pg8::MoeOrder S{(const PG8_LAS int*)(C.lds + MOE_TAB_OFF), nT, C.G, C.vcu, nullptr, RT};
        pg8::EpiBf16N E{(bf16*)(a.ws + WS_YG), D, 3};
        pg8::gemm_phase<pg8::EpiBf16N, pg8::MoeOrder, PG8_ALIGN, PG8_SP2>(ring, g, S, E);
    } SEAM(11);
    if (IN(12)) { FRESH(Cp) phase_moe_combine(a, Cp, 0); } SEAM(12);
    if (IN(13)) {
        pg8::Gemm g{(const bf16*)(a.ws + WS_A), (const bf16*)(a.ws + WS_WIN1), RT, 1536, D}; pg8::QkvOrder S{C.G, C.vcu};
        pg8::EpiRope E{(bf16*)(a.ws + WS_Q1), (bf16*)(a.ws + WS_K1), (bf16*)(a.ws + WS_V1), (const float*)(a.ws + WS_COS), (const float*)(a.ws + WS_SIN)};
        pg8::gemm_phase<pg8::EpiRope, pg8::QkvOrder, PG8_ALIGN, PG8_SP2>(ring, g, S, E);
        { FRESH(Cp) Cp.bid = C.vcu; moe_convert(a, Cp, 1, C.G == 256 ? 32 : 0); }
    } SEAM(13);
    if (IN(14)) { FRESH(Cp) phase_attn(a, Cp); } SEAM(14);
    if (IN(15)) {
        pg8::Gemm g{(const bf16*)(a.ws + WS_O1), (const bf16*)(a.ws + WS_WOUT1), RL, D, D}; pg8::StaticOrder S; S.init(RL, D, C.G, C.bid);
        pg8::EpiBf16N E{(bf16*)(a.ws + WS_Y), D, 0xffff};
        pg8::gemm_phase<pg8::EpiBf16N, pg8::StaticOrder, PG8_ALIGN, PG8_SP2>(ring, g, S, E);
    } SEAM(15);
    if (IN(16)) { FRESH(Cp) phase_ffn_norm_route(a, Cp, 1); } SEAM(16);
    if (IN(18)) {
        int nT; { FRESH(Cp) nT = moe_tables(a, Cp, 1, MOE_TAB_OFF); }
        pg8::Gemm g{(const bf16*)(a.ws + WS_A), (const bf16*)(a.ws + WS_WUP), 0, 0, D}; pg8::MoeOrder S{(const PG8_LAS int*)(C.lds + MOE_TAB_OFF), nT, C.G, C.vcu, (const int*)(a.ws + WS_ROWSE), RT};
        pg8::EpiSwiGLU E{(bf16*)(a.ws + WS_HG)};
        pg8::gemm_phase<pg8::EpiSwiGLU, pg8::MoeOrder, PG8_ALIGN, PG8_SP2, true>(ring, g, S, E);
    } SEAM(18);
    if (IN(19)) {
        int nT; { FRESH(Cp) nT = moe_tables(a, Cp, 1, MOE_TAB_OFF); }
        pg8::Gemm g{(const bf16*)(a.ws + WS_HG), (const bf16*)(a.ws + WS_WDN), 0, 0, 512}; pg8::MoeOrder S{(const PG8_LAS int*)(C.lds + MOE_TAB_OFF), nT, C.G, C.vcu, nullptr, RT};
        pg8::EpiBf16N E{(bf16*)(a.ws + WS_YG), D, 3};
        pg8::gemm_phase<pg8::EpiBf16N, pg8::MoeOrder, PG8_ALIGN, PG8_SP2>(ring, g, S, E);
    } SEAM(19);
    if (IN(20)) { FRESH(Cp) phase_moe_combine(a, Cp, 1); }
#undef IN
#undef SEAM
}

extern "C" void kernel_launch(void* const* d_in, const int* in_sizes, int n_in, void* d_out, int out_size, void* d_ws, size_t ws_size, hipStream_t stream) {
    static int grid = 0;
    if (grid == 0) {
        if (n_in != 24 || in_sizes[0] != RL * D || out_size != RL * D || ws_size < WS_END) { fprintf(stderr, "kernel_launch: unexpected shapes: n_in %d in0 %d out %d ws %zu (need %zu)\n", n_in, n_in > 0 ? in_sizes[0] : -1, out_size, ws_size, (size_t)WS_END); grid = -1; return; }
        int dev = 0, cus = 0;
        if (hipGetDevice(&dev) != hipSuccess || hipDeviceGetAttribute(&cus, hipDeviceAttributeMultiprocessorCount, dev) != hipSuccess) { grid = -1; return; }
        if (hipFuncSetAttribute((const void*)fwd, hipFuncAttributeMaxDynamicSharedMemorySize, LDS_BYTES) != hipSuccess) { fprintf(stderr, "kernel_launch: hipFuncSetAttribute failed\n"); grid = -1; return; }
        int per_cu = 0;
        if (hipOccupancyMaxActiveBlocksPerMultiprocessor(&per_cu, (const void*)fwd, NTHR, LDS_BYTES) != hipSuccess || per_cu < 1) fprintf(stderr, "kernel_launch: occupancy query reports %d\n", per_cu);
        (void)hipGetLastError();
        grid = cus;
    }
    if (grid < 0) return;
    if (hipMemsetAsync((char*)d_ws + WS_CTL, 0, CTL_ZERO_BYTES, stream) != hipSuccess) return;
    Args a{};
    const float** f = (const float**)&a;
    for (int i = 0; i < 24; ++i) f[i] = (const float*)d_in[i];
    a.out = (float*)d_out; a.ws = (unsigned char*)d_ws;
    for (int li = 0; li < MK_N_LAUNCHES; ++li) {
        a.ph_lo = (MK_N_LAUNCHES == 1) ? 0 : li; a.ph_hi = (MK_N_LAUNCHES == 1) ? NPH : li + 1;
        hipLaunchKernelGGL(fwd, dim3(grid), dim3(NTHR), LDS_BYTES, stream, a);
    }
}
```

```cpp
#include <hip/hip_runtime.h>
#include <cstdio>
#include <cstdint>
namespace pg8 {
#define PG8_LAS __attribute__((address_space(3)))
typedef unsigned short bf16_t;
typedef short bf16x8 __attribute__((ext_vector_type(8)));
typedef float f32x4 __attribute__((ext_vector_type(4)));
typedef unsigned u32x4 __attribute__((ext_vector_type(4)));
typedef unsigned u32x2 __attribute__((ext_vector_type(2)));
constexpr int BM = 256, BK = 64, HALF = 128, HTB = HALF * BK * 2  , STAGE_BYTES = 8 * HTB, NXCD = 8, WGM = 8;

__host__ __device__ __forceinline__ int lds_byte(int r, int c) { const int st = (r >> 4) * 2 + (c >> 5), rr = r & 15, cc = c & 31, ob = rr * 64 + cc * 2; return st * 1024 + (ob ^ (((ob >> 9) & 1) << 5)); }
__host__ __device__ __forceinline__ void stage_rc(int b, int& R, int& C) { const int st = b / 1024, sb = b % 1024, swz = sb ^ (((sb >> 9) & 1) << 5); R = (st >> 1) * 16 + swz / 64; C = (st & 1) * 32 + (swz % 64) / 2; }
__host__ __device__ __forceinline__ int perm32(int rho) { const int n = rho >> 4, i = rho & 15; return 8 * (i >> 2) + 4 * n + (i & 3); }

struct Unit { int pm, pn; };
struct Gemm { const bf16_t* A; const bf16_t* Bt; int M, N, K; };

struct StaticOrder {
    int nM, nN, nwg, G, c;
    __host__ __device__ void init(int M, int N, int G_, int c_) { nM = M / BM; nN = N / BM; nwg = nM * nN; G = G_; c = c_; }
    __host__ __device__ bool next(int i, Unit& u) const {
        const long L = (long)i * G + c; if (L >= nwg) return false;
        int wgid = (int)L; { const int q = nwg / NXCD, r = nwg % NXCD, xcd = wgid % NXCD, off = wgid / NXCD; wgid = (xcd < r ? xcd * (q + 1) : r * (q + 1) + (xcd - r) * q) + off; }
        const int nig = WGM * nN, gid = wgid / nig, fm = gid * WGM, gsz = (nM - fm) < WGM ? (nM - fm) : WGM;
        u.pm = fm + ((wgid % nig) % gsz); u.pn = (wgid % nig) / gsz; return true;
    }
    __device__ __forceinline__ void a_ready(const Unit&) const {}
    __device__ __forceinline__ void done(const Unit&) const {}
};

typedef float f32x2c __attribute__((ext_vector_type(2)));
typedef __bf16 bf16x2c __attribute__((ext_vector_type(2)));
__device__ __forceinline__ unsigned cvt_pk_bf16(float lo, float hi) { const f32x2c v = {lo, hi}; const bf16x2c b = __builtin_convertvector(v, bf16x2c); return __builtin_bit_cast(unsigned, b); }
__device__ __forceinline__ float silu_f(float x) { return x * __builtin_amdgcn_rcpf(1.0f + __expf(-x)); }

struct EpiBf16N {
    static constexpr bool PERM = true, AFTER_DRAIN = false;
    bf16_t* O; int ldc; int pnmask;
    __device__ __forceinline__ void operator()(const f32x4 (&acc)[2][2][4][2], const Unit& u, int wr, int wc, int fr, int fq) const {
        const int row0 = u.pm * BM + wr * 64 + fr; const int col0 = (u.pn & pnmask) * BM + wc * 32 + 8 * fq;
#pragma unroll
        for (int ai = 0; ai < 2; ++ai)
#pragma unroll
            for (int m = 0; m < 4; ++m) { bf16_t* rowp = O + (size_t)(row0 + ai * HALF + m * 16) * ldc + col0;
#pragma unroll
                for (int bj = 0; bj < 2; ++bj) { const f32x4 v0 = acc[ai][bj][m][0], v1 = acc[ai][bj][m][1];
                    u32x4 w; w.x = cvt_pk_bf16(v0[0], v0[1]); w.y = cvt_pk_bf16(v0[2], v0[3]); w.z = cvt_pk_bf16(v1[0], v1[1]); w.w = cvt_pk_bf16(v1[2], v1[3]);
                    *(u32x4*)(rowp + bj * HALF) = w; } }
    }
};
struct EpiSwiGLU {
    static constexpr bool PERM = true, AFTER_DRAIN = false;
    bf16_t* O;
    __device__ __forceinline__ void operator()(const f32x4 (&acc)[2][2][4][2], const Unit& u, int wr, int wc, int fr, int fq) const {
        const int row0 = u.pm * BM + wr * 64 + fr; const int col0 = (u.pn & 3) * 128 + wc * 16 + 4 * fq;
#pragma unroll
        for (int ai = 0; ai < 2; ++ai)
#pragma unroll
            for (int m = 0; m < 4; ++m) { bf16_t* rowp = O + (size_t)(row0 + ai * HALF + m * 16) * 512 + col0;
#pragma unroll
                for (int bj = 0; bj < 2; ++bj) { const f32x4 a = acc[ai][bj][m][0], b = acc[ai][bj][m][1];
                    u32x2 w; w.x = cvt_pk_bf16(silu_f(a[0]) * b[0], silu_f(a[1]) * b[1]); w.y = cvt_pk_bf16(silu_f(a[2]) * b[2], silu_f(a[3]) * b[3]);
                    *(u32x2*)(rowp + bj * 64) = w; } }
    }
};
struct EpiResid {
    static constexpr bool PERM = false, AFTER_DRAIN = false;
    const float* resid_ctx; const float* resid_lat; float* out_ctx; float* out_lat; const float* mod; int ctx_rows;
    __device__ __forceinline__ void operator()(const f32x4 (&acc)[2][2][4][2], const Unit& u, int wr, int wc, int fr, int fq) const {
        const int rt = u.pm * BM; const float* rs; float* op; const float* gp; int rbase;
        if (rt < ctx_rows) { rs = resid_ctx; op = out_ctx; gp = mod + 16 * 6144; rbase = rt; }
        else { rbase = rt - ctx_rows; rs = resid_lat; op = out_lat; gp = mod + (size_t)(rbase >> 11) * 6144; }
        const int col0 = u.pn * BM + wc * 32 + 4 * fq;
        f32x4 gv[2][2];
#pragma unroll
        for (int bj = 0; bj < 2; ++bj)
#pragma unroll
            for (int n = 0; n < 2; ++n) gv[bj][n] = *(const f32x4*)(gp + col0 + bj * HALF + n * 16);
#pragma unroll
        for (int ai = 0; ai < 2; ++ai)
#pragma unroll
            for (int m = 0; m < 4; ++m) { const size_t off = (size_t)(rbase + wr * 64 + fr + ai * HALF + m * 16) * 1024 + col0;
#pragma unroll
                for (int bj = 0; bj < 2; ++bj)
#pragma unroll
                    for (int n = 0; n < 2; ++n) { const f32x4 r = *(const f32x4*)(rs + off + bj * HALF + n * 16);
                        *(f32x4*)(op + off + bj * HALF + n * 16) = r + gv[bj][n] * acc[ai][bj][m][n]; } }
    }
};
struct EpiRope {
    static constexpr bool PERM = false, AFTER_DRAIN = false;
    bf16_t* Q; bf16_t* K; bf16_t* V; const float* ctab; const float* stab;
    __device__ __forceinline__ void operator()(const f32x4 (&acc)[2][2][4][2], const Unit& u, int wr, int wc, int fr, int fq) const {
        const int rt = u.pm * BM; const bool lat = rt >= 4096;
#pragma unroll
        for (int ai = 0; ai < 2; ++ai)
#pragma unroll
            for (int m = 0; m < 4; ++m) { const int r = rt + ai * HALF + wr * 64 + m * 16 + fr;
                f32x4 cs = (f32x4){1.f, 1.f, 1.f, 1.f}, sn = (f32x4){0.f, 0.f, 0.f, 0.f};
                if (lat && u.pn < 5) { const int t = (r - 4096) & 2047; const int pos = (wc & 1) ? (t & 63) : (t >> 6);
                    cs = *(const f32x4*)(ctab + pos * 16 + 4 * fq); sn = *(const f32x4*)(stab + pos * 16 + 4 * fq); }
#pragma unroll
                for (int bj = 0; bj < 2; ++bj) { const f32x4 u1 = acc[ai][bj][m][0], u2 = acc[ai][bj][m][1];
                    f32x4 o1 = u1 * cs - u2 * sn, o2 = u1 * sn + u2 * cs;
                    const int lc = bj * HALF + wc * 32 + 4 * fq; bf16_t* p;
                    if (u.pn < 4) { o1 = o1 * 0.18033688011112042f; o2 = o2 * 0.18033688011112042f;     p = Q + (size_t)(r - 4096) * 1024 + u.pn * BM + lc; }
                    else if (u.pn == 4) p = K + (size_t)r * 256 + lc;
                    else p = V + (size_t)r * 256 + lc;
                    u32x2 w1, w2; w1.x = cvt_pk_bf16(o1[0], o1[1]); w1.y = cvt_pk_bf16(o1[2], o1[3]); w2.x = cvt_pk_bf16(o2[0], o2[1]); w2.y = cvt_pk_bf16(o2[2], o2[3]);
                    *(u32x2*)p = w1; *(u32x2*)(p + 16) = w2; } }
    }
};
struct MoeOrder {
    const PG8_LAS int* tab; int nT, G, c; const int* rowse;
    int cap;
    __device__ __forceinline__ bool next(int i, Unit& u) const { const long L = (long)i * G + c; if (L >= (long)nT * 4) return false; const int pm = (int)(L >> 2); u.pm = pm; u.pn = tab[128 + pm] * 4 + (int)(L & 3); return true; }
    __device__ __forceinline__ int row(int pm, int r) const { const int e = tab[128 + pm], idx = pm * 256 - tab[32 + e] + r; return rowse[(size_t)e * cap + (idx < tab[e] ? idx : 0)]; }
    __device__ __forceinline__ void a_ready(const Unit&) const {}
    __device__ __forceinline__ void done(const Unit&) const {}
};
struct QkvOrder {
    int G, c;
    __device__ __forceinline__ bool next(int i, Unit& u) const { const long L = (long)i * G + c; if (L < 768) { u.pm = 16 + (int)(L / 6); u.pn = (int)(L % 6); return true; }
        if (L < 800) { u.pm = (int)(L - 768) >> 1; u.pn = 4 + ((int)(L - 768) & 1); return true; } return false; }
    __device__ __forceinline__ void a_ready(const Unit&) const {}
    __device__ __forceinline__ void done(const Unit&) const {}
};
struct LatOrder {
    int nM, nN, G, c;
    __device__ __forceinline__ bool next(int i, Unit& u) const { const long L = (long)i * G + c; if (L >= (long)nM * nN) return false; u.pm = (int)(L / nN); u.pn = (int)(L % nN); return true; }
    __device__ __forceinline__ void a_ready(const Unit&) const {}
    __device__ __forceinline__ void done(const Unit&) const {}
};
template <class Epi, class Sched, bool ALIGN_EPI = false, bool SP2 = false, bool GATHER = false>
__device__ __forceinline__ void gemm_phase(PG8_LAS unsigned char* lds, const Gemm g, const Sched& S, const Epi& E) {
    int tid_ = threadIdx.x; asm volatile("" : "+v"(tid_));
    const int tid = tid_, wid = __builtin_amdgcn_readfirstlane(tid >> 6), lane = tid & 63, wr = wid >> 2, wc = wid & 3, fr = lane & 15, fq = lane >> 4;
    const int K = g.K, nt = K / BK;
    unsigned voffA[2], voffB[2];
#pragma unroll
    for (int i = 0; i < 2; ++i) { int R, C; stage_rc(tid * 16 + i * 8192, R, C); const int Rb = Epi::PERM ? ((R & ~31) + perm32(R & 31)) : R;
        voffA[i] = (unsigned)(R * K + C) * 2u; voffB[i] = (unsigned)(Rb * K + C) * 2u; }
    const size_t kstep = (size_t)(BK * 2);
    const size_t hstep = (size_t)HALF * K * 2;
    const size_t tstep = 2 * hstep;
    const size_t hstepA = GATHER ? 0 : hstep;
    const unsigned ldsw = (unsigned)wid * 1024u;
    const int aoff = lds_byte(wr * 64 + fr, fq * 8), boff = lds_byte(wc * 32 + fr, fq * 8);
#define PG8_SA(b, h) (((b) * 2 + (h)) * HTB)
#define PG8_SB(b, h) ((4 + (b) * 2 + (h)) * HTB)
#define PG8_STAGE(bufoff, gbase, voff) do { _Pragma("unroll") for (int _i = 0; _i < 2; ++_i) \
        __builtin_amdgcn_global_load_lds((const unsigned*)((const char*)(gbase) + (voff)[_i]), (PG8_LAS unsigned*)(lds + (bufoff) + ldsw + _i * 8192), 16, 0, 0); } while (0)
#define PG8_LDA(dst, b, h) do { _Pragma("unroll") for (int m = 0; m < 4; ++m) _Pragma("unroll") for (int k = 0; k < 2; ++k) dst[m][k] = *(const PG8_LAS bf16x8*)(lds + PG8_SA(b, h) + aoff + m * 2048 + k * 1024); } while (0)
#define PG8_LDB(dst, b, h) do { _Pragma("unroll") for (int n = 0; n < 2; ++n) _Pragma("unroll") for (int k = 0; k < 2; ++k) dst[n][k] = *(const PG8_LAS bf16x8*)(lds + PG8_SB(b, h) + boff + n * 2048 + k * 1024); } while (0)
#define PG8_MMA(ai, bj, At, Bt) do { __builtin_amdgcn_s_setprio(1); _Pragma("unroll") for (int m = 0; m < 4; ++m) _Pragma("unroll") for (int n = 0; n < 2; ++n) _Pragma("unroll") for (int k = 0; k < 2; ++k) \
        acc[ai][bj][m][n] = __builtin_amdgcn_mfma_f32_16x16x32_bf16(Bt[n][k], At[m][k], acc[ai][bj][m][n], 0, 0, 0); __builtin_amdgcn_s_setprio(0); } while (0)
#define PG8_WAIT_V(n) asm volatile("s_waitcnt vmcnt(" #n ")" ::: "memory")
#define PG8_WAIT_L(n) asm volatile("s_waitcnt lgkmcnt(" #n ")" ::: "memory")
#define PG8_BAR __builtin_amdgcn_s_barrier()
#define PG8_SCHED __builtin_amdgcn_sched_barrier(0)
    Unit cur, nxt; int ui = 0;
    if (!S.next(0, cur)) return;
    f32x4 acc[2][2][4][2];
#pragma unroll
    for (int a = 0; a < 2; ++a)
#pragma unroll
        for (int b = 0; b < 2; ++b)
#pragma unroll
            for (int m = 0; m < 4; ++m)
#pragma unroll
                for (int n = 0; n < 2; ++n) acc[a][b][m][n] = (f32x4){0.f, 0.f, 0.f, 0.f};
    bf16x8 At[4][2], B0[2][2], B1[2][2];
    const char* cA = (const char*)g.A + (GATHER ? (size_t)0 : (size_t)cur.pm * tstep); const char* cB = (const char*)g.Bt + (size_t)cur.pn * tstep;
    unsigned vC[2][2], vN[2][2], v2[2][2];
    int RA[2], CA[2];
#pragma unroll
    for (int i = 0; i < 2; ++i) stage_rc(tid * 16 + i * 8192, RA[i], CA[i]);
    PG8_LAS int* lrows = (PG8_LAS int*)(lds + STAGE_BYTES);
    if constexpr (GATHER) {
        Unit uu; for (int i = 0; i < 8 && S.next(i, uu); ++i) { if (tid < 256) lrows[i * 256 + tid] = S.row(uu.pm, tid); }
        __syncthreads();
#pragma unroll
        for (int h = 0; h < 2; ++h)
#pragma unroll
            for (int i = 0; i < 2; ++i) vC[h][i] = (unsigned)lrows[h * 128 + RA[i]] * (unsigned)(K * 2) + (unsigned)(CA[i] * 2);
    } else {
#pragma unroll
        for (int h = 0; h < 2; ++h)
#pragma unroll
            for (int i = 0; i < 2; ++i) vC[h][i] = voffA[i];
    }
#pragma unroll
    for (int h = 0; h < 2; ++h)
#pragma unroll
        for (int i = 0; i < 2; ++i) { vN[h][i] = vC[h][i]; v2[h][i] = vC[h][i]; }
    S.a_ready(cur);
    if constexpr (SP2) {
        PG8_STAGE(PG8_SB(0, 0), cB, voffB); PG8_STAGE(PG8_SB(0, 1), cB + hstep, voffB); PG8_STAGE(PG8_SA(0, 0), cA, vC[0]); PG8_STAGE(PG8_SA(0, 1), cA + hstepA, vC[1]);
        if (wr == 1) PG8_BAR;
        PG8_WAIT_V(2); PG8_BAR;
        PG8_STAGE(PG8_SB(1, 0), cB + kstep, voffB); PG8_STAGE(PG8_SA(1, 0), cA + kstep, vC[0]); PG8_STAGE(PG8_SB(1, 1), cB + hstep + kstep, voffB);
        PG8_WAIT_V(6); PG8_BAR;
    } else {
        PG8_STAGE(PG8_SB(0, 0), cB, voffB); PG8_STAGE(PG8_SA(0, 0), cA, vC[0]); PG8_STAGE(PG8_SB(0, 1), cB + hstep, voffB); PG8_STAGE(PG8_SA(0, 1), cA + hstepA, vC[1]);
        if (wr == 1) PG8_BAR;
        PG8_WAIT_V(4); PG8_BAR;
        PG8_STAGE(PG8_SB(1, 0), cB + kstep, voffB); PG8_STAGE(PG8_SA(1, 0), cA + kstep, vC[0]); PG8_STAGE(PG8_SB(1, 1), cB + hstep + kstep, voffB);
        PG8_WAIT_V(6); PG8_BAR;
    }
    for (;;) {
        const bool has_next = S.next(ui + 1, nxt);
        const char* nA = (has_next && !GATHER) ? (const char*)g.A + (size_t)nxt.pm * tstep : cA; const char* nB = has_next ? (const char*)g.Bt + (size_t)nxt.pn * tstep : cB;
        if constexpr (GATHER) { if (has_next) {
#pragma unroll
            for (int h = 0; h < 2; ++h)
#pragma unroll
                for (int i = 0; i < 2; ++i) vN[h][i] = (unsigned)lrows[(ui + 1) * 256 + h * 128 + RA[i]] * (unsigned)(K * 2) + (unsigned)(CA[i] * 2); } }
        for (int t = 0; t < nt; t += 2) {
            const bool last = (t == nt - 2);
            const char* a1 = cA + (size_t)(t + 1) * kstep;
            const char* a2 = last ? nA : cA + (size_t)(t + 2) * kstep; const char* b2 = last ? nB : cB + (size_t)(t + 2) * kstep;
            const char* a3 = a2 + kstep; const char* b3 = b2 + kstep;
            if constexpr (GATHER) {
#pragma unroll
                for (int h = 0; h < 2; ++h)
#pragma unroll
                    for (int i = 0; i < 2; ++i) v2[h][i] = (last && has_next) ? vN[h][i] : vC[h][i]; }
            if (last && has_next) S.a_ready(nxt);
            if constexpr (SP2) {
            PG8_LDB(B0, 0, 0); PG8_LDB(B1, 0, 1); PG8_SCHED; PG8_LDA(At, 0, 0); PG8_STAGE(PG8_SA(1, 1), a1 + hstepA, vC[1]);
            PG8_WAIT_V(8); PG8_WAIT_L(0); PG8_BAR; PG8_MMA(0, 0, At, B0); PG8_MMA(0, 1, At, B1); PG8_BAR; PG8_SCHED;
            PG8_LDA(At, 0, 1); PG8_STAGE(PG8_SB(0, 0), b2, voffB); PG8_STAGE(PG8_SB(0, 1), b2 + hstep, voffB); PG8_STAGE(PG8_SA(0, 0), a2, v2[0]);
            PG8_WAIT_V(8); PG8_WAIT_L(0); PG8_BAR; PG8_MMA(1, 0, At, B0); PG8_MMA(1, 1, At, B1); PG8_BAR; PG8_SCHED;
            PG8_LDB(B0, 1, 0); PG8_LDB(B1, 1, 1); PG8_SCHED; PG8_LDA(At, 1, 0); PG8_STAGE(PG8_SA(0, 1), a2 + hstepA, v2[1]);
            PG8_WAIT_V(8); PG8_WAIT_L(0); PG8_BAR; PG8_MMA(0, 0, At, B0); PG8_MMA(0, 1, At, B1); PG8_BAR; PG8_SCHED;
            PG8_LDA(At, 1, 1); PG8_STAGE(PG8_SB(1, 0), b3, voffB); PG8_STAGE(PG8_SB(1, 1), b3 + hstep, voffB); PG8_STAGE(PG8_SA(1, 0), a3, v2[0]);
            PG8_WAIT_V(8); PG8_WAIT_L(0); PG8_BAR; PG8_MMA(1, 0, At, B0); PG8_MMA(1, 1, At, B1); PG8_BAR; PG8_SCHED;
            } else {
            PG8_LDB(B0, 0, 0); PG8_SCHED; PG8_LDA(At, 0, 0); PG8_STAGE(PG8_SA(1, 1), a1 + hstepA, vC[1]);
            PG8_WAIT_L(8); PG8_BAR; PG8_WAIT_L(0); PG8_MMA(0, 0, At, B0); PG8_BAR; PG8_SCHED;
            PG8_LDB(B1, 0, 1); PG8_STAGE(PG8_SB(0, 0), b2, voffB);
            PG8_BAR; PG8_WAIT_L(0); PG8_MMA(0, 1, At, B1); PG8_BAR;
            PG8_LDA(At, 0, 1); PG8_STAGE(PG8_SA(0, 0), a2, v2[0]);
            PG8_BAR; PG8_WAIT_L(0); PG8_MMA(1, 0, At, B0); PG8_BAR; PG8_SCHED;
            PG8_STAGE(PG8_SB(0, 1), b2 + hstep, voffB);
            PG8_WAIT_V(6); PG8_BAR; PG8_MMA(1, 1, At, B1); PG8_BAR;
            PG8_LDB(B0, 1, 0); PG8_SCHED; PG8_LDA(At, 1, 0); PG8_STAGE(PG8_SA(0, 1), a2 + hstepA, v2[1]);
            PG8_WAIT_L(8); PG8_BAR; PG8_WAIT_L(0); PG8_MMA(0, 0, At, B0); PG8_BAR; PG8_SCHED;
            PG8_LDB(B1, 1, 1); PG8_STAGE(PG8_SB(1, 0), b3, voffB);
            PG8_BAR; PG8_WAIT_L(0); PG8_MMA(0, 1, At, B1); PG8_BAR;
            PG8_LDA(At, 1, 1); PG8_STAGE(PG8_SA(1, 0), a3, v2[0]);
            PG8_BAR; PG8_WAIT_L(0); PG8_MMA(1, 0, At, B0); PG8_BAR; PG8_SCHED;
            PG8_STAGE(PG8_SB(1, 1), b3 + hstep, voffB);
            PG8_WAIT_V(6); PG8_BAR; PG8_MMA(1, 1, At, B1); PG8_BAR;
            }
        }
        if constexpr (ALIGN_EPI) { if (wr == 0) PG8_BAR; }
        if constexpr (!Epi::AFTER_DRAIN) { E(acc, cur, wr, wc, fr, fq); S.done(cur); }
        if (!has_next) break;
#pragma unroll
        for (int a = 0; a < 2; ++a)
#pragma unroll
            for (int b = 0; b < 2; ++b)
#pragma unroll
                for (int m = 0; m < 4; ++m)
#pragma unroll
                    for (int n = 0; n < 2; ++n) acc[a][b][m][n] = (f32x4){0.f, 0.f, 0.f, 0.f};
        cur = nxt; cA = nA; cB = nB; ++ui;
        if constexpr (GATHER) {
#pragma unroll
            for (int h = 0; h < 2; ++h)
#pragma unroll
                for (int i = 0; i < 2; ++i) vC[h][i] = vN[h][i]; }
        if constexpr (ALIGN_EPI) { if (wr == 1) PG8_BAR; }
    }
    PG8_WAIT_V(0);
    if constexpr (!ALIGN_EPI) { if (wr == 0) PG8_BAR; }
    PG8_BAR;
    if constexpr (Epi::AFTER_DRAIN) { E.fused(acc, cur, wr, wc, fr, fq, lds, wid, lane); S.done(cur); }
#undef PG8_SA
#undef PG8_SB
#undef PG8_STAGE
#undef PG8_LDA
#undef PG8_LDB
#undef PG8_MMA
#undef PG8_WAIT_V
#undef PG8_WAIT_L
#undef PG8_BAR
#undef PG8_SCHED
}
}

constexpr int NWAVES = 8, NTHR = 512;
constexpr int D = 1024, NB = 16, SEQ = 2048, LCTX = 256;
constexpr int RC = NB * LCTX;
constexpr int RL = NB * SEQ;
constexpr int RT = RC + RL;
constexpr int NZ = 3584;
constexpr int NUNIT = (RT / 64) * 8;
constexpr float EPS = 1e-6f;

constexpr size_t MiB = 1u << 20;
constexpr size_t WS_CTL = 0, CTL_ZERO_BYTES = 1 * MiB;
constexpr size_t WS_MOD = 1 * MiB;
constexpr size_t WS_TAB = 2 * MiB;
constexpr size_t WS_COS = WS_TAB, WS_SIN = WS_TAB + 4096, WS_WAB = WS_TAB + 65536  , WS_WR = WS_TAB + 131072  , WS_TILE = WS_TAB + 131072 + 393216  ;
constexpr size_t WS_LA = 3 * MiB, WS_BT = 5 * MiB;
constexpr size_t WS_WIN0 = 8 * MiB, WS_WOUT0 = 15 * MiB, WS_WIN1 = 17 * MiB, WS_WOUT1 = 20 * MiB;
constexpr size_t WS_HCTX = 22 * MiB;
constexpr size_t WS_AB = 38 * MiB;
constexpr size_t WS_ASG = 41 * MiB;
constexpr size_t WS_ROWSE = 540 * MiB;
constexpr size_t WS_GL = 43 * MiB;
constexpr size_t WS_GE = 44 * MiB;
constexpr size_t WS_WUP = 48 * MiB, WS_WDN = 112 * MiB;
constexpr size_t WS_A = 144 * MiB;
constexpr size_t WS_Z = 216 * MiB;
constexpr size_t WS_U = 144 * MiB, WS_W = 216 * MiB, WS_QD = 288 * MiB, WS_KD = 360 * MiB, WS_QK = 432 * MiB;
constexpr size_t WS_Y = 380 * MiB;
constexpr size_t WS_MIX = 468 * MiB;
constexpr size_t WS_XG = 216 * MiB, WS_HG = 376 * MiB, WS_YG = 216 * MiB;
constexpr size_t WS_Q1 = 216 * MiB, WS_K1 = 280 * MiB, WS_V1 = 298 * MiB, WS_O1 = 316 * MiB;
constexpr size_t WS_END = 545 * MiB;
constexpr int CW_TMO = 0, CW_BAR = 4096, CW_CNT = 8192;

constexpr int RING_OFF = 0, RING_BYTES = 131072;
constexpr int LDS_BYTES = 163840;
constexpr int LDSCTL_OFF = LDS_BYTES - 128, MISC_OFF = LDSCTL_OFF;

#define GAS __attribute__((address_space(1)))
#define LAS __attribute__((address_space(3)))
typedef unsigned short bf16;
typedef unsigned u32x4 __attribute__((ext_vector_type(4)));
typedef unsigned u32x2 __attribute__((ext_vector_type(2)));
typedef float f32x4 __attribute__((ext_vector_type(4)));
typedef GAS unsigned gu32;
#define RLX_AGENT __ATOMIC_RELAXED, __HIP_MEMORY_SCOPE_AGENT
__device__ __forceinline__ unsigned f2bf(float f) { unsigned u = __builtin_bit_cast(unsigned, f); return (u + 0x7fffu + ((u >> 16) & 1u)) >> 16; }
__device__ __forceinline__ unsigned pk2(float lo, float hi) { return pg8::cvt_pk_bf16(lo, hi); }
__device__ __forceinline__ float bflo(unsigned w) { return __uint_as_float(w << 16); }
__device__ __forceinline__ float bfhi(unsigned w) { return __uint_as_float(w & 0xffff0000u); }
__device__ __forceinline__ float bf2f(bf16 v) { return __uint_as_float((unsigned)v << 16); }
__device__ __forceinline__ void unpack8(const u32x4 v, float (&f)[8]) { f[0] = bflo(v.x); f[1] = bfhi(v.x); f[2] = bflo(v.y); f[3] = bfhi(v.y); f[4] = bflo(v.z); f[5] = bfhi(v.z); f[6] = bflo(v.w); f[7] = bfhi(v.w); }
__device__ __forceinline__ u32x4 pack8(const float (&f)[8]) { u32x4 w; w.x = pk2(f[0], f[1]); w.y = pk2(f[2], f[3]); w.z = pk2(f[4], f[5]); w.w = pk2(f[6], f[7]); return w; }
template <int CTRL> __device__ __forceinline__ float dppf(float x) { return __builtin_bit_cast(float, __builtin_amdgcn_mov_dpp(__builtin_bit_cast(int, x), CTRL, 0xf, 0xf, true)); }
constexpr int DPP_XOR1 = 0xB1, DPP_XOR2 = 0x4E, DPP_HMIR = 0x141, DPP_ROR8 = 0x128, DPP_REV4 = 0x1B;
__device__ __forceinline__ float row16_sum(float x) { x += dppf<DPP_XOR1>(x); x += dppf<DPP_XOR2>(x); x += dppf<DPP_HMIR>(x); x += dppf<DPP_ROR8>(x); return x; }
__device__ __forceinline__ float row16_max(float x) { x = fmaxf(x, dppf<DPP_XOR1>(x)); x = fmaxf(x, dppf<DPP_XOR2>(x)); x = fmaxf(x, dppf<DPP_HMIR>(x)); x = fmaxf(x, dppf<DPP_ROR8>(x)); return x; }
__device__ __forceinline__ float xor16_sum(float x) { auto s = __builtin_amdgcn_permlane16_swap(__float_as_uint(x), __float_as_uint(x), false, false); return __uint_as_float(s[0]) + __uint_as_float(s[1]); }
__device__ __forceinline__ float xor32_sum(float x) { auto s = __builtin_amdgcn_permlane32_swap(__float_as_uint(x), __float_as_uint(x), false, false); return __uint_as_float(s[0]) + __uint_as_float(s[1]); }
__device__ __forceinline__ float xor16_max(float x) { auto s = __builtin_amdgcn_permlane16_swap(__float_as_uint(x), __float_as_uint(x), false, false); return fmaxf(__uint_as_float(s[0]), __uint_as_float(s[1])); }
__device__ __forceinline__ float xor32_max(float x) { auto s = __builtin_amdgcn_permlane32_swap(__float_as_uint(x), __float_as_uint(x), false, false); return fmaxf(__uint_as_float(s[0]), __uint_as_float(s[1])); }
__device__ __forceinline__ float lane_xor16(float x, int lane) { auto s = __builtin_amdgcn_permlane16_swap(__float_as_uint(x), __float_as_uint(x), false, false); return __uint_as_float((lane & 16) ? s[0] : s[1]); }
__device__ __forceinline__ float lane_xor32(float x, int lane) { auto s = __builtin_amdgcn_permlane32_swap(__float_as_uint(x), __float_as_uint(x), false, false); return __uint_as_float((lane & 32) ? s[0] : s[1]); }
__device__ __forceinline__ float wave_sum(float v) { return xor32_sum(xor16_sum(row16_sum(v))); }
__device__ __forceinline__ float wave_max(float v) { return xor32_max(xor16_max(row16_max(v))); }
__device__ __forceinline__ float silu(float x) { return x * __builtin_amdgcn_rcpf(1.0f + __expf(-x)); }
__device__ __forceinline__ void row_info(int m, int& modrow, int& t, int& L) { if (m < RC) { modrow = 16; t = m & 255; L = LCTX; } else { const int mm = m - RC; modrow = mm >> 11; t = mm & 2047; L = SEQ; } }

#define XB_TMO      128
#define XB_XCNT(j)  (256  + 64 * (j))
#define XB_XSUB(j)  (1280 + 64 * (j))
#define XB_XGEN(j)  (2304 + 64 * (j))
#define XB_TOP      3328
#define XB_TOPGEN   3392
#define XCD_BAR_WORDS 3456
#define XB_SPIN_CAP (1u << 18)
__device__ __forceinline__ unsigned xb_ld(unsigned* p)              { return __hip_atomic_load(p, __ATOMIC_RELAXED, __HIP_MEMORY_SCOPE_AGENT); }
__device__ __forceinline__ unsigned xb_add(unsigned* p, unsigned v) { return __hip_atomic_fetch_add(p, v, __ATOMIC_RELAXED, __HIP_MEMORY_SCOPE_AGENT); }
__device__ __forceinline__ unsigned xb_xcc_id() { return (unsigned)__builtin_amdgcn_s_getreg((3 << 11) | 20) & 0xFu; }
#define XB_SPIN(cond, bar) do { unsigned _sp = 0; while (cond) { __builtin_amdgcn_s_sleep(1); \
    if ((++_sp & 255u) == 0u) { if (xb_ld(&(bar)[XB_TMO])) break; if (_sp > XB_SPIN_CAP) { atomicAdd(&(bar)[XB_TMO], 1u); break; } } } } while (0)
struct XcdBarrier { unsigned* bar; unsigned x; volatile LAS unsigned* st; };
__device__ __forceinline__ XcdBarrier xcd_barrier_post(unsigned* bar, volatile LAS unsigned* st) {
    XcdBarrier b; b.bar = bar; b.x = xb_xcc_id(); b.st = st;
    if (threadIdx.x == 0) (void)xb_add(&bar[XB_XCNT(b.x)], 1u);
    return b;
}
__device__ __forceinline__ void xcd_barrier_complete(unsigned* bar, unsigned x, unsigned& nloc, unsigned& nx) {
    const unsigned G = gridDim.x * gridDim.y * gridDim.z;
    unsigned sum, cnt, mine, sp = 0u;
    for (;;) {
        sum = 0u; cnt = 0u; mine = 0u;
#pragma unroll
        for (unsigned j = 0; j < 16; ++j) { const unsigned c = xb_ld(&bar[XB_XCNT(j)]); sum += c; cnt += (c > 0u) ? 1u : 0u; mine = (j == x) ? c : mine; }
        if (sum == G) break;
        __builtin_amdgcn_s_sleep(1);
        if ((++sp & 255u) == 0u) { if (xb_ld(&bar[XB_TMO])) break; if (sp > XB_SPIN_CAP) { atomicAdd(&bar[XB_TMO], 1u); break; } }
    }
    nloc = mine > 0u ? mine : 1u; nx = cnt > 0u ? cnt : 1u;
}
__device__ __forceinline__ void xcd_barrier(const XcdBarrier& b) {
    asm volatile("s_waitcnt vmcnt(0)" ::: "memory");
    __syncthreads();
    if (threadIdx.x == 0) {
        unsigned* bar = b.bar;
        __builtin_amdgcn_s_waitcnt(0);
        unsigned nloc = b.st[0], nx = b.st[1];
        if (nloc == 0u) { xcd_barrier_complete(bar, b.x, nloc, nx); b.st[0] = nloc; b.st[1] = nx; }
        const unsigned old = xb_add(&bar[XB_XSUB(b.x)], 1u);
        const unsigned gen = old / nloc;
        if (old + 1u == (gen + 1u) * nloc) {
            __builtin_amdgcn_fence(__ATOMIC_RELEASE, "agent");
            asm volatile("s_waitcnt vmcnt(0)" ::: "memory");
            const unsigned og = xb_add(&bar[XB_TOP], 1u);
            const unsigned tg = og / nx;
            if (og + 1u == (tg + 1u) * nx) xb_add(&bar[XB_TOPGEN], 1u);
            else XB_SPIN(xb_ld(&bar[XB_TOPGEN]) == tg, bar);
            __builtin_amdgcn_fence(__ATOMIC_ACQUIRE, "agent");
            xb_add(&bar[XB_XGEN(b.x)], 1u);
            asm volatile("s_waitcnt vmcnt(0)" ::: "memory");
        } else {
            XB_SPIN(xb_ld(&bar[XB_XGEN(b.x)]) == gen, bar);
            __builtin_amdgcn_fence(__ATOMIC_ACQUIRE, "agent");
            asm volatile("s_waitcnt vmcnt(0)" ::: "memory");
        }
    }
    __syncthreads();
}

struct Args {
    const float *x, *c, *ctx, *c_ctx, *ada_w, *ada_b, *norm_mix, *norm_ffn, *norm_final;
    const float *ab_w_in, *ab_conv_qkv, *ab_conv_sc, *ab_a_log, *ab_dt_bias, *ab_out_norm, *ab_w_out;
    const float *at_w_in, *at_sink, *at_w_out;
    const float *moe_w_group, *moe_w_expert, *moe_w1, *moe_w3, *moe_w2;
    float* out; unsigned char* ws;
    int ph_lo, ph_hi;
};
struct Ctx {
    LAS unsigned char* lds; int tid, lane, wave, G, bid, gw, ngw;
    int vcu;
};

__device__ __forceinline__ void transpose_item(const float* W, int ldw, int k0, int srccol, bf16* WT, int K, int dstrow0, bool il, LAS float* scr, int lane) {
    { float tv[32];
      const float* wp_ = W + (size_t)(k0 + (lane >> 5)) * ldw + srccol + (lane & 31);
#pragma unroll
      for (int i = 0; i < 32; ++i) tv[i] = wp_[(size_t)(2 * i) * ldw];
#pragma unroll
      for (int i = 0; i < 32; ++i) scr[(2 * i + (lane >> 5)) * 33 + (lane & 31)] = tv[i]; }
    asm volatile("s_waitcnt lgkmcnt(0)" ::: "memory");
    const int c = lane & 7;
#pragma unroll
    for (int j = 0; j < 4; ++j) { const int n = (lane >> 3) + 8 * j; const LAS float* s = scr + (8 * c) * 33 + n;
        u32x4 o; o.x = pk2(s[0 * 33], s[1 * 33]); o.y = pk2(s[2 * 33], s[3 * 33]); o.z = pk2(s[4 * 33], s[5 * 33]); o.w = pk2(s[6 * 33], s[7 * 33]);
        const int drow = dstrow0 + (il ? (8 * (n >> 2) + (n & 3)) : n);
        *(u32x4*)(WT + (size_t)drow * K + k0 + 8 * c) = o; }
    asm volatile("s_waitcnt lgkmcnt(0)" ::: "memory");
}
__device__ __forceinline__ void moe_convert(const Args& a, const Ctx& C, int l, int blk0) {
    LAS float* scr = (LAS float*)(C.lds + C.wave * 8448);
    bf16* WUP = (bf16*)(a.ws + WS_WUP); bf16* WDN = (bf16*)(a.ws + WS_WDN);
    if (C.bid < blk0) return;
    for (int it = (C.bid - blk0) * NWAVES + C.wave; it < 32 * 768; it += (C.G - blk0) * NWAVES) {
        const int e = it / 768, r = it % 768;
        if (r < 512) { const int rr = r & 255, kb = rr >> 4, nb = rr & 15; const float* src = (r < 256 ? a.moe_w1 : a.moe_w3) + (size_t)(l * 32 + e) * 1024 * 512;
            transpose_item(src, 512, 64 * kb, 32 * nb, WUP + (size_t)e * 1024 * 1024, 1024, 64 * nb + (r < 256 ? 0 : 4), true, scr, C.lane); }
        else { const int rr = r - 512, kb = rr >> 5, nb = rr & 31;
            transpose_item(a.moe_w2 + (size_t)(l * 32 + e) * 512 * 1024, 1024, 64 * kb, 32 * nb, WDN + (size_t)e * 1024 * 512, 512, 32 * nb, false, scr, C.lane); }
    }
}
__device__ __forceinline__ void norm_mod(const float* hrow, const float* nw, const float* shift, const float* scale, int lane, f32x4 (&v)[4]) {
    const f32x4* xr = (const f32x4*)hrow + lane; float s = 0.f;
#pragma unroll
    for (int j = 0; j < 4; ++j) { v[j] = xr[64 * j]; s += (v[j].x * v[j].x + v[j].y * v[j].y) + (v[j].z * v[j].z + v[j].w * v[j].w); }
    const float rstd = 1.0f / sqrtf(wave_sum(s) * (1.0f / D) + EPS);
#pragma unroll
    for (int j = 0; j < 4; ++j) { const f32x4 w = ((const f32x4*)nw)[lane + 64 * j], sc = ((const f32x4*)scale)[lane + 64 * j], sh = ((const f32x4*)shift)[lane + 64 * j];
        v[j] = v[j] * rstd * w * (sc + 1.0f) + sh; }
}
__device__ __forceinline__ void store_row_bf16(bf16* orow, int lane, const f32x4 (&v)[4]) {
    u32x2* o = (u32x2*)orow + lane;
#pragma unroll
    for (int j = 0; j < 4; ++j) { u32x2 w; w.x = pk2(v[j].x, v[j].y); w.y = pk2(v[j].z, v[j].w); o[64 * j] = w; }
}

__device__ __forceinline__ void phase_prologue(const Args& a, const Ctx& C) {
    LAS float* scr = (LAS float*)(C.lds + C.wave * 8448);
    bf16* WIN0 = (bf16*)(a.ws + WS_WIN0); bf16* WOUT0 = (bf16*)(a.ws + WS_WOUT0); bf16* WIN1 = (bf16*)(a.ws + WS_WIN1); bf16* WOUT1 = (bf16*)(a.ws + WS_WOUT1);
    for (int it0 = C.gw; it0 < 3584; it0 += C.ngw) {
        int it = it0;
        if (it < 1792) { const int kb = it / 112, nb = it % 112, n0 = 32 * nb; transpose_item(a.ab_w_in, 3600, 64 * kb, n0 < 2048 ? n0 : n0 + 16, WIN0, 1024, n0, false, scr, C.lane); continue; } it -= 1792;
        if (it < 512) { const int kb = it >> 5, nb = it & 31; transpose_item(a.ab_w_out, 1024, 64 * kb, 32 * nb, WOUT0, 1024, 32 * nb, false, scr, C.lane); continue; } it -= 512;
        if (it < 768) { const int kb = it / 48, nb = it % 48; transpose_item(a.at_w_in, 1536, 64 * kb, 32 * nb, WIN1, 1024, 32 * nb, false, scr, C.lane); continue; } it -= 768;
        { const int kb = it >> 5, nb = it & 31; transpose_item(a.at_w_out, 1024, 64 * kb, 32 * nb, WOUT1, 1024, 32 * nb, false, scr, C.lane); }
    }
    const int gt = (C.G - 1 - C.bid) * NTHR + C.tid, ngt = C.G * NTHR;
    float* ctab = (float*)(a.ws + WS_COS); float* stab = (float*)(a.ws + WS_SIN); float* wab = (float*)(a.ws + WS_WAB); float* wr = (float*)(a.ws + WS_WR);
    for (int i = gt; i < 1024; i += ngt) { const int pos = i >> 4, f = i & 15; const float inv = powf(10000.0f, -(float)f / 16.0f); const float ang = (float)pos * inv; ctab[i] = cosf(ang); stab[i] = sinf(ang); }
    for (int i = gt; i < 16384; i += ngt) { const int j = i >> 10, k = i & 1023; wab[i] = a.ab_w_in[(size_t)k * 3600 + 2048 + j]; }
    for (int i = gt; i < 2 * 49152; i += ngt) { const int l = i / 49152, r = i % 49152, k = r / 48, cc = r % 48;
        wr[i] = cc < 4 ? a.moe_w_group[(size_t)(l * 1024 + k) * 4 + cc] : (cc < 36 ? a.moe_w_expert[(size_t)(l * 1024 + k) * 32 + cc - 4] : 0.f); }
    __syncthreads();
    typedef float f32x16p __attribute__((ext_vector_type(16)));
    LAS float* sc = (LAS float*)C.lds;
    LAS float* red = (LAS float*)(C.lds + 70144);
    float* MOD = (float*)(a.ws + WS_MOD);
    if (C.bid < 192) {
        { f32x4 cv[9];
#pragma unroll
          for (int u = 0; u < 9; ++u) { const int i4 = C.tid + NTHR * u; cv[u] = i4 < 4096 ? ((const f32x4*)a.c)[i4] : (i4 < 4352 ? ((const f32x4*)a.c_ctx)[i4 - 4096] : (f32x4){0.f, 0.f, 0.f, 0.f}); }
#pragma unroll
          for (int u = 0; u < 9; ++u) { const int i4 = C.tid + NTHR * u; if (i4 < 4352) *(LAS f32x4*)(sc + (i4 >> 8) * 1028 + 4 * (i4 & 255)) = (f32x4){silu(cv[u].x), silu(cv[u].y), silu(cv[u].z), silu(cv[u].w)}; } }
        __syncthreads();
        for (int item = C.bid; item < 192; item += C.G) {
            const int l = item / 96, cg = item % 96, ks = C.wave, n = C.lane & 31, kh = C.lane >> 5, mrow = n < 17 ? n : 16;
            const float* wp = a.ada_w + (size_t)l * 1024 * 6144 + (size_t)(128 * ks + 64 * kh) * 6144 + cg * 64 + n;
            const LAS float* ap = sc + mrow * 1028 + 128 * ks + 64 * kh;
            f32x16p acc0, acc1;
#pragma unroll
            for (int i = 0; i < 16; ++i) { acc0[i] = 0.f; acc1[i] = 0.f; }
            float b0[2][16], b1[2][16];
#pragma unroll
            for (int u = 0; u < 16; ++u) { b0[0][u] = wp[(size_t)u * 6144]; b1[0][u] = wp[(size_t)u * 6144 + 32]; }
#pragma unroll
            for (int c4 = 0; c4 < 4; ++c4) { const int hs = 16 * c4, hn = c4 < 3 ? hs + 16 : hs;
                f32x4 av[4];
#pragma unroll
                for (int u = 0; u < 16; ++u) { b0[(c4 + 1) & 1][u] = wp[(size_t)(hn + u) * 6144]; b1[(c4 + 1) & 1][u] = wp[(size_t)(hn + u) * 6144 + 32]; }
#pragma unroll
                for (int j = 0; j < 4; ++j) av[j] = *(const LAS f32x4*)(ap + hs + 4 * j);
#pragma unroll
                for (int u = 0; u < 16; ++u) { acc0 = __builtin_amdgcn_mfma_f32_32x32x2f32(av[u >> 2][u & 3], b0[c4 & 1][u], acc0, 0, 0, 0); acc1 = __builtin_amdgcn_mfma_f32_32x32x2f32(av[u >> 2][u & 3], b1[c4 & 1][u], acc1, 0, 0, 0); }
            }
#pragma unroll
            for (int i = 0; i < 16; ++i) { const int row = 8 * (i >> 2) + 4 * kh + (i & 3); if (row < 17) { red[(ks * 17 + row) * 64 + n] = acc0[i]; red[(ks * 17 + row) * 64 + 32 + n] = acc1[i]; } }
            __syncthreads();
            for (int i = C.tid; i < 17 * 64; i += NTHR) { const int r = i >> 6, cc = i & 63; float s = 0.f;
#pragma unroll
                for (int q = 0; q < 8; ++q) s += red[(q * 17 + r) * 64 + cc];
                MOD[(size_t)(l * 17 + r) * 6144 + cg * 64 + cc] = s + a.ada_b[l * 6144 + cg * 64 + cc]; }
            __syncthreads();
        }
    }
}
__device__ __forceinline__ float reduce16(float (&p)[16], int lane) {
    float q8[8], q4[4], q2[2];
#pragma unroll
    for (int i = 0; i < 8; ++i) { const bool up = lane & 32; const float keep = up ? p[i + 8] : p[i], send = up ? p[i] : p[i + 8]; q8[i] = keep + lane_xor32(send, lane); }
#pragma unroll
    for (int i = 0; i < 4; ++i) { const bool up = lane & 16; const float keep = up ? q8[i + 4] : q8[i], send = up ? q8[i] : q8[i + 4]; q4[i] = keep + lane_xor16(send, lane); }
#pragma unroll
    for (int i = 0; i < 2; ++i) { const bool up = lane & 8; const float keep = up ? q4[i + 2] : q4[i], send = up ? q4[i] : q4[i + 2]; q2[i] = keep + dppf<DPP_ROR8>(send); }
    float r; { const bool up = lane & 4; const float keep = up ? q2[1] : q2[0], send = up ? q2[0] : q2[1]; r = keep + dppf<DPP_REV4>(dppf<DPP_HMIR>(send)); }
    r += dppf<DPP_XOR2>(r); r += dppf<DPP_XOR1>(r);
    return r;
}
__device__ __forceinline__ void phase_norm0(const Args& a, const Ctx& C) {
    LAS float* wab = (LAS float*)C.lds;
    const float* gw_ = (const float*)(a.ws + WS_WAB);
    for (int i = C.tid; i < 16384; i += NTHR) wab[i] = gw_[i];
    __syncthreads();
    const float* MOD = (const float*)(a.ws + WS_MOD); bf16* A = (bf16*)(a.ws + WS_A); float* AB = (float*)(a.ws + WS_AB);
    const int per = (RT + C.ngw - 1) / C.ngw, mbeg = C.gw * per, mend = mbeg + per < RT ? mbeg + per : RT;
    if (mbeg >= mend) return;
    f32x4 nwv[4], scv[4], shv[4], raw[2][4]; int curmod = -1;
#pragma unroll
    for (int j = 0; j < 4; ++j) nwv[j] = ((const f32x4*)a.norm_mix)[C.lane + 64 * j];
#define N0_LOAD(k_, m_) do { const int mc_ = (m_) < mend ? (m_) : mend - 1; const float* src_ = mc_ < RC ? a.ctx + (size_t)mc_ * D : a.x + (size_t)(mc_ - RC) * D; \
        _Pragma("unroll") for (int j_ = 0; j_ < 4; ++j_) raw[k_][j_] = ((const f32x4*)src_)[C.lane + 64 * j_]; } while (0)
    N0_LOAD(0, mbeg); N0_LOAD(1, mbeg + 1);
    for (int mp = mbeg; mp < mend; mp += 2) {
        asm volatile("" ::: "memory");
        f32x4 v[2][4];
#pragma unroll
        for (int k = 0; k < 2; ++k) { const int m = mp + k < mend ? mp + k : mend - 1; int modrow, t, L; row_info(m, modrow, t, L);
            if (modrow != curmod) { curmod = modrow; const float* md = MOD + (size_t)modrow * 6144;
#pragma unroll
                for (int j = 0; j < 4; ++j) { shv[j] = ((const f32x4*)md)[C.lane + 64 * j]; scv[j] = ((const f32x4*)(md + 1024))[C.lane + 64 * j]; } }
            float ss = 0.f;
#pragma unroll
            for (int j = 0; j < 4; ++j) { v[k][j] = raw[k][j]; ss += (v[k][j].x * v[k][j].x + v[k][j].y * v[k][j].y) + (v[k][j].z * v[k][j].z + v[k][j].w * v[k][j].w); }
            N0_LOAD(k, mp + 2 + k);
            const float rstd = 1.0f / sqrtf(wave_sum(ss) * (1.0f / D) + EPS);
#pragma unroll
            for (int j = 0; j < 4; ++j) v[k][j] = v[k][j] * rstd * nwv[j] * (scv[j] + 1.0f) + shv[j];
            if (mp + k < mend) store_row_bf16(A + (size_t)m * D, C.lane, v[k]); }
        float p0[16], p1[16];
#pragma unroll
        for (int q = 0; q < 16; ++q) { float s0 = 0.f, s1 = 0.f;
#pragma unroll
            for (int j = 0; j < 4; ++j) { const f32x4 w = *(const LAS f32x4*)(wab + q * 1024 + 4 * C.lane + 256 * j);
                s0 += (v[0][j].x * w.x + v[0][j].y * w.y) + (v[0][j].z * w.z + v[0][j].w * w.w); s1 += (v[1][j].x * w.x + v[1][j].y * w.y) + (v[1][j].z * w.z + v[1][j].w * w.w); }
            p0[q] = s0; p1[q] = s1; }
        const float r0 = reduce16(p0, C.lane), r1 = reduce16(p1, C.lane);
        if ((C.lane & 3) == 0) { const int idx = ((C.lane >> 5) & 1) * 8 + ((C.lane >> 4) & 1) * 4 + ((C.lane >> 3) & 1) * 2 + ((C.lane >> 2) & 1);
            AB[(size_t)mp * 16 + idx] = r0; if (mp + 1 < mend) AB[(size_t)(mp + 1) * 16 + idx] = r1; }
    }
#undef N0_LOAD
}
__device__ __forceinline__ void phase_conv(const Args& a, const Ctx& C) {
    const bf16* Z = (const bf16*)(a.ws + WS_Z); bf16* QKV = (bf16*)a.out; bf16* MIX = (bf16*)(a.ws + WS_MIX);
    const float* AB = (const float*)(a.ws + WS_AB); float* LA = (float*)(a.ws + WS_LA); float* BT = (float*)(a.ws + WS_BT);
    const u32x4 zero4 = (u32x4){0u, 0u, 0u, 0u};
    const int lane = C.lane;
    for (int task = C.gw; task < (RT / 32) * 5; task += C.ngw) {
        const int strip = task / 5, sl = task % 5, m0 = strip * 32;
        int modrow, t0, L; row_info(m0, modrow, t0, L);
        if (sl == 3) {
            float abv[8];
#pragma unroll
            for (int u = 0; u < 8; ++u) abv[u] = AB[(size_t)m0 * 16 + lane + 64 * u];
            const float dtb = a.ab_dt_bias[lane & 7], alg = a.ab_a_log[lane & 7];
            for (int rb = 0; rb < 32; rb += 8) { u32x4 gg[8];
#pragma unroll
                for (int u = 0; u < 8; ++u) gg[u] = *(const u32x4*)(Z + (size_t)(m0 + rb + u) * NZ + 1536 + lane * 8);
#pragma unroll
                for (int u = 0; u < 8; ++u) { float g[8], y[8]; unpack8(gg[u], g);
#pragma unroll
                    for (int e = 0; e < 8; ++e) y[e] = silu(g[e]);
                    *(u32x4*)(MIX + (size_t)(m0 + rb + u) * D + lane * 8) = pack8(y); } }
#pragma unroll
            for (int u = 0; u < 8; ++u) { const int i = lane + 64 * u, m = m0 + (i >> 4), c = i & 15; const float xx = abv[u];
                if (c < 8) { const float x2 = xx + dtb; const float sp = x2 > 20.f ? x2 : log1pf(expf(x2)); LA[(size_t)m * 8 + c] = -expf(alg) * sp; }
                else BT[(size_t)m * 8 + c - 8] = 1.0f / (1.0f + expf(-xx)); }
            continue;
        }
        if (sl < 3) {
            const int col = sl * 512 + lane * 8; float w0[8], w1[8], w2[8];
#pragma unroll
            for (int e = 0; e < 8; ++e) { w0[e] = a.ab_conv_qkv[col + e]; w1[e] = a.ab_conv_qkv[1536 + col + e]; w2[e] = a.ab_conv_qkv[3072 + col + e]; }
            const bf16* zp = Z + (size_t)m0 * NZ + col;
            u32x4 prev = t0 > 0 ? *(const u32x4*)(zp - NZ) : zero4, cur = *(const u32x4*)zp;
            u32x4 nb[2][8];
#define CV_LOAD(set, rb_) do { _Pragma("unroll") for (int u_ = 0; u_ < 8; ++u_) { const bool in_ = t0 + (rb_) + u_ + 1 < L; nb[set][u_] = *(const u32x4*)(zp + (size_t)(in_ ? (rb_) + u_ + 1 : (rb_) + u_) * NZ); } } while (0)
#define CV_ROWS(set, rb_) do { _Pragma("unroll") for (int u_ = 0; u_ < 8; ++u_) { const bool in_ = t0 + (rb_) + u_ + 1 < L; const u32x4 nxt_ = in_ ? nb[set][u_] : zero4; \
                float fa[8], fc[8], fb[8], y[8]; unpack8(prev, fa); unpack8(cur, fc); unpack8(nxt_, fb); \
                float ss = 0.f; \
                _Pragma("unroll") for (int e = 0; e < 8; ++e) { const float s_ = fa[e] * w0[e] + fc[e] * w1[e] + fb[e] * w2[e]; y[e] = silu(s_); ss += y[e] * y[e]; } \
                if (sl < 2) { ss = row16_sum(ss); \
                    const float sc_ = __builtin_amdgcn_rsqf(ss + EPS) * (sl == 0 ? 0.08838834764831845f : 1.0f); \
                    _Pragma("unroll") for (int e = 0; e < 8; ++e) y[e] *= sc_; } \
                *(u32x4*)(QKV + (size_t)(m0 + (rb_) + u_) * 1536 + col) = pack8(y); \
                prev = cur; cur = nxt_; } } while (0)
            CV_LOAD(0, 0);
            CV_LOAD(1, 8);  CV_ROWS(0, 0);
            CV_LOAD(0, 16); CV_ROWS(1, 8);
            CV_LOAD(1, 24); CV_ROWS(0, 16);
            CV_ROWS(1, 24);
#undef CV_LOAD
#undef CV_ROWS
        } else {
            const int col = lane * 8; float w0[8], w1[8], w2[8];
#pragma unroll
            for (int e = 0; e < 8; ++e) { w0[e] = a.ab_conv_sc[col + e]; w1[e] = a.ab_conv_sc[512 + col + e]; w2[e] = a.ab_conv_sc[1024 + col + e]; }
            const bf16* zp = Z + (size_t)m0 * NZ + col;
            float pp[8], pc[8];
            { float c_[8], h_[8];
              if (t0 > 0) { unpack8(*(const u32x4*)(zp - NZ + 2560), c_); unpack8(*(const u32x4*)(zp - NZ + 3072), h_);
#pragma unroll
                  for (int e = 0; e < 8; ++e) pp[e] = c_[e] * h_[e]; }
              else {
#pragma unroll
                  for (int e = 0; e < 8; ++e) pp[e] = 0.f; }
              unpack8(*(const u32x4*)(zp + 2560), c_); unpack8(*(const u32x4*)(zp + 3072), h_);
#pragma unroll
              for (int e = 0; e < 8; ++e) pc[e] = c_[e] * h_[e]; }
            for (int rb = 0; rb < 32; rb += 4) { u32x4 lc[4], lh[4], lgt[4];
#pragma unroll
                for (int u = 0; u < 4; ++u) { const bool in = t0 + rb + u + 1 < L; const size_t ro = (size_t)(in ? rb + u + 1 : rb + u) * NZ;
                    lc[u] = *(const u32x4*)(zp + ro + 2560); lh[u] = *(const u32x4*)(zp + ro + 3072); lgt[u] = *(const u32x4*)(zp + (size_t)(rb + u) * NZ + 2048); }
#pragma unroll
                for (int u = 0; u < 4; ++u) { float c_[8], h_[8], bg[8], y[8], pn[8]; const bool in = t0 + rb + u + 1 < L;
                    unpack8(lc[u], c_); unpack8(lh[u], h_); unpack8(lgt[u], bg);
#pragma unroll
                    for (int e = 0; e < 8; ++e) { pn[e] = in ? c_[e] * h_[e] : 0.f; y[e] = bg[e] * (pp[e] * w0[e] + pc[e] * w1[e] + pn[e] * w2[e]); pp[e] = pc[e]; pc[e] = pn[e]; }
                    *(u32x4*)(MIX + (size_t)(m0 + rb + u) * D + 512 + col) = pack8(y); } }
        }
    }
}
__device__ __forceinline__ void phase_dn_combine(const Args& a, const Ctx& C) {
    const bf16* OF = (const bf16*)(a.ws + WS_QD); const bf16* OB = OF + (size_t)RT * 512; bf16* MIX = (bf16*)(a.ws + WS_MIX);
    float on[8];
#pragma unroll
    for (int e = 0; e < 8; ++e) on[e] = a.ab_out_norm[(C.lane & 15) * 8 + e];
    for (int mb = C.gw; mb < RT; mb += 2 * C.ngw) {
      u32x4 lf[2], lb[2], lg[2];
#pragma unroll
      for (int k = 0; k < 2; ++k) { const int m = (mb + k * C.ngw < RT) ? mb + k * C.ngw : mb; lf[k] = *(const u32x4*)(OF + (size_t)m * 512 + C.lane * 8); lb[k] = *(const u32x4*)(OB + (size_t)m * 512 + C.lane * 8); lg[k] = *(const u32x4*)(MIX + (size_t)m * D + C.lane * 8); }
#pragma unroll
      for (int k = 0; k < 2; ++k) { const int m = mb + k * C.ngw; if (m >= RT) continue;
        float f[8], b[8], g[8], y[8]; unpack8(lf[k], f); unpack8(lb[k], b); unpack8(lg[k], g);
        float ss = 0.f;
#pragma unroll
        for (int e = 0; e < 8; ++e) { f[e] += b[e]; ss += f[e] * f[e]; }
        ss = row16_sum(ss);
        const float rstd = 1.0f / sqrtf(ss * (1.0f / 128.0f) + EPS);
#pragma unroll
        for (int e = 0; e < 8; ++e) y[e] = f[e] * rstd * on[e] * g[e];
        *(u32x4*)(MIX + (size_t)m * D + C.lane * 8) = pack8(y);
      }
    }
}
typedef float f32x4v __attribute__((ext_vector_type(4)));
__device__ __forceinline__ void phase_ffn_norm_route(const Args& a, const Ctx& C, int l) {
    LAS float* fsb = (LAS float*)C.lds;
    LAS float* redb = (LAS float*)(C.lds + 131584);
    LAS float* lgw = (LAS float*)(C.lds + 156160);
    LAS int* le = (LAS int*)(C.lds + 159232);
    LAS int* lr = le + 320;
    LAS int* hist = lr + 320;
    LAS int* base = hist + 32;
    const float* MOD = (const float*)(a.ws + WS_MOD) + (size_t)l * 17 * 6144;
    const float* wr = (const float*)(a.ws + WS_WR) + (size_t)l * 49152;
    const float* nw = a.norm_ffn + l * D;
    float* hctx = (float*)(a.ws + WS_HCTX); bf16* F = (bf16*)(a.ws + WS_A); int* ASG = (int*)(a.ws + WS_ASG);
    unsigned* cnt = (unsigned*)(a.ws + WS_CTL) + CW_CNT + 64 * l;
    if (C.tid < 32) hist[C.tid] = 0;
    const int g0 = l == 0 ? 0 : RC / 16, ngroups = RT / 16;
    const int gper = (ngroups - g0 + C.G - 1) / C.G, gfirst = g0 + C.bid * gper;
    const int n = gfirst < ngroups ? (ngroups - gfirst < gper ? ngroups - gfirst : gper) : 0;
    __syncthreads();
    if (C.wave >= 4) {
        const int rw = C.wave - 4;
        f32x4 pr[4][4]; u32x2 py[4][4];
        f32x4 mg[4], msc[4], msh[4], nwv[4];
#pragma unroll
        for (int j = 0; j < 4; ++j) nwv[j] = ((const f32x4*)nw)[C.lane + 64 * j];
        int curmod = -1;
#define P8_LOAD(g_) do { { int mr_, t_, L_; row_info((g_) * 16, mr_, t_, L_); if (mr_ != curmod) { curmod = mr_; const float* md_ = MOD + (size_t)mr_ * 6144; \
        _Pragma("unroll") for (int j_ = 0; j_ < 4; ++j_) { mg[j_] = ((const f32x4*)(md_ + 2048))[C.lane + 64 * j_]; msc[j_] = ((const f32x4*)(md_ + 4096))[C.lane + 64 * j_]; msh[j_] = ((const f32x4*)(md_ + 3072))[C.lane + 64 * j_]; } } } \
        _Pragma("unroll") for (int q_ = 0; q_ < 4; ++q_) { const int m_ = (g_) * 16 + 4 * rw + q_; \
        const float* rsd_ = l == 0 ? (m_ < RC ? a.ctx + (size_t)m_ * D : a.x + (size_t)(m_ - RC) * D) : a.out + (size_t)(m_ - RC) * D; \
        const bf16* yrow_ = (const bf16*)(a.ws + WS_Y) + (size_t)(l == 0 ? m_ : m_ - RC) * D; \
        _Pragma("unroll") for (int j_ = 0; j_ < 4; ++j_) { pr[q_][j_] = ((const f32x4*)rsd_)[C.lane + 64 * j_]; py[q_][j_] = ((const u32x2*)yrow_)[C.lane + 64 * j_]; } } } while (0)
        if (n > 0) P8_LOAD(gfirst);
        for (int i = 0; i < n + 2; ++i) {
            if (i < n) { const int g = gfirst + i; LAS float* fs = fsb + (i & 1) * (16 * 1028);
#pragma unroll
                for (int q = 0; q < 4; ++q) { const int r = 4 * rw + q, m = g * 16 + r; int modrow, t, L; row_info(m, modrow, t, L);
                    float* hdst = m < RC ? (float*)hctx + (size_t)m * D : a.out + (size_t)(m - RC) * D;
                    f32x4 v[4]; float ss = 0.f;
#pragma unroll
                    for (int j = 0; j < 4; ++j) { const f32x4 r4 = pr[q][j], g4 = mg[j]; const u32x2 yy = py[q][j];
                        v[j] = r4 + g4 * (f32x4){bflo(yy.x), bfhi(yy.x), bflo(yy.y), bfhi(yy.y)}; ((f32x4*)hdst)[C.lane + 64 * j] = v[j];
                        ss += (v[j].x * v[j].x + v[j].y * v[j].y) + (v[j].z * v[j].z + v[j].w * v[j].w); }
                    { const float rstd = 1.0f / sqrtf(wave_sum(ss) * (1.0f / D) + EPS);
#pragma unroll
                      for (int j = 0; j < 4; ++j) v[j] = v[j] * rstd * nwv[j] * (msc[j] + 1.0f) + msh[j]; }
                    store_row_bf16(F + (size_t)m * D, C.lane, v);
#pragma unroll
                    for (int j = 0; j < 4; ++j) *(LAS f32x4*)(fs + r * 1028 + 4 * C.lane + 256 * j) = v[j]; }
                if (i + 1 < n) P8_LOAD(g + 1);
            }
            __syncthreads();
        }
#undef P8_LOAD
    } else {
        int ln_ = C.lane; asm volatile("" : "+v"(ln_));
        const int kk = ln_ >> 4, rr = ln_ & 15, w = C.wave;
        float Bf[3][64];
#pragma unroll
        for (int ct = 0; ct < 3; ++ct)
#pragma unroll
            for (int s = 0; s < 64; ++s) Bf[ct][s] = wr[(size_t)(256 * w + 64 * kk + s) * 48 + 16 * ct + rr];
        for (int i = 0; i < n + 2; ++i) {
            if (i >= 2) {
                const int gi = i - 2, g = gfirst + gi; const LAS float* red = redb + (gi & 1) * (4 * 16 * 48);
                { const int r4 = ln_ >> 4, c = ln_ & 15;
#pragma unroll
                  for (int ct = 0; ct < 3; ++ct) { const int col = 16 * ct + c; float sum = 0.f;
#pragma unroll
                      for (int w2 = 0; w2 < 4; ++w2) sum += red[(w2 * 16 + 4 * w + r4) * 48 + col];
                      lgw[(w * 4 + r4) * 48 + col] = sum; } }
                asm volatile("s_waitcnt lgkmcnt(0)" ::: "memory");
                if (ln_ < 4) { const int r = 4 * w + ln_, m = g * 16 + r; const LAS float* lp = lgw + (w * 4 + ln_) * 48;
                    int gs = 0; float gm = lp[0];
#pragma unroll
                    for (int i2 = 1; i2 < 4; ++i2) if (lp[i2] > gm) { gm = lp[i2]; gs = i2; }
                    float gsum = 0.f;
#pragma unroll
                    for (int i2 = 0; i2 < 4; ++i2) gsum += expf(lp[i2] - gm);
                    const float pg = 1.0f / gsum;
                    const LAS float* ep = lp + 4 + gs * 8; float em = ep[0];
#pragma unroll
                    for (int i2 = 1; i2 < 8; ++i2) em = fmaxf(em, ep[i2]);
                    float pe[8], esum = 0.f;
#pragma unroll
                    for (int i2 = 0; i2 < 8; ++i2) { pe[i2] = expf(ep[i2] - em); esum += pe[i2]; }
                    int t0 = 0; float p0 = pe[0] / esum;
                    float pn[8];
#pragma unroll
                    for (int i2 = 0; i2 < 8; ++i2) pn[i2] = pe[i2] / esum;
#pragma unroll
                    for (int i2 = 1; i2 < 8; ++i2) if (pn[i2] > p0) { p0 = pn[i2]; t0 = i2; }
                    int t1 = -1; float p1 = -1.f;
#pragma unroll
                    for (int i2 = 0; i2 < 8; ++i2) if (i2 != t0 && pn[i2] > p1) { p1 = pn[i2]; t1 = i2; }
                    if (t1 < 0) t1 = (t0 == 0) ? 1 : 0;
                    const float w0 = pg * p0 / (p0 + p1), w1 = pg * p1 / (p0 + p1);
                    const int e0 = gs * 8 + t0, e1 = gs * 8 + t1;
                    const int r0 = atomicAdd((int*)&hist[e0], 1), r1 = atomicAdd((int*)&hist[e1], 1);
                    le[(gi * 16 + r) * 2] = e0; le[(gi * 16 + r) * 2 + 1] = e1; lr[(gi * 16 + r) * 2] = r0; lr[(gi * 16 + r) * 2 + 1] = r1;
                    int* ag = ASG + (size_t)m * 8; ag[0] = e0; ag[1] = e1; ag[4] = __float_as_int(w0); ag[5] = __float_as_int(w1);
                }
            }
            if (i >= 1 && i <= n) {
                const int gi = i - 1; const LAS float* fs = fsb + (gi & 1) * (16 * 1028); LAS float* red = redb + (gi & 1) * (4 * 16 * 48);
                f32x4v acc[3];
#pragma unroll
                for (int ct = 0; ct < 3; ++ct) acc[ct] = (f32x4v){0.f, 0.f, 0.f, 0.f};
                const LAS float* ab = fs + rr * 1028 + 256 * w + 64 * kk;
#pragma unroll
                for (int s4 = 0; s4 < 16; ++s4) { const f32x4 a4 = *(const LAS f32x4*)(ab + 4 * s4);
#pragma unroll
                    for (int e = 0; e < 4; ++e)
#pragma unroll
                        for (int ct = 0; ct < 3; ++ct) acc[ct] = __builtin_amdgcn_mfma_f32_16x16x4f32(a4[e], Bf[ct][4 * s4 + e], acc[ct], 0, 0, 0); }
#pragma unroll
                for (int ct = 0; ct < 3; ++ct)
#pragma unroll
                    for (int q = 0; q < 4; ++q) red[(w * 16 + 4 * kk + q) * 48 + 16 * ct + rr] = acc[ct][q];
            }
            __syncthreads();
        }
    }
    const int li = n;
    __syncthreads();
    if (C.tid < 32) base[C.tid] = (int)__hip_atomic_fetch_add(cnt + C.tid, (unsigned)hist[C.tid], RLX_AGENT);
    __syncthreads();
    int* ROWSE = (int*)(a.ws + WS_ROWSE);
    for (int i = C.tid; i < li * 16; i += NTHR) { const int gi = i >> 4, r = i & 15, m = (gfirst + gi) * 16 + r; int* ag = ASG + (size_t)m * 8;
        const int e0 = le[i * 2], e1 = le[i * 2 + 1], p0 = base[e0] + lr[i * 2], p1 = base[e1] + lr[i * 2 + 1];
        ag[2] = p0; ag[3] = p1; ROWSE[(size_t)e0 * RT + p0] = m; ROWSE[(size_t)e1 * RT + p1] = m; }
}
__device__ __forceinline__ int moe_tables(const Args& a, const Ctx& C, int l, int tabofs) {
    LAS int* tab = (LAS int*)(C.lds + tabofs);
    const unsigned* cnt = (const unsigned*)(a.ws + WS_CTL) + CW_CNT + 64 * l;
    if (C.tid < 32) tab[C.tid] = (int)cnt[C.tid];
    __syncthreads();
    if (C.tid == 0) { int acc = 0; for (int e = 0; e < 32; ++e) { const int c = tab[e]; tab[32 + e] = acc; acc += (c + 255) & ~255; } tab[64] = acc; }
    __syncthreads();
    const int nT = tab[64] >> 8;
    for (int ti = C.tid; ti < nT; ti += NTHR) { int e = 0; for (int q = 0; q < 32; ++q) if (tab[32 + q] <= ti * 256 && ti * 256 < tab[32 + q] + ((tab[q] + 255) & ~255)) e = q; tab[128 + ti] = e; }
    __syncthreads();
    return nT;
}
struct CombAsg { int e0, e1, p0, p1, w0, w1; };
__device__ __forceinline__ void phase_moe_combine(const Args& a, const Ctx& C, int l) {
    const float* MOD = (const float*)(a.ws + WS_MOD); const bf16* YG = (const bf16*)(a.ws + WS_YG); const int* ASG = (const int*)(a.ws + WS_ASG);
    float* hctx = (float*)(a.ws + WS_HCTX); bf16* A = (bf16*)(a.ws + WS_A);
    const int m0 = l == 0 ? 0 : RC;
    (void)moe_tables(a, C, l, 0); const LAS int* tab = (const LAS int*)C.lds;
    const int per = (RT - m0 + C.ngw - 1) / C.ngw, mbeg = m0 + C.gw * per, mend = mbeg + per < RT ? mbeg + per : RT;
    if (mbeg >= mend) return;
    f32x4 g2v[4], nwv[4], scv[4], shv[4]; int curmod = -1;
#pragma unroll
    for (int j = 0; j < 4; ++j) nwv[j] = ((const f32x4*)(l == 0 ? a.norm_mix + D : a.norm_final))[C.lane + 64 * j];
    u32x2 y0[2][4], y1[2][4]; f32x4 hv[2][4]; float cw0[2], cw1[2];
    CombAsg q0, q1;
#define CB_ASG(dst, m_) do { const int mc_ = (m_) < mend ? (m_) : mend - 1; const int* ag_ = ASG + (size_t)mc_ * 8; dst.e0 = ag_[0]; dst.e1 = ag_[1]; dst.p0 = ag_[2]; dst.p1 = ag_[3]; dst.w0 = ag_[4]; dst.w1 = ag_[5]; } while (0)
#define CB_ROWS(set, src, m_) do { const int mc_ = (m_) < mend ? (m_) : mend - 1; const int d0_ = tab[32 + src.e0] + src.p0, d1_ = tab[32 + src.e1] + src.p1; cw0[set] = __int_as_float(src.w0); cw1[set] = __int_as_float(src.w1); \
        const float* hr_ = mc_ < RC ? hctx + (size_t)mc_ * D : a.out + (size_t)(mc_ - RC) * D; \
        _Pragma("unroll") for (int j_ = 0; j_ < 4; ++j_) { y0[set][j_] = ((const u32x2*)(YG + (size_t)d0_ * D))[C.lane + 64 * j_]; y1[set][j_] = ((const u32x2*)(YG + (size_t)d1_ * D))[C.lane + 64 * j_]; hv[set][j_] = ((const f32x4*)hr_)[C.lane + 64 * j_]; } } while (0)
#define CB_ROW(set, m_) do { const int m = (m_); int modrow, t_, L_; row_info(m, modrow, t_, L_); \
        if (modrow != curmod) { curmod = modrow; const float* g2_ = MOD + (size_t)(l * 17 + modrow) * 6144 + 5120; const float* md_ = MOD + (size_t)(17 + modrow) * 6144; \
            _Pragma("unroll") for (int j_ = 0; j_ < 4; ++j_) { g2v[j_] = ((const f32x4*)g2_)[C.lane + 64 * j_]; if (l == 0) { scv[j_] = ((const f32x4*)(md_ + 1024))[C.lane + 64 * j_]; shv[j_] = ((const f32x4*)md_)[C.lane + 64 * j_]; } } } \
        float* hrow = m < RC ? hctx + (size_t)m * D : a.out + (size_t)(m - RC) * D; const float w0 = cw0[set], w1 = cw1[set]; \
        f32x4 v[4]; float ss = 0.f; \
        _Pragma("unroll") for (int j = 0; j < 4; ++j) { const u32x2 p0 = y0[set][j], p1 = y1[set][j]; \
            f32x4 y; y.x = w0 * bflo(p0.x) + w1 * bflo(p1.x); y.y = w0 * bfhi(p0.x) + w1 * bfhi(p1.x); y.z = w0 * bflo(p0.y) + w1 * bflo(p1.y); y.w = w0 * bfhi(p0.y) + w1 * bfhi(p1.y); \
            v[j] = hv[set][j] + g2v[j] * y; ss += (v[j].x * v[j].x + v[j].y * v[j].y) + (v[j].z * v[j].z + v[j].w * v[j].w); } \
          \
        if (m + 2 < mend) { if (set == 0) { CB_ROWS(0, q0, m + 2); CB_ASG(q0, m + 4); } else { CB_ROWS(1, q1, m + 2); CB_ASG(q1, m + 4); } } \
        const float rstd = 1.0f / sqrtf(wave_sum(ss) * (1.0f / D) + EPS); \
        if (l == 0) { \
            if (m >= RC) { _Pragma("unroll") for (int j = 0; j < 4; ++j) ((f32x4*)hrow)[C.lane + 64 * j] = v[j]; } \
            _Pragma("unroll") for (int j = 0; j < 4; ++j) v[j] = v[j] * rstd * nwv[j] * (scv[j] + 1.0f) + shv[j]; \
            store_row_bf16(A + (size_t)m * D, C.lane, v); \
        } else { _Pragma("unroll") for (int j = 0; j < 4; ++j) ((f32x4*)hrow)[C.lane + 64 * j] = v[j] * rstd * nwv[j]; } } while (0)
    CB_ASG(q0, mbeg); CB_ASG(q1, mbeg + 1);
    CB_ROWS(0, q0, mbeg); CB_ROWS(1, q1, mbeg + 1);
    CB_ASG(q0, mbeg + 2); CB_ASG(q1, mbeg + 3);
    for (int mi = mbeg; mi < mend; mi += 2) {
        CB_ROW(0, mi);
        if (mi + 1 < mend) CB_ROW(1, mi + 1);
    }
#undef CB_ASG
#undef CB_ROWS
#undef CB_ROW
}
__device__ __forceinline__ void phase_attn_naive(const Args& a, const Ctx& C) {
    LAS float* ps = (LAS float*)(C.lds + C.wave * 9472);
    LAS float* qs = ps + 4 * 528;
    const bf16* Q1 = (const bf16*)(a.ws + WS_Q1); const bf16* K1 = (const bf16*)(a.ws + WS_K1); const bf16* V1 = (const bf16*)(a.ws + WS_V1); bf16* O1 = (bf16*)(a.ws + WS_O1);
    for (int task = C.gw; task < RL * 4; task += C.ngw) {
        const int kvh = task & 3, bt = task >> 2, b = bt >> 11, t = bt & 2047;
        { const u32x2 qv = *((const u32x2*)(Q1 + (size_t)bt * 1024 + kvh * 256) + C.lane); qs[4 * C.lane] = bflo(qv.x); qs[4 * C.lane + 1] = bfhi(qv.x); qs[4 * C.lane + 2] = bflo(qv.y); qs[4 * C.lane + 3] = bfhi(qv.y); }
        const int lo = t - 128 < 0 ? 0 : t - 128, hi = t + 128 > SEQ - 1 ? SEQ - 1 : t + 128, nk = 256 + hi - lo + 1;
        float sc[4][9];
#pragma unroll
        for (int i = 0; i < 9; ++i) { const int kx = C.lane + 64 * i;
            if (kx < nk) { const int row = kx < 256 ? b * 256 + kx : RC + b * SEQ + lo + (kx - 256); const u32x4* kp = (const u32x4*)(K1 + (size_t)row * 256 + kvh * 64);
                float s0 = 0.f, s1 = 0.f, s2 = 0.f, s3 = 0.f;
#pragma unroll
                for (int c8 = 0; c8 < 8; ++c8) { float kf[8]; unpack8(kp[c8], kf);
#pragma unroll
                    for (int e = 0; e < 8; ++e) { const int dd = c8 * 8 + e; s0 += qs[dd] * kf[e]; s1 += qs[64 + dd] * kf[e]; s2 += qs[128 + dd] * kf[e]; s3 += qs[192 + dd] * kf[e]; } }
                sc[0][i] = s0; sc[1][i] = s1; sc[2][i] = s2; sc[3][i] = s3; }
            else { sc[0][i] = -INFINITY; sc[1][i] = -INFINITY; sc[2][i] = -INFINITY; sc[3][i] = -INFINITY; } }
#pragma unroll
        for (int g = 0; g < 4; ++g) { const float sink = a.at_sink[kvh * 4 + g]; float mx = sc[g][0];
#pragma unroll
            for (int i = 1; i < 9; ++i) mx = fmaxf(mx, sc[g][i]);
            mx = fmaxf(wave_max(mx), sink); float sum = 0.f, p[9];
#pragma unroll
            for (int i = 0; i < 9; ++i) { p[i] = __expf(sc[g][i] - mx); sum += p[i]; }
            sum = wave_sum(sum) + __expf(sink - mx); const float inv = 1.0f / sum;
#pragma unroll
            for (int i = 0; i < 9; ++i) { const int kx = C.lane + 64 * i; if (kx < 528) ps[g * 528 + kx] = p[i] * inv; } }
        float o0 = 0.f, o1 = 0.f, o2 = 0.f, o3 = 0.f;
        for (int kx = 0; kx < nk; ++kx) { const int row = kx < 256 ? b * 256 + kx : RC + b * SEQ + lo + (kx - 256); const float v = bf2f(V1[(size_t)row * 256 + kvh * 64 + C.lane]);
            o0 += ps[kx] * v; o1 += ps[528 + kx] * v; o2 += ps[1056 + kx] * v; o3 += ps[1584 + kx] * v; }
        bf16* op = O1 + (size_t)bt * 1024 + kvh * 256 + C.lane;
        op[0] = (bf16)f2bf(o0); op[64] = (bf16)f2bf(o1); op[128] = (bf16)f2bf(o2); op[192] = (bf16)f2bf(o3);
    }
}
typedef float f32x16 __attribute__((ext_vector_type(16)));
typedef short s16x8 __attribute__((ext_vector_type(8)));
typedef short s16x4 __attribute__((ext_vector_type(4)));
template <bool MASK>
__device__ __forceinline__ void attn_tile(const s16x8 (&kf)[4], const s16x8 (&qf)[4], float& m_run, float& l_run, f32x16& Oa, f32x16& Ob, unsigned va, int start, int tq, int h) {
    f32x16 S = __builtin_amdgcn_mfma_f32_32x32x16_bf16(kf[0], qf[0], (f32x16){0.f, 0.f, 0.f, 0.f, 0.f, 0.f, 0.f, 0.f, 0.f, 0.f, 0.f, 0.f, 0.f, 0.f, 0.f, 0.f}, 0, 0, 0);
#pragma unroll
    for (int s = 1; s < 4; ++s) S = __builtin_amdgcn_mfma_f32_32x32x16_bf16(kf[s], qf[s], S, 0, 0, 0);
    if constexpr (MASK) {
#pragma unroll
        for (int i = 0; i < 16; ++i) { const int key = start + (i & 3) + 8 * (i >> 2) + 4 * h; const int dl = tq - key; if (dl > 128 || dl < -128) S[i] = -INFINITY; } }
    float tmax = S[0];
#pragma unroll
    for (int i = 1; i < 16; ++i) tmax = fmaxf(tmax, S[i]);
    tmax = xor32_max(tmax);
    const float m_new = fmaxf(m_run, tmax), alpha = __builtin_amdgcn_exp2f(m_run - m_new);
    float psum = 0.f;
#pragma unroll
    for (int i = 0; i < 16; ++i) { S[i] = __builtin_amdgcn_exp2f(S[i] - m_new); psum += S[i]; }
    psum = xor32_sum(psum);
    l_run = l_run * alpha + psum; m_run = m_new;
#pragma unroll
    for (int i = 0; i < 16; ++i) { Oa[i] *= alpha; Ob[i] *= alpha; }
    s16x8 pf[2];
#pragma unroll
    for (int s = 0; s < 2; ++s) { u32x4 w; w.x = pk2(S[8 * s], S[8 * s + 1]); w.y = pk2(S[8 * s + 2], S[8 * s + 3]); w.z = pk2(S[8 * s + 4], S[8 * s + 5]); w.w = pk2(S[8 * s + 6], S[8 * s + 7]); pf[s] = __builtin_bit_cast(s16x8, w); }
    u32x2 v000, v010, v100, v110, v001, v011, v101, v111;
    asm volatile("ds_read_b64_tr_b16 %0, %8\n\tds_read_b64_tr_b16 %1, %8 offset:1024\n\tds_read_b64_tr_b16 %2, %8 offset:2048\n\tds_read_b64_tr_b16 %3, %8 offset:3072\n\t"
                 "ds_read_b64_tr_b16 %4, %8 offset:64\n\tds_read_b64_tr_b16 %5, %8 offset:1088\n\tds_read_b64_tr_b16 %6, %8 offset:2112\n\tds_read_b64_tr_b16 %7, %8 offset:3136\n\ts_waitcnt lgkmcnt(0)"
                 : "=&v"(v000), "=&v"(v010), "=&v"(v100), "=&v"(v110), "=&v"(v001), "=&v"(v011), "=&v"(v101), "=&v"(v111) : "v"(va) : "memory");
    { u32x4 w; w.x = v000.x; w.y = v000.y; w.z = v010.x; w.w = v010.y; Oa = __builtin_amdgcn_mfma_f32_32x32x16_bf16(__builtin_bit_cast(s16x8, w), pf[0], Oa, 0, 0, 0); }
    { u32x4 w; w.x = v100.x; w.y = v100.y; w.z = v110.x; w.w = v110.y; Oa = __builtin_amdgcn_mfma_f32_32x32x16_bf16(__builtin_bit_cast(s16x8, w), pf[1], Oa, 0, 0, 0); }
    { u32x4 w; w.x = v001.x; w.y = v001.y; w.z = v011.x; w.w = v011.y; Ob = __builtin_amdgcn_mfma_f32_32x32x16_bf16(__builtin_bit_cast(s16x8, w), pf[0], Ob, 0, 0, 0); }
    { u32x4 w; w.x = v101.x; w.y = v101.y; w.z = v111.x; w.w = v111.y; Ob = __builtin_amdgcn_mfma_f32_32x32x16_bf16(__builtin_bit_cast(s16x8, w), pf[1], Ob, 0, 0, 0); }
}
__device__ __forceinline__ void phase_attn(const Args& a, const Ctx& C) {
    LAS unsigned char* vl = C.lds;
    LAS unsigned char* kl = C.lds + 73728;
    const unsigned vl_addr = (unsigned)(uintptr_t)vl;
    const bf16* Q1 = (const bf16*)(a.ws + WS_Q1); const bf16* K1 = (const bf16*)(a.ws + WS_K1); const bf16* V1 = (const bf16*)(a.ws + WS_V1); bf16* O1 = (bf16*)(a.ws + WS_O1);
    const int lane = C.lane, r = lane & 31, h = lane >> 5, g = C.wave >> 1, qh = C.wave & 1;
    const unsigned lane_off = (unsigned)((4 * h + ((lane & 15) >> 2)) * 128 + (16 * ((lane >> 4) & 1) + 4 * (lane & 3)) * 2);
    const LAS unsigned char* kbase = kl + r * 128; const int swz = (r >> 1) & 7;
    u32x4 vreg[9], kreg[9];
#define ATT_KVLOAD(u_) do { const int qb_ = (u_) & 31, kvh_ = ((u_) >> 5) & 3, b_ = (u_) >> 7, q0_ = qb_ * 64; _Pragma("unroll") for (int k_ = 0; k_ < 9; ++k_) { const int idx_ = C.tid + NTHR * k_, row_ = idx_ >> 3, ch_ = idx_ & 7; \
            int grow_; bool ok_ = true; if (row_ < 256) grow_ = b_ * 256 + row_; else { const int kp_ = q0_ - 128 + (row_ - 256); ok_ = kp_ >= 0 && kp_ < SEQ; grow_ = RC + b_ * SEQ + (ok_ ? kp_ : 0); } \
            vreg[k_] = *(const u32x4*)(V1 + (size_t)grow_ * 256 + kvh_ * 64 + ch_ * 8); kreg[k_] = *(const u32x4*)(K1 + (size_t)grow_ * 256 + kvh_ * 64 + ch_ * 8); } } while (0)
#define ATT_KVSTORE() do { _Pragma("unroll") for (int k_ = 0; k_ < 9; ++k_) { const int idx_ = C.tid + NTHR * k_, row_ = idx_ >> 3, ch_ = idx_ & 7; *(LAS u32x4*)(vl + row_ * 128 + ch_ * 16) = vreg[k_]; \
            *(LAS u32x4*)(kl + row_ * 128 + ((ch_ ^ ((row_ >> 1) & 7)) * 16)) = kreg[k_]; } } while (0)
    if (C.vcu < 2048) { ATT_KVLOAD(C.vcu); ATT_KVSTORE(); }
    __syncthreads();
    for (int unit = C.vcu; unit < 2048; unit += C.G) {
        const int qb = unit & 31, kvh = (unit >> 5) & 3, b = unit >> 7, q0 = qb * 64;
        if (unit + C.G < 2048) ATT_KVLOAD(unit + C.G);
        const int tq0 = q0 + 32 * qh, tq = tq0 + r, head = kvh * 4 + g;
        s16x8 qf[4];
        { const bf16* qp = Q1 + (size_t)(b * SEQ + tq) * 1024 + head * 64 + 8 * h;
#pragma unroll
          for (int s = 0; s < 4; ++s) qf[s] = *(const s16x8*)(qp + 16 * s); }
        float m_run = a.at_sink[head] * 1.4426950408889634f, l_run = 1.0f;
        f32x16 Oa, Ob;
#pragma unroll
        for (int i = 0; i < 16; ++i) { Oa[i] = 0.f; Ob[i] = 0.f; }
        const int i_lo = tq0 < 128 ? (128 - tq0) >> 5 : 0, i_hi = (SEQ - 32 - (tq0 - 128)) >> 5 > 8 ? 8 : (SEQ - 32 - (tq0 - 128)) >> 5, ntile = 8 + i_hi - i_lo + 1;
#define ATT_LT(tn_) ((tn_) < 8 ? (tn_) : 8 + i_lo + (tn_) - 8 + qh)
#define ATT_KLOAD(kf_, tn_) do { const LAS unsigned char* kp_ = kbase + ATT_LT(tn_) * 4096; _Pragma("unroll") for (int s_ = 0; s_ < 4; ++s_) kf_[s_] = *(const LAS s16x8*)(kp_ + (((h + 2 * s_) ^ swz) * 16)); } while (0)
#define ATT_TILE(kf_, tj_) do { const int tj__ = (tj_); const bool lat_ = tj__ >= 8; const int i_ = i_lo + tj__ - 8; const int start_ = lat_ ? tq0 - 128 + 32 * i_ : 0; const int ltile_ = lat_ ? 8 + i_ + qh : tj__; \
            const unsigned va_ = vl_addr + (unsigned)ltile_ * 4096u + lane_off; \
            if (lat_ && (i_ == 0 || i_ == 8)) attn_tile<true>(kf_, qf, m_run, l_run, Oa, Ob, va_, start_, tq, h); else attn_tile<false>(kf_, qf, m_run, l_run, Oa, Ob, va_, start_, tq, h); } while (0)
        s16x8 kA[4], kB[4];
        ATT_KLOAD(kA, 0);
        int tj = 0;
        for (; tj + 1 < ntile; tj += 2) {
            ATT_KLOAD(kB, tj + 1);
            ATT_TILE(kA, tj);
            if (tj + 2 < ntile) ATT_KLOAD(kA, tj + 2);
            ATT_TILE(kB, tj + 1);
        }
        if (tj < ntile) ATT_TILE(kA, tj);
#undef ATT_KLOAD
#undef ATT_TILE
#undef ATT_LT
        const float inv = 1.0f / l_run;
        bf16* ob = O1 + (size_t)(b * SEQ + tq) * 1024 + head * 64 + 8 * h;
#pragma unroll
        for (int j = 0; j < 2; ++j) {
            u32x2 a0, b0, a1, b1;
            a0.x = pk2(Oa[8 * j] * inv, Oa[8 * j + 1] * inv); a0.y = pk2(Oa[8 * j + 2] * inv, Oa[8 * j + 3] * inv); b0.x = pk2(Oa[8 * j + 4] * inv, Oa[8 * j + 5] * inv); b0.y = pk2(Oa[8 * j + 6] * inv, Oa[8 * j + 7] * inv);
            a1.x = pk2(Ob[8 * j] * inv, Ob[8 * j + 1] * inv); a1.y = pk2(Ob[8 * j + 2] * inv, Ob[8 * j + 3] * inv); b1.x = pk2(Ob[8 * j + 4] * inv, Ob[8 * j + 5] * inv); b1.y = pk2(Ob[8 * j + 6] * inv, Ob[8 * j + 7] * inv);
            const auto sx0 = __builtin_amdgcn_permlane32_swap(a0.x, b0.x, false, false), sy0 = __builtin_amdgcn_permlane32_swap(a0.y, b0.y, false, false);
            const auto sx1 = __builtin_amdgcn_permlane32_swap(a1.x, b1.x, false, false), sy1 = __builtin_amdgcn_permlane32_swap(a1.y, b1.y, false, false);
            *(u32x4*)(ob + 16 * j) = (u32x4){sx0[0], sy0[0], sx0[1], sy0[1]};
            *(u32x4*)(ob + 32 + 16 * j) = (u32x4){sx1[0], sy1[0], sx1[1], sy1[1]};
        }
        __syncthreads();
        if (unit + C.G < 2048) ATT_KVSTORE();
        __syncthreads();
    }
#undef ATT_KVLOAD
#undef ATT_KVSTORE
}
#define RMAP(tile, r) (32 * ((tile) >> 1) + 8 * ((r) >> 2) + ((r) & 3) + 4 * ((tile) & 1))
constexpr int SB_WN = 0, SB_QD = 17408, SB_KDT = 34816, SB_QK = 53248, SB_UT = 62464, SB_BYTES = 71680;
__device__ __forceinline__ s16x8 afrag16(const LAS unsigned char* p) { return *(const LAS s16x8*)p; }
__device__ __forceinline__ s16x8 afrag(const LAS unsigned char* p) { const u32x2 lo = *(const LAS u32x2*)p, hi = *(const LAS u32x2*)(p + 32); u32x4 w; w.x = lo.x; w.y = lo.y; w.z = hi.x; w.w = hi.y; return __builtin_bit_cast(s16x8, w); }
__device__ __forceinline__ s16x8 pack_acc2(const f32x4 a, const f32x4 b) { u32x4 w; w.x = pk2(a.x, a.y); w.y = pk2(a.z, a.w); w.z = pk2(b.x, b.y); w.w = pk2(b.z, b.w); return __builtin_bit_cast(s16x8, w); }
__device__ __forceinline__ int scan_unit(int step, int b, int h, int d, int& cg) { if (step < 4) cg = b * 4 + (d ? 3 - step : step); else { const int n = step - 4; cg = 64 + b * 32 + (d ? 31 - n : n); } return (cg * 4 + h) * 2 + d; }
__device__ __forceinline__ void phase_dn_scan(const Args& a, const Ctx& C) {
    const unsigned char* gW = a.ws + WS_W; const unsigned char* gQ = (const unsigned char*)a.out; const unsigned char* gQK = a.ws + WS_QK; const unsigned char* gU = a.ws + WS_U;
    const float* GL = (const float*)(a.ws + WS_GL);
    const float* GE = (const float*)(a.ws + WS_GE);
    bf16* OF = (bf16*)(a.ws + WS_QD); bf16* OB = OF + (size_t)RT * 512;
    const int tid = C.tid;
    const int lt = tid & 255;
    const unsigned sd_wq = (unsigned)((lt >> 4) * 272 + (lt & 15) * 16), sd_k = (unsigned)(((lt >> 4) >> 1) * 528 + ((lt >> 4) & 1) * 8 + ((lt >> 4) >> 3) * 64 + (lt & 15) * 32), sd_g = (unsigned)((lt >> 3) * 144 + (lt & 7) * 16);
    for (int work = C.vcu; work < 256; work += C.G) {
        const int half = work & 1, d = (work >> 1) & 1, h = (work >> 2) & 3, b = work >> 4;
        const int qoff0 = (d ? 63 - (lt >> 4) : (lt >> 4)) * 3072 + h * 256 + (lt & 15) * 16, qstep = d ? -16 * 3072 : 16 * 3072;
#define SCAN_LOAD(st, step_) do { int cg_; const size_t ub = (size_t)scan_unit((step_), b, h, d, cg_); \
            _Pragma("unroll") for (int i_ = 0; i_ < 4; ++i_) { st[i_] = *(const u32x4*)(gW + ub * 16384 + (size_t)(lt + 256 * i_) * 16); st[4 + i_] = *(const u32x4*)(gQ + (size_t)cg_ * (64 * 3072) + (unsigned)(qoff0 + i_ * qstep)); \
                st[8 + i_] = *(const u32x4*)(gQ + (size_t)cg_ * (64 * 3072) + (unsigned)(qoff0 + 1024 + i_ * qstep)); } \
            _Pragma("unroll") for (int i_ = 0; i_ < 2; ++i_) { st[12 + i_] = *(const u32x4*)(gQK + ub * 8192 + (size_t)(lt + 256 * i_) * 16); st[14 + i_] = *(const u32x4*)(gU + ub * 16384 + (size_t)half * 8192 + (size_t)(lt + 256 * i_) * 16); } } while (0)
#define SCAN_STORE(st, bufoff) do { _Pragma("unroll") for (int i_ = 0; i_ < 4; ++i_) { *(LAS u32x4*)(C.lds + (bufoff) + SB_WN + sd_wq + i_ * 4352) = st[i_]; *(LAS u32x4*)(C.lds + (bufoff) + SB_QD + sd_wq + i_ * 4352) = st[4 + i_]; \
                LAS unsigned char* kp_ = C.lds + (bufoff) + SB_KDT + sd_k + i_ * 4352; *(LAS u32x2*)kp_ = (u32x2){st[8 + i_].x, st[8 + i_].y}; *(LAS u32x2*)(kp_ + 16) = (u32x2){st[8 + i_].z, st[8 + i_].w}; } \
            _Pragma("unroll") for (int i_ = 0; i_ < 2; ++i_) { *(LAS u32x4*)(C.lds + (bufoff) + SB_QK + sd_g + i_ * 4608) = st[12 + i_]; *(LAS u32x4*)(C.lds + (bufoff) + SB_UT + sd_g + i_ * 4608) = st[14 + i_]; } } while (0)
#define SCAN_FLUSH(sp) do { int cgp_; (void)scan_unit((sp), b, h, d, cgp_); _Pragma("unroll") for (int k_ = 0; k_ < 2; ++k_) { const int c_ = lt + 256 * k_, rr_ = c_ >> 3, ch_ = c_ & 7; \
            const u32x4 v_ = *(const LAS u32x4*)(C.lds + 2 * SB_BYTES + ((sp) & 1) * 9216 + rr_ * 144 + ch_ * 16); const int m_ = cgp_ * 64 + (d ? 63 - rr_ : rr_); \
            *(u32x4*)((d ? OB : OF) + (size_t)m_ * 512 + h * 128 + half * 64 + ch_ * 8) = v_; } } while (0)
        if (C.wave >= 4) {
            u32x4 sa[16], sb[16];
            SCAN_LOAD(sa, 0); SCAN_STORE(sa, 0); SCAN_LOAD(sb, 1); SCAN_LOAD(sa, 2);
            __syncthreads();
            for (int step = 0; step < 36; step += 2) {
                SCAN_STORE(sb, SB_BYTES); if (step + 3 < 36) SCAN_LOAD(sb, step + 3);
                if (step > 0) SCAN_FLUSH(step - 1);
                __syncthreads();
                if (step + 2 < 36) SCAN_STORE(sa, 0); if (step + 4 < 36) SCAN_LOAD(sa, step + 4);
                SCAN_FLUSH(step);
                __syncthreads();
            }
            SCAN_FLUSH(35);
        } else {
        int ln_ = C.lane; asm volatile("" : "+v"(ln_)); const int fr = ln_ & 15, q = ln_ >> 4;
        f32x4 S[8];
#pragma unroll
        for (int t = 0; t < 8; ++t) S[t] = (f32x4){0.f, 0.f, 0.f, 0.f};
        f32x4 egn[4], gkn[4];
        { int cg0_; const int u0_ = scan_unit(0, b, h, d, cg0_);
#pragma unroll
          for (int i = 0; i < 4; ++i) { egn[i] = *(const f32x4*)(GE + (size_t)u0_ * 128 + RMAP(i, 4 * q)); gkn[i] = *(const f32x4*)(GE + (size_t)u0_ * 128 + 64 + RMAP(i, 4 * q)); } }
        const unsigned ktr_lane = (unsigned)(q * 2176 + (fr >> 3) * 528 + ((fr >> 2) & 1) * 8 + (fr & 3) * 32);
        __syncthreads();
        for (int step = 0; step < 36; ++step) {
            int cg; const int ucur = scan_unit(step, b, h, d, cg);
            {
                f32x4 eg[4], gk[4];
#pragma unroll
                for (int i = 0; i < 4; ++i) { eg[i] = egn[i]; gk[i] = gkn[i]; }
                if (step + 1 < 36) { int cgn_; const int un_ = scan_unit(step + 1, b, h, d, cgn_);
#pragma unroll
                    for (int i = 0; i < 4; ++i) { egn[i] = *(const f32x4*)(GE + (size_t)un_ * 128 + RMAP(i, 4 * q)); gkn[i] = *(const f32x4*)(GE + (size_t)un_ * 128 + 64 + RMAP(i, 4 * q)); } }

                const LAS unsigned char* B0 = C.lds + (step & 1) * SB_BYTES;
                const float gl = GL[ucur];
                s16x8 Sb[4];
#pragma unroll
                for (int s = 0; s < 4; ++s) Sb[s] = pack_acc2(S[2 * s], S[2 * s + 1]);
                f32x4 vn[4], o[4];
                s16x8 wf[2][4], qf[2][4];
#define SCAN_LDWQ(buf, i) do { _Pragma("unroll") for (int s_ = 0; s_ < 4; ++s_) { wf[buf][s_] = afrag16(B0 + SB_WN + RMAP(i, fr) * 272 + (32 * s_ + 8 * q) * 2); qf[buf][s_] = afrag16(B0 + SB_QD + RMAP(i, fr) * 272 + (32 * s_ + 8 * q) * 2); } } while (0)
                SCAN_LDWQ(0, 0);
#pragma unroll
                for (int i = 0; i < 4; ++i) {
                    const u32x2 uu = *(const LAS u32x2*)(B0 + SB_UT + (16 * C.wave + fr) * 144 + RMAP(i, 4 * q) * 2);
                    if (i < 3) { if (i & 1) SCAN_LDWQ(0, i + 1); else SCAN_LDWQ(1, i + 1); }
                    __builtin_amdgcn_sched_barrier(0);
                    vn[i] = (f32x4){bflo(uu.x), bfhi(uu.x), bflo(uu.y), bfhi(uu.y)}; o[i] = (f32x4){0.f, 0.f, 0.f, 0.f};
#pragma unroll
                    for (int s = 0; s < 4; ++s) { vn[i] = __builtin_amdgcn_mfma_f32_16x16x32_bf16(wf[i & 1][s], Sb[s], vn[i], 0, 0, 0); o[i] = __builtin_amdgcn_mfma_f32_16x16x32_bf16(qf[i & 1][s], Sb[s], o[i], 0, 0, 0); }
                    __builtin_amdgcn_sched_barrier(0);
                }
#undef SCAN_LDWQ
#pragma unroll
                for (int i = 0; i < 4; ++i) o[i] = o[i] * eg[i];
                s16x8 gf[2][4];
#define SCAN_LDG(buf, g) do { if ((g) < 2) { _Pragma("unroll") for (int j_ = 0; j_ < 4; ++j_) gf[buf][j_] = afrag16(B0 + SB_QK + RMAP(2 * (g) + (j_ >> 1), fr) * 144 + (32 * (j_ & 1) + 8 * q) * 2); } \
                    else { _Pragma("unroll") for (int j_ = 0; j_ < 4; ++j_) { const int t_ = 2 * ((g) - 2) + (j_ >> 1); const LAS unsigned char* p_ = B0 + SB_KDT + ktr_lane + (j_ & 1) * 8704 + (8 * (t_ >> 1) + (t_ & 1)) * 16; \
                        const s16x4 lo_ = __builtin_amdgcn_ds_read_tr16_b64_v4i16((LAS s16x4*)p_), hi_ = __builtin_amdgcn_ds_read_tr16_b64_v4i16((LAS s16x4*)(p_ + 1056)); \
                        gf[buf][j_] = __builtin_shufflevector(lo_, hi_, 0, 1, 2, 3, 4, 5, 6, 7); } } } while (0)
                SCAN_LDG(0, 0);
                s16x8 vb[2], vbk[2];
#pragma unroll
                for (int s = 0; s < 2; ++s) { vb[s] = pack_acc2(vn[2 * s], vn[2 * s + 1]); vbk[s] = pack_acc2(vn[2 * s] * gk[2 * s], vn[2 * s + 1] * gk[2 * s + 1]); }
#pragma unroll
                for (int g = 0; g < 6; ++g) {
                    if (g < 5) { if (g & 1) SCAN_LDG(0, g + 1); else SCAN_LDG(1, g + 1); }
                    __builtin_amdgcn_sched_barrier(0);
                    if (g < 2) {
#pragma unroll
                        for (int j = 0; j < 4; ++j) o[2 * g + (j >> 1)] = __builtin_amdgcn_mfma_f32_16x16x32_bf16(gf[g & 1][j], vb[j & 1], o[2 * g + (j >> 1)], 0, 0, 0);
                    } else {
#pragma unroll
                        for (int j = 0; j < 4; ++j) { const int t = 2 * (g - 2) + (j >> 1); if ((j & 1) == 0) S[t] = S[t] * gl; S[t] = __builtin_amdgcn_mfma_f32_16x16x32_bf16(gf[g & 1][j], vbk[j & 1], S[t], 0, 0, 0); }
                    }
                    __builtin_amdgcn_sched_barrier(0);
                }
#undef SCAN_LDG
                LAS bf16* ob = (LAS bf16*)(C.lds + 2 * SB_BYTES + (step & 1) * 9216) + 16 * C.wave + fr;
#pragma unroll
                for (int i = 0; i < 4; ++i)
#pragma unroll
                    for (int e = 0; e < 4; ++e) ob[RMAP(i, 4 * q + e) * 72] = (bf16)f2bf(o[i][e]);
            }
            __syncthreads();
        }
        }
#undef SCAN_LOAD
#undef SCAN_STORE
#undef SCAN_FLUSH
    }
}
constexpr int IN_AT = 0, IN_TILE = 18432, IN_G = 18432 + 19456, IN_WAVE = 18432 + 19456 + 1024;
__device__ __forceinline__ unsigned tile_row(int row) { return (unsigned)(row * 288 + (row >> 3) * 128); }
__device__ __forceinline__ void phase_dn_intra(const Args& a, const Ctx& C) {
    if (C.wave >= 4) return;
    LAS unsigned char* wb = C.lds + C.wave * IN_WAVE;
    LAS float* AT = (LAS float*)(wb + IN_AT); LAS unsigned char* TU = wb + IN_AT; LAS unsigned char* TW = wb + IN_AT + 9216; LAS unsigned char* TL = wb + IN_TILE;
    LAS float* gs = (LAS float*)(wb + IN_G); LAS float* bs = gs + 64; LAS float* es = gs + 128; LAS float* ks = gs + 192;
    const unsigned tl_addr = (unsigned)(uintptr_t)TL;
    const bf16* QKV = (const bf16*)a.out; const float* LA = (const float*)(a.ws + WS_LA); const float* BT = (const float*)(a.ws + WS_BT);
    bf16* UT = (bf16*)(a.ws + WS_U); bf16* WN = (bf16*)(a.ws + WS_W); bf16* QK = (bf16*)(a.ws + WS_QK);
    float* GL = (float*)(a.ws + WS_GL); float* GE = (float*)(a.ws + WS_GE);
    const int wid = C.bid * 4 + C.wave, nw = C.G * 4;
    for (int unit = wid; unit < NUNIT; unit += nw) {
        int lane = C.lane; asm volatile("" : "+v"(lane));
        const int cg = unit >> 3, h = (unit >> 1) & 3, d = unit & 1;
        const size_t ub = (size_t)unit;
        u32x4 kst[16]; float la_n, b_n;
        { const int m = cg * 64 + (d ? 63 - lane : lane); la_n = LA[(size_t)m * 8 + d * 4 + h]; b_n = BT[(size_t)m * 8 + d * 4 + h];
          const unsigned char* kb_ = (const unsigned char*)(QKV + (size_t)cg * 64 * 1536 + 512 + h * 128);
#pragma unroll
          for (int c = 0; c < 16; ++c) { const int ch = c * 64 + lane, row = ch >> 4, cc = ch & 15; const unsigned off = (unsigned)((d ? 63 - row : row) * 3072 + cc * 16); kst[c] = *(const u32x4*)(kb_ + off); } }
        s16x8 Qall[4][4];
        { const int fr0 = lane & 15, q0_ = lane >> 4; const unsigned char* qb_ = (const unsigned char*)(QKV + (size_t)cg * 64 * 1536 + h * 128);
#pragma unroll
          for (int it = 0; it < 4; ++it) { const int i = 16 * it + fr0; const unsigned off = (unsigned)((d ? 63 - i : i) * 3072 + q0_ * 16);
#pragma unroll
              for (int s = 0; s < 4; ++s) Qall[it][s] = *(const s16x8*)(qb_ + off + 64 * s); } }
        { float g = la_n;
#pragma unroll
          for (int o = 1; o < 64; o <<= 1) { const float t = __int_as_float(__builtin_amdgcn_ds_bpermute(((lane - o) & 63) << 2, __float_as_int(g))); if (lane >= o) g += t; }
          const float g63 = __int_as_float(__builtin_amdgcn_readlane(__float_as_int(g), 63));
          const float eg_ = expf(g); gs[lane] = g; bs[lane] = b_n; const float kd_ = expf(g63 - g); es[lane] = eg_; ks[lane] = kd_; GE[ub * 128 + lane] = eg_; GE[ub * 128 + 64 + lane] = kd_;
          if (lane == 63) GL[unit] = expf(g); }
        asm volatile("s_waitcnt lgkmcnt(0)" ::: "memory");
        { int ln_ = lane; asm volatile("" : "+v"(ln_)); const int fr = ln_ & 15, q = ln_ >> 4;
#pragma unroll
        for (int c = 0; c < 16; ++c) { const int ch = c * 64 + lane, row = ch >> 4, cc = ch & 15; *(LAS u32x4*)(TL + tile_row(row) + cc * 16) = kst[c]; }
        asm volatile("s_waitcnt lgkmcnt(0)" ::: "memory");
#pragma unroll
        for (int it = 0; it < 4; ++it) {
            s16x8 Qf[4];
            {
#pragma unroll
              for (int s = 0; s < 4; ++s) Qf[s] = Qall[it][s]; }
#pragma unroll
            for (int jt = 0; jt < 4; ++jt) {
                if (jt <= it) {
                    f32x4 dk = (f32x4){0.f, 0.f, 0.f, 0.f}, dq = (f32x4){0.f, 0.f, 0.f, 0.f};
#pragma unroll
                    for (int s = 0; s < 4; ++s) { const s16x8 ki = *(const LAS s16x8*)(TL + tile_row(16 * it + fr) + (32 * s + 8 * q) * 2), kj = *(const LAS s16x8*)(TL + tile_row(16 * jt + fr) + (32 * s + 8 * q) * 2);
                        dk = __builtin_amdgcn_mfma_f32_16x16x32_bf16(ki, kj, dk, 0, 0, 0);
                        dq = __builtin_amdgcn_mfma_f32_16x16x32_bf16(kj, Qf[s], dq, 0, 0, 0); }
                    { const int j = 16 * jt + fr; const float gj = gs[j]; f32x4 av; const f32x4 gi4 = *(const LAS f32x4*)(gs + 16 * it + 4 * q), bi4 = *(const LAS f32x4*)(bs + 16 * it + 4 * q);
#pragma unroll
                      for (int e = 0; e < 4; ++e) { const int i = 16 * it + 4 * q + e; const float v = dk[e] * bi4[e] * __expf(fminf(gi4[e] - gj, 0.f)); av[e] = (i > j) ? v : 0.f; }
                      *(LAS f32x4*)(AT + j * 64 + 16 * it + 4 * q) = av; }
                    { const int i = 16 * it + fr; const float gi = gs[i]; float qv[4]; const f32x4 gj4 = *(const LAS f32x4*)(gs + 16 * jt + 4 * q);
#pragma unroll
                      for (int e = 0; e < 4; ++e) { const int j = 16 * jt + 4 * q + e; const float v = dq[e] * __expf(fminf(gi - gj4[e], 0.f)); qv[e] = (i >= j) ? v : 0.f; }
                      u32x2 w; w.x = pk2(qv[0], qv[1]); w.y = pk2(qv[2], qv[3]); *(u32x2*)(QK + ub * 4096 + i * 64 + 16 * jt + 4 * q) = w; }
                } else { const int i = 16 * it + fr; *(u32x2*)(QK + ub * 4096 + i * 64 + 16 * jt + 4 * q) = (u32x2){0u, 0u};
                    *(LAS f32x4*)(AT + (16 * jt + fr) * 64 + 16 * it + 4 * q) = (f32x4){0.f, 0.f, 0.f, 0.f}; }
                    }
        }
        }
        asm volatile("s_waitcnt lgkmcnt(0)" ::: "memory");
        u32x4 vst[16];
        f32x4 a21[2][2];
        { int ln_ = lane; asm volatile("" : "+v"(ln_)); const int hb = ln_ >> 5, r = ln_ & 31;
          const LAS float* ATb = AT + hb * (32 * 64 + 32);
          LAS float* trow = (LAS float*)(TL + 5120) + ln_ * 36;
#pragma unroll
          for (int k = 0; k < 8; ++k) *(LAS f32x4*)(trow + 4 * k) = (f32x4){0.f, 0.f, 0.f, 0.f};
          trow[31] = (r == 31) ? 1.f : 0.f;
#pragma unroll 1
          for (int cc = 30; cc >= 0; --cc) { float acc0 = (r == cc) ? 1.f : 0.f, acc1 = 0.f; const LAS float* ap = ATb + cc * 64;
              float acc2 = 0.f, acc3 = 0.f;
#pragma unroll
              for (int hq = 0; hq < 2; ++hq) { f32x4 av[4], tv[4];
#pragma unroll
                  for (int jq = 0; jq < 4; ++jq) { av[jq] = *(const LAS f32x4*)(ap + 16 * hq + 4 * jq); tv[jq] = *(const LAS f32x4*)(trow + 16 * hq + 4 * jq); }
#pragma unroll
                  for (int jq = 0; jq < 4; ++jq) { acc0 -= av[jq][0] * tv[jq][0]; acc1 -= av[jq][1] * tv[jq][1]; acc2 -= av[jq][2] * tv[jq][2]; acc3 -= av[jq][3] * tv[jq][3]; } }
              trow[cc] = (acc0 + acc1) + (acc2 + acc3); }
          { const int fr = ln_ & 15, q = ln_ >> 4;
#pragma unroll
            for (int t = 0; t < 2; ++t)
#pragma unroll
                for (int jt = 0; jt < 2; ++jt) a21[t][jt] = *(const LAS f32x4*)(AT + (16 * jt + fr) * 64 + 32 + 16 * t + 4 * q); }
          asm volatile("s_waitcnt lgkmcnt(0)" ::: "memory");
          { LAS unsigned char* dst = TL + hb * 2560 + r * 80;
#pragma unroll 1
            for (int c8 = 0; c8 < 4; ++c8) { float f[8], fu[8], fw[8]; const f32x4 t0 = *(const LAS f32x4*)(trow + 8 * c8), t1 = *(const LAS f32x4*)(trow + 8 * c8 + 4);
                const LAS float* bp = bs + 32 * hb + 8 * c8; const LAS float* ep = es + 32 * hb + 8 * c8;
                const f32x4 b0 = *(const LAS f32x4*)bp, b1 = *(const LAS f32x4*)(bp + 4), e0 = *(const LAS f32x4*)ep, e1 = *(const LAS f32x4*)(ep + 4);
#pragma unroll
                for (int e = 0; e < 4; ++e) { f[e] = t0[e]; f[4 + e] = t1[e]; fu[e] = t0[e] * b0[e]; fu[4 + e] = t1[e] * b1[e]; fw[e] = fu[e] * e0[e]; fw[4 + e] = fu[4 + e] * e1[e]; }
                *(LAS u32x4*)(dst + c8 * 16) = pack8(f);
                *(LAS u32x4*)(TU + ln_ * 144 + (4 * hb + c8) * 16) = pack8(fu); *(LAS u32x4*)(TW + ln_ * 144 + (4 * hb + c8) * 16) = pack8(fw);
                *(LAS u32x4*)(TU + ln_ * 144 + (4 * (1 - hb) + c8) * 16) = (u32x4){0u, 0u, 0u, 0u}; *(LAS u32x4*)(TW + ln_ * 144 + (4 * (1 - hb) + c8) * 16) = (u32x4){0u, 0u, 0u, 0u}; } }
        }
        asm volatile("s_waitcnt lgkmcnt(0)" ::: "memory");
        { int ln_ = lane; asm volatile("" : "+v"(ln_)); const int fr = ln_ & 15, q = ln_ >> 4;
          s16x8 t22f[2];
#pragma unroll
          for (int rt = 0; rt < 2; ++rt) t22f[rt] = afrag(TL + 2560 + (16 * rt + fr) * 80 + 8 * q);
          f32x4 zt[2][2];
#pragma unroll
          for (int jt = 0; jt < 2; ++jt) { const s16x8 af = pack_acc2(a21[0][jt], a21[1][jt]);
#pragma unroll
              for (int rt = 0; rt < 2; ++rt) zt[jt][rt] = __builtin_amdgcn_mfma_f32_16x16x32_bf16(af, t22f[rt], (f32x4){0.f, 0.f, 0.f, 0.f}, 0, 0, 0); }
#pragma unroll
          for (int ct = 0; ct < 2; ++ct) { u32x2 lo_, hi_; const unsigned ad_ = tl_addr + (unsigned)((4 * q + (fr >> 2)) * 80 + (16 * ct + 4 * (fr & 3)) * 2);
              asm volatile("ds_read_b64_tr_b16 %0, %2\n\tds_read_b64_tr_b16 %1, %2 offset:1280\n\ts_waitcnt lgkmcnt(0)" : "=&v"(lo_), "=&v"(hi_) : "v"(ad_) : "memory");
              u32x4 w_; w_.x = lo_.x; w_.y = lo_.y; w_.z = hi_.x; w_.w = hi_.y; const s16x8 t11f = __builtin_bit_cast(s16x8, w_);
              const f32x4 b4 = *(const LAS f32x4*)(bs + 16 * ct + 4 * q), e4 = *(const LAS f32x4*)(es + 16 * ct + 4 * q);
#pragma unroll
              for (int rt = 0; rt < 2; ++rt) { const f32x4 dd = __builtin_amdgcn_mfma_f32_16x16x32_bf16(t11f, pack_acc2(zt[0][rt], zt[1][rt]), (f32x4){0.f, 0.f, 0.f, 0.f}, 0, 0, 0);
                  float fu[4], fw[4];
#pragma unroll
                  for (int e = 0; e < 4; ++e) { fu[e] = -dd[e] * b4[e]; fw[e] = fu[e] * e4[e]; }
                  u32x2 wu, ww; wu.x = pk2(fu[0], fu[1]); wu.y = pk2(fu[2], fu[3]); ww.x = pk2(fw[0], fw[1]); ww.y = pk2(fw[2], fw[3]);
                  *(LAS u32x2*)(TU + (32 + 16 * rt + fr) * 144 + (16 * ct + 4 * q) * 2) = wu; *(LAS u32x2*)(TW + (32 + 16 * rt + fr) * 144 + (16 * ct + 4 * q) * 2) = ww; } }
          asm volatile("s_waitcnt lgkmcnt(0)" ::: "memory");
#pragma unroll
          for (int c = 0; c < 16; ++c) { const int ch = c * 64 + ln_, row = ch >> 4, cc = ch & 15; *(LAS u32x4*)(TL + tile_row(row) + cc * 16) = kst[c]; }
        }
        asm volatile("s_waitcnt lgkmcnt(0)" ::: "memory");
        { const unsigned char* vb_ = (const unsigned char*)(QKV + (size_t)cg * 64 * 1536 + 1024 + h * 128);
#pragma unroll
        for (int c = 0; c < 16; ++c) { const int ch = c * 64 + lane, row = ch >> 4, cc = ch & 15; const unsigned off = (unsigned)((d ? 63 - row : row) * 3072 + cc * 16); vst[c] = *(const u32x4*)(vb_ + off); } }
        { int ln_ = lane; asm volatile("" : "+v"(ln_)); const int fr = ln_ & 15, q = ln_ >> 4;
        const unsigned tr_lane = (unsigned)(((fr >> 2)) * 288 + (4 * (fr & 3)) * 2);
#define TR_FRAG(dst, ct, s) do { u32x2 lo_, hi_; const unsigned ad_ = tl_addr + tile_row(32 * (s) + 8 * q) + tr_lane + (unsigned)(ct) * 32u; \
            asm volatile("ds_read_b64_tr_b16 %0, %2\n\tds_read_b64_tr_b16 %1, %2 offset:1152\n\ts_waitcnt lgkmcnt(0)" : "=&v"(lo_), "=&v"(hi_) : "v"(ad_) : "memory"); \
            u32x4 w_; w_.x = lo_.x; w_.y = lo_.y; w_.z = hi_.x; w_.w = hi_.y; dst = __builtin_bit_cast(s16x8, w_); } while (0)
        s16x8 Tf[4][2];
#pragma unroll
        for (int it = 0; it < 4; ++it)
#pragma unroll
            for (int s = 0; s < 2; ++s) Tf[it][s] = *(const LAS s16x8*)(TW + (16 * it + fr) * 144 + (32 * s + 8 * q) * 2);
        asm volatile("s_waitcnt lgkmcnt(0)" ::: "memory");
#pragma unroll 1
        for (int hf = 0; hf < 2; ++hf) {
            s16x8 kfr[4][2];
#pragma unroll
            for (int c4 = 0; c4 < 4; ++c4) { TR_FRAG(kfr[c4][0], 4 * hf + c4, 0); TR_FRAG(kfr[c4][1], 4 * hf + c4, 1); }
#pragma unroll
            for (int c4 = 0; c4 < 4; ++c4)
#pragma unroll
                for (int it = 0; it < 4; ++it) { f32x4 acc = (f32x4){0.f, 0.f, 0.f, 0.f};
                    acc = __builtin_amdgcn_mfma_f32_16x16x32_bf16(kfr[c4][0], Tf[it][0], acc, 0, 0, 0); acc = __builtin_amdgcn_mfma_f32_16x16x32_bf16(kfr[c4][1], Tf[it][1], acc, 0, 0, 0);
                    u32x2 w; w.x = pk2(-acc[0], -acc[1]); w.y = pk2(-acc[2], -acc[3]); *(LAS u32x2*)(TW + (16 * it + fr) * 144 + (16 * c4 + 4 * q) * 2) = w; }
            asm volatile("s_waitcnt lgkmcnt(0)" ::: "memory");
#pragma unroll 4
            for (int c = 0; c < 8; ++c) { const int idx = c * 64 + ln_; *(u32x4*)(WN + ub * 8192 + (idx >> 3) * 128 + hf * 64 + (idx & 7) * 8) = *(const LAS u32x4*)(TW + (idx >> 3) * 144 + (idx & 7) * 16); }
            asm volatile("s_waitcnt lgkmcnt(0)" ::: "memory");
        }
        }
        { int ln_ = lane; asm volatile("" : "+v"(ln_)); const int fr = ln_ & 15, q = ln_ >> 4;
        const unsigned tr_lane = (unsigned)(((fr >> 2)) * 288 + (4 * (fr & 3)) * 2);
#pragma unroll
        for (int c = 0; c < 16; ++c) { const int ch = c * 64 + lane, row = ch >> 4, cc = ch & 15; *(LAS u32x4*)(TL + tile_row(row) + cc * 16) = vst[c]; }
        asm volatile("s_waitcnt lgkmcnt(0)" ::: "memory");
        s16x8 Tf[4][2];
#pragma unroll
        for (int it = 0; it < 4; ++it)
#pragma unroll
            for (int s = 0; s < 2; ++s) Tf[it][s] = *(const LAS s16x8*)(TU + (16 * it + fr) * 144 + (32 * s + 8 * q) * 2);
        asm volatile("s_waitcnt lgkmcnt(0)" ::: "memory");
#pragma unroll
        for (int ct = 0; ct < 8; ++ct) { s16x8 vf0, vf1; TR_FRAG(vf0, ct, 0); TR_FRAG(vf1, ct, 1);
#pragma unroll
            for (int it = 0; it < 4; ++it) { f32x4 acc = (f32x4){0.f, 0.f, 0.f, 0.f};
                acc = __builtin_amdgcn_mfma_f32_16x16x32_bf16(Tf[it][0], vf0, acc, 0, 0, 0); acc = __builtin_amdgcn_mfma_f32_16x16x32_bf16(Tf[it][1], vf1, acc, 0, 0, 0);
                u32x2 w; w.x = pk2(acc[0], acc[1]); w.y = pk2(acc[2], acc[3]); *(LAS u32x2*)(TU + (16 * ct + fr) * 144 + (16 * it + 4 * q) * 2) = w; } }
        asm volatile("s_waitcnt lgkmcnt(0)" ::: "memory");
#pragma unroll 4
        for (int c = 0; c < 16; ++c) { const int idx = c * 64 + ln_; *(u32x4*)(UT + ub * 8192 + idx * 8) = *(const LAS u32x4*)(TU + (idx >> 3) * 144 + (idx & 7) * 16); }
        asm volatile("s_waitcnt lgkmcnt(0)" ::: "memory");
        }
#undef TR_FRAG
    }
}

#ifndef MK_N_LAUNCHES
#define MK_N_LAUNCHES 1
#endif
constexpr int NPH = 21;
constexpr int MOE_TAB_OFF = 131072 + 8192;
#ifndef PG8_SP2
#define PG8_SP2 true
#endif
#ifndef PG8_ALIGN
#define PG8_ALIGN true
#endif
__global__ void __launch_bounds__(NTHR, 2) fwd(Args a) {
    extern __shared__ __attribute__((aligned(16))) unsigned char lds_raw[];
    Ctx C; C.lds = (LAS unsigned char*)lds_raw; C.tid = threadIdx.x; C.lane = C.tid & 63; C.wave = __builtin_amdgcn_readfirstlane(C.tid >> 6);
    C.G = gridDim.x; C.bid = blockIdx.x; C.gw = C.bid * NWAVES + C.wave; C.ngw = C.G * NWAVES;
    C.vcu = (C.G % 8 == 0) ? (C.bid % 8) * (C.G / 8) + C.bid / 8 : C.bid;
#define FRESH(Cn) Ctx Cn; { int t_ = threadIdx.x; asm volatile("" : "+v"(t_)); Cn.lds = C.lds; Cn.tid = t_; Cn.lane = t_ & 63; Cn.wave = __builtin_amdgcn_readfirstlane(t_ >> 6); Cn.G = C.G; Cn.bid = C.bid; Cn.vcu = C.vcu; Cn.gw = Cn.bid * NWAVES + Cn.wave; Cn.ngw = C.ngw; }
    volatile LAS unsigned* MISC = (volatile LAS unsigned*)(C.lds + MISC_OFF);
    for (int u = C.tid; u < (LDS_BYTES - LDSCTL_OFF) / 4; u += NTHR) ((LAS unsigned*)(C.lds + LDSCTL_OFF))[u] = 0u;
    __syncthreads();
    const int lo = a.ph_lo, hi = a.ph_hi;
    unsigned* ctl = (unsigned*)(a.ws + WS_CTL);
    XcdBarrier bar; bar.bar = ctl + CW_BAR; bar.x = 0; bar.st = nullptr;
    if (hi - lo > 1) bar = xcd_barrier_post(ctl + CW_BAR, MISC + 8);
#define IN(k) (lo <= (k) && (k) < hi)
#define SEAM(k) do { if (IN(k) && (k) + 1 < hi) xcd_barrier(bar); } while (0)
    PG8_LAS unsigned char* ring = (PG8_LAS unsigned char*)(C.lds + RING_OFF);
    const float* MOD = (const float*)(a.ws + WS_MOD);

    if (IN(0)) { FRESH(Cp) phase_prologue(a, Cp); } SEAM(0);
    if (IN(1)) { FRESH(Cp) phase_norm0(a, Cp); } SEAM(1);
    if (IN(2)) {
        pg8::Gemm g{(const bf16*)(a.ws + WS_A), (const bf16*)(a.ws + WS_WIN0), RT, NZ, D}; pg8::StaticOrder S; S.init(RT, NZ, C.G, C.bid);
        pg8::EpiBf16N E{(bf16*)(a.ws + WS_Z), NZ, 0xffff};
        pg8::gemm_phase<pg8::EpiBf16N, pg8::StaticOrder, PG8_ALIGN, PG8_SP2>(ring, g, S, E);
    } SEAM(2);
    if (IN(3)) { FRESH(Cp) phase_conv(a, Cp); } SEAM(3);
    if (IN(4)) { FRESH(Cp) phase_dn_intra(a, Cp); } SEAM(4);
    if (IN(5)) { FRESH(Cp) phase_dn_scan(a, Cp); } SEAM(5);
    if (IN(6)) { FRESH(Cp) phase_dn_combine(a, Cp); } SEAM(6);
    if (IN(7)) {
        pg8::Gemm g{(const bf16*)(a.ws + WS_MIX), (const bf16*)(a.ws + WS_WOUT0), RT, D, D}; pg8::StaticOrder S; S.init(RT, D, C.G, C.bid);
        pg8::EpiBf16N E{(bf16*)(a.ws + WS_Y), D, 0xffff};
        pg8::gemm_phase<pg8::EpiBf16N, pg8::StaticOrder, PG8_ALIGN, PG8_SP2>(ring, g, S, E);
        { FRESH(Cp) moe_convert(a, Cp, 0, C.G == 256 ? 64 : 0); }
    } SEAM(7);
    if (IN(8)) { FRESH(Cp) phase_ffn_norm_route(a, Cp, 0); } SEAM(8);
    if (IN(10)) {
        int nT; { FRESH(Cp) nT = moe_tables(a, Cp, 0, MOE_TAB_OFF); }
        pg8::Gemm g{(const bf16*)(a.ws + WS_A), (const bf16*)(a.ws + WS_WUP), 0, 0, D}; pg8::MoeOrder S{(const PG8_LAS int*)(C.lds + MOE_TAB_OFF), nT, C.G, C.vcu, (const int*)(a.ws + WS_ROWSE), RT};
        pg8::EpiSwiGLU E{(bf16*)(a.ws + WS_HG)};
        pg8::gemm_phase<pg8::EpiSwiGLU, pg8::MoeOrder, PG8_ALIGN, PG8_SP2, true>(ring, g, S, E);
    } SEAM(10);
    if (IN(11)) {
        int nT; { FRESH(Cp) nT = moe_tables(a, Cp, 0, MOE_TAB_OFF); }
        pg8::Gemm g{(const bf16*)(a.ws + WS_HG), (const bf16*)(a.ws + WS_WDN), 0, 0, 512}; pg8::MoeOrder S{(const PG8_LAS int*)(C.lds + MOE_TAB_OFF), nT, C.G, C.vcu, nullptr, RT};
        pg8::EpiBf16N E{(bf16*)(a.ws + WS_YG), D, 3};
        pg8::gemm_phase<pg8::EpiBf16N, pg8::MoeOrder, PG8_ALIGN, PG8_SP2>(ring, g, S, E);
    } SEAM(11);
    if (IN(12)) { FRESH(Cp) phase_moe_combine(a, Cp, 0); } SEAM(12);
    if (IN(13)) {
        pg8::Gemm g{(const bf16*)(a.ws + WS_A), (const bf16*)(a.ws + WS_WIN1), RT, 1536, D}; pg8::QkvOrder S{C.G, C.vcu};
        pg8::EpiRope E{(bf16*)(a.ws + WS_Q1), (bf16*)(a.ws + WS_K1), (bf16*)(a.ws + WS_V1), (const float*)(a.ws + WS_COS), (const float*)(a.ws + WS_SIN)};
        pg8::gemm_phase<pg8::EpiRope, pg8::QkvOrder, PG8_ALIGN, PG8_SP2>(ring, g, S, E);
        { FRESH(Cp) Cp.bid = C.vcu; moe_convert(a, Cp, 1, C.G == 256 ? 32 : 0); }
    } SEAM(13);
    if (IN(14)) { FRESH(Cp) phase_attn(a, Cp); } SEAM(14);
    if (IN(15)) {
        pg8::Gemm g{(const bf16*)(a.ws + WS_O1), (const bf16*)(a.ws + WS_WOUT1), RL, D, D}; pg8::StaticOrder S; S.init(RL, D, C.G, C.bid);
        pg8::EpiBf16N E{(bf16*)(a.ws + WS_Y), D, 0xffff};
        pg8::gemm_phase<pg8::EpiBf16N, pg8::StaticOrder, PG8_ALIGN, PG8_SP2>(ring, g, S, E);
    } SEAM(15);
    if (IN(16)) { FRESH(Cp) phase_ffn_norm_route(a, Cp, 1); } SEAM(16);
    if (IN(18)) {
        int nT; { FRESH(Cp) nT = moe_tables(a, Cp, 1, MOE_TAB_OFF); }
        pg8::Gemm g{(const bf16*)(a.ws + WS_A), (const bf16*)(a.ws + WS_WUP), 0, 0, D}; pg8::MoeOrder S{(const PG8_LAS int*)(C.lds + MOE_TAB_OFF), nT, C.G, C.vcu, (const int*)(a.ws + WS_ROWSE), RT};
        pg8::EpiSwiGLU E{(bf16*)(a.ws + WS_HG)};
        pg8::gemm_phase<pg8::EpiSwiGLU, pg8::MoeOrder, PG8_ALIGN, PG8_SP2, true>(ring, g, S, E);
    } SEAM(18);
    if (IN(19)) {
        int nT; { FRESH(Cp) nT = moe_tables(a, Cp, 1, MOE_TAB_OFF); }
        pg8::Gemm g{(const bf16*)(a.ws + WS_HG), (const bf16*)(a.ws + WS_WDN), 0, 0, 512}; pg8::MoeOrder S{(const PG8_LAS int*)(C.lds + MOE_TAB_OFF), nT, C.G, C.vcu, nullptr, RT};
        pg8::EpiBf16N E{(bf16*)(a.ws + WS_YG), D, 3};
        pg8::gemm_phase<pg8::EpiBf16N, pg8::MoeOrder, PG8_ALIGN, PG8_SP2>(ring, g, S, E);
    } SEAM(19);
    if (IN(20)) { FRESH(Cp) phase_moe_combine(a, Cp, 1); }
#undef IN
#undef SEAM
}

extern "C" void kernel_launch(void* const* d_in, const int* in_sizes, int n_in, void* d_out, int out_size, void* d_ws, size_t ws_size, hipStream_t stream) {
    static int grid = 0;
    if (grid == 0) {
        if (n_in != 24 || in_sizes[0] != RL * D || out_size != RL * D || ws_size < WS_END) { fprintf(stderr, "kernel_launch: unexpected shapes: n_in %d in0 %d out %d ws %zu (need %zu)\n", n_in, n_in > 0 ? in_sizes[0] : -1, out_size, ws_size, (size_t)WS_END); grid = -1; return; }
        int dev = 0, cus = 0;
        if (hipGetDevice(&dev) != hipSuccess || hipDeviceGetAttribute(&cus, hipDeviceAttributeMultiprocessorCount, dev) != hipSuccess) { grid = -1; return; }
        if (hipFuncSetAttribute((const void*)fwd, hipFuncAttributeMaxDynamicSharedMemorySize, LDS_BYTES) != hipSuccess) { fprintf(stderr, "kernel_launch: hipFuncSetAttribute failed\n"); grid = -1; return; }
        int per_cu = 0;
        if (hipOccupancyMaxActiveBlocksPerMultiprocessor(&per_cu, (const void*)fwd, NTHR, LDS_BYTES) != hipSuccess || per_cu < 1) fprintf(stderr, "kernel_launch: occupancy query reports %d\n", per_cu);
        (void)hipGetLastError();
        grid = cus;
    }
    if (grid < 0) return;
    if (hipMemsetAsync((char*)d_ws + WS_CTL, 0, CTL_ZERO_BYTES, stream) != hipSuccess) return;
    Args a{};
    const float** f = (const float**)&a;
    for (int i = 0; i < 24; ++i) f[i] = (const float*)d_in[i];
    a.out = (float*)d_out; a.ws = (unsigned char*)d_ws;
    for (int li = 0; li < MK_N_LAUNCHES; ++li) {
        a.ph_lo = (MK_N_LAUNCHES == 1) ? 0 : li; a.ph_hi = (MK_N_LAUNCHES == 1) ? NPH : li + 1;
        hipLaunchKernelGGL(fwd, dim3(grid), dim3(NTHR), LDS_BYTES, stream, a);
    }
}
```

```cpp
#include <hip/hip_runtime.h>
#include <cstdio>
#include <cstdint>
namespace pg8 {
#define PG8_LAS __attribute__((address_space(3)))
typedef unsigned short bf16_t;
typedef short bf16x8 __attribute__((ext_vector_type(8)));
typedef float f32x4 __attribute__((ext_vector_type(4)));
typedef unsigned u32x4 __attribute__((ext_vector_type(4)));
typedef unsigned u32x2 __attribute__((ext_vector_type(2)));
constexpr int BM = 256, BK = 64, HALF = 128, HTB = HALF * BK * 2  , STAGE_BYTES = 8 * HTB, NXCD = 8, WGM = 8;

__host__ __device__ __forceinline__ int lds_byte(int r, int c) { const int st = (r >> 4) * 2 + (c >> 5), rr = r & 15, cc = c & 31, ob = rr * 64 + cc * 2; return st * 1024 + (ob ^ (((ob >> 9) & 1) << 5)); }
__host__ __device__ __forceinline__ void stage_rc(int b, int& R, int& C) { const int st = b / 1024, sb = b % 1024, swz = sb ^ (((sb >> 9) & 1) << 5); R = (st >> 1) * 16 + swz / 64; C = (st & 1) * 32 + (swz % 64) / 2; }
__host__ __device__ __forceinline__ int perm32(int rho) { const int n = rho >> 4, i = rho & 15; return 8 * (i >> 2) + 4 * n + (i & 3); }

struct Unit { int pm, pn; };
struct Gemm { const bf16_t* A; const bf16_t* Bt; int M, N, K; };

struct StaticOrder {
    int nM, nN, nwg, G, c;
    __host__ __device__ void init(int M, int N, int G_, int c_) { nM = M / BM; nN = N / BM; nwg = nM * nN; G = G_; c = c_; }
    __host__ __device__ bool next(int i, Unit& u) const {
        const long L = (long)i * G + c; if (L >= nwg) return false;
        int wgid = (int)L; { const int q = nwg / NXCD, r = nwg % NXCD, xcd = wgid % NXCD, off = wgid / NXCD; wgid = (xcd < r ? xcd * (q + 1) : r * (q + 1) + (xcd - r) * q) + off; }
        const int nig = WGM * nN, gid = wgid / nig, fm = gid * WGM, gsz = (nM - fm) < WGM ? (nM - fm) : WGM;
        u.pm = fm + ((wgid % nig) % gsz); u.pn = (wgid % nig) / gsz; return true;
    }
    __device__ __forceinline__ void a_ready(const Unit&) const {}
    __device__ __forceinline__ void done(const Unit&) const {}
};

typedef float f32x2c __attribute__((ext_vector_type(2)));
typedef __bf16 bf16x2c __attribute__((ext_vector_type(2)));
__device__ __forceinline__ unsigned cvt_pk_bf16(float lo, float hi) { const f32x2c v = {lo, hi}; const bf16x2c b = __builtin_convertvector(v, bf16x2c); return __builtin_bit_cast(unsigned, b); }
__device__ __forceinline__ float silu_f(float x) { return x * __builtin_amdgcn_rcpf(1.0f + __expf(-x)); }

struct EpiBf16N {
    static constexpr bool PERM = true, AFTER_DRAIN = false;
    bf16_t* O; int ldc; int pnmask;
    __device__ __forceinline__ void operator()(const f32x4 (&acc)[2][2][4][2], const Unit& u, int wr, int wc, int fr, int fq) const {
        const int row0 = u.pm * BM + wr * 64 + fr; const int col0 = (u.pn & pnmask) * BM + wc * 32 + 8 * fq;
#pragma unroll
        for (int ai = 0; ai < 2; ++ai)
#pragma unroll
            for (int m = 0; m < 4; ++m) { bf16_t* rowp = O + (size_t)(row0 + ai * HALF + m * 16) * ldc + col0;
#pragma unroll
                for (int bj = 0; bj < 2; ++bj) { const f32x4 v0 = acc[ai][bj][m][0], v1 = acc[ai][bj][m][1];
                    u32x4 w; w.x = cvt_pk_bf16(v0[0], v0[1]); w.y = cvt_pk_bf16(v0[2], v0[3]); w.z = cvt_pk_bf16(v1[0], v1[1]); w.w = cvt_pk_bf16(v1[2], v1[3]);
                    *(u32x4*)(rowp + bj * HALF) = w; } }
    }
};
struct EpiSwiGLU {
    static constexpr bool PERM = true, AFTER_DRAIN = false;
    bf16_t* O;
    __device__ __forceinline__ void operator()(const f32x4 (&acc)[2][2][4][2], const Unit& u, int wr, int wc, int fr, int fq) const {
        const int row0 = u.pm * BM + wr * 64 + fr; const int col0 = (u.pn & 3) * 128 + wc * 16 + 4 * fq;
#pragma unroll
        for (int ai = 0; ai < 2; ++ai)
#pragma unroll
            for (int m = 0; m < 4; ++m) { bf16_t* rowp = O + (size_t)(row0 + ai * HALF + m * 16) * 512 + col0;
#pragma unroll
                for (int bj = 0; bj < 2; ++bj) { const f32x4 a = acc[ai][bj][m][0], b = acc[ai][bj][m][1];
                    u32x2 w; w.x = cvt_pk_bf16(silu_f(a[0]) * b[0], silu_f(a[1]) * b[1]); w.y = cvt_pk_bf16(silu_f(a[2]) * b[2], silu_f(a[3]) * b[3]);
                    *(u32x2*)(rowp + bj * 64) = w; } }
    }
};
struct EpiResid {
    static constexpr bool PERM = false, AFTER_DRAIN = false;
    const float* resid_ctx; const float* resid_lat; float* out_ctx; float* out_lat; const float* mod; int ctx_rows;
    __device__ __forceinline__ void operator()(const f32x4 (&acc)[2][2][4][2], const Unit& u, int wr, int wc, int fr, int fq) const {
        const int rt = u.pm * BM; const float* rs; float* op; const float* gp; int rbase;
        if (rt < ctx_rows) { rs = resid_ctx; op = out_ctx; gp = mod + 16 * 6144; rbase = rt; }
        else { rbase = rt - ctx_rows; rs = resid_lat; op = out_lat; gp = mod + (size_t)(rbase >> 11) * 6144; }
        const int col0 = u.pn * BM + wc * 32 + 4 * fq;
        f32x4 gv[2][2];
#pragma unroll
        for (int bj = 0; bj < 2; ++bj)
#pragma unroll
            for (int n = 0; n < 2; ++n) gv[bj][n] = *(const f32x4*)(gp + col0 + bj * HALF + n * 16);
#pragma unroll
        for (int ai = 0; ai < 2; ++ai)
#pragma unroll
            for (int m = 0; m < 4; ++m) { const size_t off = (size_t)(rbase + wr * 64 + fr + ai * HALF + m * 16) * 1024 + col0;
#pragma unroll
                for (int bj = 0; bj < 2; ++bj)
#pragma unroll
                    for (int n = 0; n < 2; ++n) { const f32x4 r = *(const f32x4*)(rs + off + bj * HALF + n * 16);
                        *(f32x4*)(op + off + bj * HALF + n * 16) = r + gv[bj][n] * acc[ai][bj][m][n]; } }
    }
};
struct EpiRope {
    static constexpr bool PERM = false, AFTER_DRAIN = false;
    bf16_t* Q; bf16_t* K; bf16_t* V; const float* ctab; const float* stab;
    __device__ __forceinline__ void operator()(const f32x4 (&acc)[2][2][4][2], const Unit& u, int wr, int wc, int fr, int fq) const {
        const int rt = u.pm * BM; const bool lat = rt >= 4096;
#pragma unroll
        for (int ai = 0; ai < 2; ++ai)
#pragma unroll
            for (int m = 0; m < 4; ++m) { const int r = rt + ai * HALF + wr * 64 + m * 16 + fr;
                f32x4 cs = (f32x4){1.f, 1.f, 1.f, 1.f}, sn = (f32x4){0.f, 0.f, 0.f, 0.f};
                if (lat && u.pn < 5) { const int t = (r - 4096) & 2047; const int pos = (wc & 1) ? (t & 63) : (t >> 6);
                    cs = *(const f32x4*)(ctab + pos * 16 + 4 * fq); sn = *(const f32x4*)(stab + pos * 16 + 4 * fq); }
#pragma unroll
                for (int bj = 0; bj < 2; ++bj) { const f32x4 u1 = acc[ai][bj][m][0], u2 = acc[ai][bj][m][1];
                    f32x4 o1 = u1 * cs - u2 * sn, o2 = u1 * sn + u2 * cs;
                    const int lc = bj * HALF + wc * 32 + 4 * fq; bf16_t* p;
                    if (u.pn < 4) { o1 = o1 * 0.18033688011112042f; o2 = o2 * 0.18033688011112042f;     p = Q + (size_t)(r - 4096) * 1024 + u.pn * BM + lc; }
                    else if (u.pn == 4) p = K + (size_t)r * 256 + lc;
                    else p = V + (size_t)r * 256 + lc;
                    u32x2 w1, w2; w1.x = cvt_pk_bf16(o1[0], o1[1]); w1.y = cvt_pk_bf16(o1[2], o1[3]); w2.x = cvt_pk_bf16(o2[0], o2[1]); w2.y = cvt_pk_bf16(o2[2], o2[3]);
                    *(u32x2*)p = w1; *(u32x2*)(p + 16) = w2; } }
    }
};
struct MoeOrder {
    const PG8_LAS int* tab; int nT, G, c; const int* rowse;
    int cap;
    __device__ __forceinline__ bool next(int i, Unit& u) const { const long L = (long)i * G + c; if (L >= (long)nT * 4) return false; const int pm = (int)(L >> 2); u.pm = pm; u.pn = tab[128 + pm] * 4 + (int)(L & 3); return true; }
    __device__ __forceinline__ int row(int pm, int r) const { const int e = tab[128 + pm], idx = pm * 256 - tab[32 + e] + r; return rowse[(size_t)e * cap + (idx < tab[e] ? idx : 0)]; }
    __device__ __forceinline__ void a_ready(const Unit&) const {}
    __device__ __forceinline__ void done(const Unit&) const {}
};
struct QkvOrder {
    int G, c;
    __device__ __forceinline__ bool next(int i, Unit& u) const { const long L = (long)i * G + c; if (L < 768) { u.pm = 16 + (int)(L / 6); u.pn = (int)(L % 6); return true; }
        if (L < 800) { u.pm = (int)(L - 768) >> 1; u.pn = 4 + ((int)(L - 768) & 1); return true; } return false; }
    __device__ __forceinline__ void a_ready(const Unit&) const {}
    __device__ __forceinline__ void done(const Unit&) const {}
};
struct LatOrder {
    int nM, nN, G, c;
    __device__ __forceinline__ bool next(int i, Unit& u) const { const long L = (long)i * G + c; if (L >= (long)nM * nN) return false; u.pm = (int)(L / nN); u.pn = (int)(L % nN); return true; }
    __device__ __forceinline__ void a_ready(const Unit&) const {}
    __device__ __forceinline__ void done(const Unit&) const {}
};
template <class Epi, class Sched, bool ALIGN_EPI = false, bool SP2 = false, bool GATHER = false>
__device__ __forceinline__ void gemm_phase(PG8_LAS unsigned char* lds, const Gemm g, const Sched& S, const Epi& E) {
    int tid_ = threadIdx.x; asm volatile("" : "+v"(tid_));
    const int tid = tid_, wid = __builtin_amdgcn_readfirstlane(tid >> 6), lane = tid & 63, wr = wid >> 2, wc = wid & 3, fr = lane & 15, fq = lane >> 4;
    const int K = g.K, nt = K / BK;
    unsigned voffA[2], voffB[2];
#pragma unroll
    for (int i = 0; i < 2; ++i) { int R, C; stage_rc(tid * 16 + i * 8192, R, C); const int Rb = Epi::PERM ? ((R & ~31) + perm32(R & 31)) : R;
        voffA[i] = (unsigned)(R * K + C) * 2u; voffB[i] = (unsigned)(Rb * K + C) * 2u; }
    const size_t kstep = (size_t)(BK * 2);
    const size_t hstep = (size_t)HALF * K * 2;
    const size_t tstep = 2 * hstep;
    const size_t hstepA = GATHER ? 0 : hstep;
    const unsigned ldsw = (unsigned)wid * 1024u;
    const int aoff = lds_byte(wr * 64 + fr, fq * 8), boff = lds_byte(wc * 32 + fr, fq * 8);
#define PG8_SA(b, h) (((b) * 2 + (h)) * HTB)
#define PG8_SB(b, h) ((4 + (b) * 2 + (h)) * HTB)
#define PG8_STAGE(bufoff, gbase, voff) do { _Pragma("unroll") for (int _i = 0; _i < 2; ++_i) \
        __builtin_amdgcn_global_load_lds((const unsigned*)((const char*)(gbase) + (voff)[_i]), (PG8_LAS unsigned*)(lds + (bufoff) + ldsw + _i * 8192), 16, 0, 0); } while (0)
#define PG8_LDA(dst, b, h) do { _Pragma("unroll") for (int m = 0; m < 4; ++m) _Pragma("unroll") for (int k = 0; k < 2; ++k) dst[m][k] = *(const PG8_LAS bf16x8*)(lds + PG8_SA(b, h) + aoff + m * 2048 + k * 1024); } while (0)
#define PG8_LDB(dst, b, h) do { _Pragma("unroll") for (int n = 0; n < 2; ++n) _Pragma("unroll") for (int k = 0; k < 2; ++k) dst[n][k] = *(const PG8_LAS bf16x8*)(lds + PG8_SB(b, h) + boff + n * 2048 + k * 1024); } while (0)
#define PG8_MMA(ai, bj, At, Bt) do { __builtin_amdgcn_s_setprio(1); _Pragma("unroll") for (int m = 0; m < 4; ++m) _Pragma("unroll") for (int n = 0; n < 2; ++n) _Pragma("unroll") for (int k = 0; k < 2; ++k) \
        acc[ai][bj][m][n] = __builtin_amdgcn_mfma_f32_16x16x32_bf16(Bt[n][k], At[m][k], acc[ai][bj][m][n], 0, 0, 0); __builtin_amdgcn_s_setprio(0); } while (0)
#define PG8_WAIT_V(n) asm volatile("s_waitcnt vmcnt(" #n ")" ::: "memory")
#define PG8_WAIT_L(n) asm volatile("s_waitcnt lgkmcnt(" #n ")" ::: "memory")
#define PG8_BAR __builtin_amdgcn_s_barrier()
#define PG8_SCHED __builtin_amdgcn_sched_barrier(0)
    Unit cur, nxt; int ui = 0;
    if (!S.next(0, cur)) return;
    f32x4 acc[2][2][4][2];
#pragma unroll
    for (int a = 0; a < 2; ++a)
#pragma unroll
        for (int b = 0; b < 2; ++b)
#pragma unroll
            for (int m = 0; m < 4; ++m)
#pragma unroll
                for (int n = 0; n < 2; ++n) acc[a][b][m][n] = (f32x4){0.f, 0.f, 0.f, 0.f};
    bf16x8 At[4][2], B0[2][2], B1[2][2];
    const char* cA = (const char*)g.A + (GATHER ? (size_t)0 : (size_t)cur.pm * tstep); const char* cB = (const char*)g.Bt + (size_t)cur.pn * tstep;
    unsigned vC[2][2], vN[2][2], v2[2][2];
    int RA[2], CA[2];
#pragma unroll
    for (int i = 0; i < 2; ++i) stage_rc(tid * 16 + i * 8192, RA[i], CA[i]);
    PG8_LAS int* lrows = (PG8_LAS int*)(lds + STAGE_BYTES);
    if constexpr (GATHER) {
        Unit uu; for (int i = 0; i < 8 && S.next(i, uu); ++i) { if (tid < 256) lrows[i * 256 + tid] = S.row(uu.pm, tid); }
        __syncthreads();
#pragma unroll
        for (int h = 0; h < 2; ++h)
#pragma unroll
            for (int i = 0; i < 2; ++i) vC[h][i] = (unsigned)lrows[h * 128 + RA[i]] * (unsigned)(K * 2) + (unsigned)(CA[i] * 2);
    } else {
#pragma unroll
        for (int h = 0; h < 2; ++h)
#pragma unroll
            for (int i = 0; i < 2; ++i) vC[h][i] = voffA[i];
    }
#pragma unroll
    for (int h = 0; h < 2; ++h)
#pragma unroll
        for (int i = 0; i < 2; ++i) { vN[h][i] = vC[h][i]; v2[h][i] = vC[h][i]; }
    S.a_ready(cur);
    if constexpr (SP2) {
        PG8_STAGE(PG8_SB(0, 0), cB, voffB); PG8_STAGE(PG8_SB(0, 1), cB + hstep, voffB); PG8_STAGE(PG8_SA(0, 0), cA, vC[0]); PG8_STAGE(PG8_SA(0, 1), cA + hstepA, vC[1]);
        if (wr == 1) PG8_BAR;
        PG8_WAIT_V(2); PG8_BAR;
        PG8_STAGE(PG8_SB(1, 0), cB + kstep, voffB); PG8_STAGE(PG8_SA(1, 0), cA + kstep, vC[0]); PG8_STAGE(PG8_SB(1, 1), cB + hstep + kstep, voffB);
        PG8_WAIT_V(6); PG8_BAR;
    } else {
        PG8_STAGE(PG8_SB(0, 0), cB, voffB); PG8_STAGE(PG8_SA(0, 0), cA, vC[0]); PG8_STAGE(PG8_SB(0, 1), cB + hstep, voffB); PG8_STAGE(PG8_SA(0, 1), cA + hstepA, vC[1]);
        if (wr == 1) PG8_BAR;
        PG8_WAIT_V(4); PG8_BAR;
        PG8_STAGE(PG8_SB(1, 0), cB + kstep, voffB); PG8_STAGE(PG8_SA(1, 0), cA + kstep, vC[0]); PG8_STAGE(PG8_SB(1, 1), cB + hstep + kstep, voffB);
        PG8_WAIT_V(6); PG8_BAR;
    }
    for (;;) {
        const bool has_next = S.next(ui + 1, nxt);
        const char* nA = (has_next && !GATHER) ? (const char*)g.A + (size_t)nxt.pm * tstep : cA; const char* nB = has_next ? (const char*)g.Bt + (size_t)nxt.pn * tstep : cB;
        if constexpr (GATHER) { if (has_next) {
#pragma unroll
            for (int h = 0; h < 2; ++h)
#pragma unroll
                for (int i = 0; i < 2; ++i) vN[h][i] = (unsigned)lrows[(ui + 1) * 256 + h * 128 + RA[i]] * (unsigned)(K * 2) + (unsigned)(CA[i] * 2); } }
        for (int t = 0; t < nt; t += 2) {
            const bool last = (t == nt - 2);
            const char* a1 = cA + (size_t)(t + 1) * kstep;
            const char* a2 = last ? nA : cA + (size_t)(t + 2) * kstep; const char* b2 = last ? nB : cB + (size_t)(t + 2) * kstep;
            const char* a3 = a2 + kstep; const char* b3 = b2 + kstep;
            if constexpr (GATHER) {
#pragma unroll
                for (int h = 0; h < 2; ++h)
#pragma unroll
                    for (int i = 0; i < 2; ++i) v2[h][i] = (last && has_next) ? vN[h][i] : vC[h][i]; }
            if (last && has_next) S.a_ready(nxt);
            if constexpr (SP2) {
            PG8_LDB(B0, 0, 0); PG8_LDB(B1, 0, 1); PG8_SCHED; PG8_LDA(At, 0, 0); PG8_STAGE(PG8_SA(1, 1), a1 + hstepA, vC[1]);
            PG8_WAIT_V(8); PG8_WAIT_L(0); PG8_BAR; PG8_MMA(0, 0, At, B0); PG8_MMA(0, 1, At, B1); PG8_BAR; PG8_SCHED;
            PG8_LDA(At, 0, 1); PG8_STAGE(PG8_SB(0, 0), b2, voffB); PG8_STAGE(PG8_SB(0, 1), b2 + hstep, voffB); PG8_STAGE(PG8_SA(0, 0), a2, v2[0]);
            PG8_WAIT_V(8); PG8_WAIT_L(0); PG8_BAR; PG8_MMA(1, 0, At, B0); PG8_MMA(1, 1, At, B1); PG8_BAR; PG8_SCHED;
            PG8_LDB(B0, 1, 0); PG8_LDB(B1, 1, 1); PG8_SCHED; PG8_LDA(At, 1, 0); PG8_STAGE(PG8_SA(0, 1), a2 + hstepA, v2[1]);
            PG8_WAIT_V(8); PG8_WAIT_L(0); PG8_BAR; PG8_MMA(0, 0, At, B0); PG8_MMA(0, 1, At, B1); PG8_BAR; PG8_SCHED;
            PG8_LDA(At, 1, 1); PG8_STAGE(PG8_SB(1, 0), b3, voffB); PG8_STAGE(PG8_SB(1, 1), b3 + hstep, voffB); PG8_STAGE(PG8_SA(1, 0), a3, v2[0]);
            PG8_WAIT_V(8); PG8_WAIT_L(0); PG8_BAR; PG8_MMA(1, 0, At, B0); PG8_MMA(1, 1, At, B1); PG8_BAR; PG8_SCHED;
            } else {
            PG8_LDB(B0, 0, 0); PG8_SCHED; PG8_LDA(At, 0, 0); PG8_STAGE(PG8_SA(1, 1), a1 + hstepA, vC[1]);
            PG8_WAIT_L(8); PG8_BAR; PG8_WAIT_L(0); PG8_MMA(0, 0, At, B0); PG8_BAR; PG8_SCHED;
            PG8_LDB(B1, 0, 1); PG8_STAGE(PG8_SB(0, 0), b2, voffB);
            PG8_BAR; PG8_WAIT_L(0); PG8_MMA(0, 1, At, B1); PG8_BAR;
            PG8_LDA(At, 0, 1); PG8_STAGE(PG8_SA(0, 0), a2, v2[0]);
            PG8_BAR; PG8_WAIT_L(0); PG8_MMA(1, 0, At, B0); PG8_BAR; PG8_SCHED;
            PG8_STAGE(PG8_SB(0, 1), b2 + hstep, voffB);
            PG8_WAIT_V(6); PG8_BAR; PG8_MMA(1, 1, At, B1); PG8_BAR;
            PG8_LDB(B0, 1, 0); PG8_SCHED; PG8_LDA(At, 1, 0); PG8_STAGE(PG8_SA(0, 1), a2 + hstepA, v2[1]);
            PG8_WAIT_L(8); PG8_BAR; PG8_WAIT_L(0); PG8_MMA(0, 0, At, B0); PG8_BAR; PG8_SCHED;
            PG8_LDB(B1, 1, 1); PG8_STAGE(PG8_SB(1, 0), b3, voffB);
            PG8_BAR; PG8_WAIT_L(0); PG8_MMA(0, 1, At, B1); PG8_BAR;
            PG8_LDA(At, 1, 1); PG8_STAGE(PG8_SA(1, 0), a3, v2[0]);
            PG8_BAR; PG8_WAIT_L(0); PG8_MMA(1, 0, At, B0); PG8_BAR; PG8_SCHED;
            PG8_STAGE(PG8_SB(1, 1), b3 + hstep, voffB);
            PG8_WAIT_V(6); PG8_BAR; PG8_MMA(1, 1, At, B1); PG8_BAR;
            }
        }
        if constexpr (ALIGN_EPI) { if (wr == 0) PG8_BAR; }
        if constexpr (!Epi::AFTER_DRAIN) { E(acc, cur, wr, wc, fr, fq); S.done(cur); }
        if (!has_next) break;
#pragma unroll
        for (int a = 0; a < 2; ++a)
#pragma unroll
            for (int b = 0; b < 2; ++b)
#pragma unroll
                for (int m = 0; m < 4; ++m)
#pragma unroll
                    for (int n = 0; n < 2; ++n) acc[a][b][m][n] = (f32x4){0.f, 0.f, 0.f, 0.f};
        cur = nxt; cA = nA; cB = nB; ++ui;
        if constexpr (GATHER) {
#pragma unroll
            for (int h = 0; h < 2; ++h)
#pragma unroll
                for (int i = 0; i < 2; ++i) vC[h][i] = vN[h][i]; }
        if constexpr (ALIGN_EPI) { if (wr == 1) PG8_BAR; }
    }
    PG8_WAIT_V(0);
    if constexpr (!ALIGN_EPI) { if (wr == 0) PG8_BAR; }
    PG8_BAR;
    if constexpr (Epi::AFTER_DRAIN) { E.fused(acc, cur, wr, wc, fr, fq, lds, wid, lane); S.done(cur); }
#undef PG8_SA
#undef PG8_SB
#undef PG8_STAGE
#undef PG8_LDA
#undef PG8_LDB
#undef PG8_MMA
#undef PG8_WAIT_V
#undef PG8_WAIT_L
#undef PG8_BAR
#undef PG8_SCHED
}
}

constexpr int NWAVES = 8, NTHR = 512;
constexpr int D = 1024, NB = 16, SEQ = 2048, LCTX = 256;
constexpr int RC = NB * LCTX;
constexpr int RL = NB * SEQ;
constexpr int RT = RC + RL;
constexpr int NZ = 3584;
constexpr int NUNIT = (RT / 64) * 8;
constexpr float EPS = 1e-6f;

constexpr size_t MiB = 1u << 20;
constexpr size_t WS_CTL = 0, CTL_ZERO_BYTES = 1 * MiB;
constexpr size_t WS_MOD = 1 * MiB;
constexpr size_t WS_TAB = 2 * MiB;
constexpr size_t WS_COS = WS_TAB, WS_SIN = WS_TAB + 4096, WS_WAB = WS_TAB + 65536  , WS_WR = WS_TAB + 131072  , WS_TILE = WS_TAB + 131072 + 393216  ;
constexpr size_t WS_LA = 3 * MiB, WS_BT = 5 * MiB;
constexpr size_t WS_WIN0 = 8 * MiB, WS_WOUT0 = 15 * MiB, WS_WIN1 = 17 * MiB, WS_WOUT1 = 20 * MiB;
constexpr size_t WS_HCTX = 22 * MiB;
constexpr size_t WS_AB = 38 * MiB;
constexpr size_t WS_ASG = 41 * MiB;
constexpr size_t WS_ROWSE = 540 * MiB;
constexpr size_t WS_GL = 43 * MiB;
constexpr size_t WS_GE = 44 * MiB;
constexpr size_t WS_WUP = 48 * MiB, WS_WDN = 112 * MiB;
constexpr size_t WS_A = 144 * MiB;
constexpr size_t WS_Z = 216 * MiB;
constexpr size_t WS_U = 144 * MiB, WS_W = 216 * MiB, WS_QD = 288 * MiB, WS_KD = 360 * MiB, WS_QK = 432 * MiB;
constexpr size_t WS_Y = 380 * MiB;
constexpr size_t WS_MIX = 468 * MiB;
constexpr size_t WS_XG = 216 * MiB, WS_HG = 376 * MiB, WS_YG = 216 * MiB;
constexpr size_t WS_Q1 = 216 * MiB, WS_K1 = 280 * MiB, WS_V1 = 298 * MiB, WS_O1 = 316 * MiB;
constexpr size_t WS_END = 545 * MiB;
constexpr int CW_TMO = 0, CW_BAR = 4096, CW_CNT = 8192;

constexpr int RING_OFF = 0, RING_BYTES = 131072;
constexpr int LDS_BYTES = 163840;
constexpr int LDSCTL_OFF = LDS_BYTES - 128, MISC_OFF = LDSCTL_OFF;

#define GAS __attribute__((address_space(1)))
#define LAS __attribute__((address_space(3)))
typedef unsigned short bf16;
typedef unsigned u32x4 __attribute__((ext_vector_type(4)));
typedef unsigned u32x2 __attribute__((ext_vector_type(2)));
typedef float f32x4 __attribute__((ext_vector_type(4)));
typedef GAS unsigned gu32;
#define RLX_AGENT __ATOMIC_RELAXED, __HIP_MEMORY_SCOPE_AGENT
__device__ __forceinline__ unsigned f2bf(float f) { unsigned u = __builtin_bit_cast(unsigned, f); return (u + 0x7fffu + ((u >> 16) & 1u)) >> 16; }
__device__ __forceinline__ unsigned pk2(float lo, float hi) { return pg8::cvt_pk_bf16(lo, hi); }
__device__ __forceinline__ float bflo(unsigned w) { return __uint_as_float(w << 16); }
__device__ __forceinline__ float bfhi(unsigned w) { return __uint_as_float(w & 0xffff0000u); }
__device__ __forceinline__ float bf2f(bf16 v) { return __uint_as_float((unsigned)v << 16); }
__device__ __forceinline__ void unpack8(const u32x4 v, float (&f)[8]) { f[0] = bflo(v.x); f[1] = bfhi(v.x); f[2] = bflo(v.y); f[3] = bfhi(v.y); f[4] = bflo(v.z); f[5] = bfhi(v.z); f[6] = bflo(v.w); f[7] = bfhi(v.w); }
__device__ __forceinline__ u32x4 pack8(const float (&f)[8]) { u32x4 w; w.x = pk2(f[0], f[1]); w.y = pk2(f[2], f[3]); w.z = pk2(f[4], f[5]); w.w = pk2(f[6], f[7]); return w; }
template <int CTRL> __device__ __forceinline__ float dppf(float x) { return __builtin_bit_cast(float, __builtin_amdgcn_mov_dpp(__builtin_bit_cast(int, x), CTRL, 0xf, 0xf, true)); }
constexpr int DPP_XOR1 = 0xB1, DPP_XOR2 = 0x4E, DPP_HMIR = 0x141, DPP_ROR8 = 0x128, DPP_REV4 = 0x1B;
__device__ __forceinline__ float row16_sum(float x) { x += dppf<DPP_XOR1>(x); x += dppf<DPP_XOR2>(x); x += dppf<DPP_HMIR>(x); x += dppf<DPP_ROR8>(x); return x; }
__device__ __forceinline__ float row16_max(float x) { x = fmaxf(x, dppf<DPP_XOR1>(x)); x = fmaxf(x, dppf<DPP_XOR2>(x)); x = fmaxf(x, dppf<DPP_HMIR>(x)); x = fmaxf(x, dppf<DPP_ROR8>(x)); return x; }
__device__ __forceinline__ float xor16_sum(float x) { auto s = __builtin_amdgcn_permlane16_swap(__float_as_uint(x), __float_as_uint(x), false, false); return __uint_as_float(s[0]) + __uint_as_float(s[1]); }
__device__ __forceinline__ float xor32_sum(float x) { auto s = __builtin_amdgcn_permlane32_swap(__float_as_uint(x), __float_as_uint(x), false, false); return __uint_as_float(s[0]) + __uint_as_float(s[1]); }
__device__ __forceinline__ float xor16_max(float x) { auto s = __builtin_amdgcn_permlane16_swap(__float_as_uint(x), __float_as_uint(x), false, false); return fmaxf(__uint_as_float(s[0]), __uint_as_float(s[1])); }
__device__ __forceinline__ float xor32_max(float x) { auto s = __builtin_amdgcn_permlane32_swap(__float_as_uint(x), __float_as_uint(x), false, false); return fmaxf(__uint_as_float(s[0]), __uint_as_float(s[1])); }
__device__ __forceinline__ float lane_xor16(float x, int lane) { auto s = __builtin_amdgcn_permlane16_swap(__float_as_uint(x), __float_as_uint(x), false, false); return __uint_as_float((lane & 16) ? s[0] : s[1]); }
__device__ __forceinline__ float lane_xor32(float x, int lane) { auto s = __builtin_amdgcn_permlane32_swap(__float_as_uint(x), __float_as_uint(x), false, false); return __uint_as_float((lane & 32) ? s[0] : s[1]); }
__device__ __forceinline__ float wave_sum(float v) { return xor32_sum(xor16_sum(row16_sum(v))); }
__device__ __forceinline__ float wave_max(float v) { return xor32_max(xor16_max(row16_max(v))); }
__device__ __forceinline__ float silu(float x) { return x * __builtin_amdgcn_rcpf(1.0f + __expf(-x)); }
__device__ __forceinline__ void row_info(int m, int& modrow, int& t, int& L) { if (m < RC) { modrow = 16; t = m & 255; L = LCTX; } else { const int mm = m - RC; modrow = mm >> 11; t = mm & 2047; L = SEQ; } }

#define XB_TMO      128
#define XB_XCNT(j)  (256  + 64 * (j))
#define XB_XSUB(j)  (1280 + 64 * (j))
#define XB_XGEN(j)  (2304 + 64 * (j))
#define XB_TOP      3328
#define XB_TOPGEN   3392
#define XCD_BAR_WORDS 3456
#define XB_SPIN_CAP (1u << 18)
__device__ __forceinline__ unsigned xb_ld(unsigned* p)              { return __hip_atomic_load(p, __ATOMIC_RELAXED, __HIP_MEMORY_SCOPE_AGENT); }
__device__ __forceinline__ unsigned xb_add(unsigned* p, unsigned v) { return __hip_atomic_fetch_add(p, v, __ATOMIC_RELAXED, __HIP_MEMORY_SCOPE_AGENT); }
__device__ __forceinline__ unsigned xb_xcc_id() { return (unsigned)__builtin_amdgcn_s_getreg((3 << 11) | 20) & 0xFu; }
#define XB_SPIN(cond, bar) do { unsigned _sp = 0; while (cond) { __builtin_amdgcn_s_sleep(1); \
    if ((++_sp & 255u) == 0u) { if (xb_ld(&(bar)[XB_TMO])) break; if (_sp > XB_SPIN_CAP) { atomicAdd(&(bar)[XB_TMO], 1u); break; } } } } while (0)
struct XcdBarrier { unsigned* bar; unsigned x; volatile LAS unsigned* st; };
__device__ __forceinline__ XcdBarrier xcd_barrier_post(unsigned* bar, volatile LAS unsigned* st) {
    XcdBarrier b; b.bar = bar; b.x = xb_xcc_id(); b.st = st;
    if (threadIdx.x == 0) (void)xb_add(&bar[XB_XCNT(b.x)], 1u);
    return b;
}
__device__ __forceinline__ void xcd_barrier_complete(unsigned* bar, unsigned x, unsigned& nloc, unsigned& nx) {
    const unsigned G = gridDim.x * gridDim.y * gridDim.z;
    unsigned sum, cnt, mine, sp = 0u;
    for (;;) {
        sum = 0u; cnt = 0u; mine = 0u;
#pragma unroll
        for (unsigned j = 0; j < 16; ++j) { const unsigned c = xb_ld(&bar[XB_XCNT(j)]); sum += c; cnt += (c > 0u) ? 1u : 0u; mine = (j == x) ? c : mine; }
        if (sum == G) break;
        __builtin_amdgcn_s_sleep(1);
        if ((++sp & 255u) == 0u) { if (xb_ld(&bar[XB_TMO])) break; if (sp > XB_SPIN_CAP) { atomicAdd(&bar[XB_TMO], 1u); break; } }
    }
    nloc = mine > 0u ? mine : 1u; nx = cnt > 0u ? cnt : 1u;
}
__device__ __forceinline__ void xcd_barrier(const XcdBarrier& b) {
    asm volatile("s_waitcnt vmcnt(0)" ::: "memory");
    __syncthreads();
    if (threadIdx.x == 0) {
        unsigned* bar = b.bar;
        __builtin_amdgcn_s_waitcnt(0);
        unsigned nloc = b.st[0], nx = b.st[1];
        if (nloc == 0u) { xcd_barrier_complete(bar, b.x, nloc, nx); b.st[0] = nloc; b.st[1] = nx; }
        const unsigned old = xb_add(&bar[XB_XSUB(b.x)], 1u);
        const unsigned gen = old / nloc;
        if (old + 1u == (gen + 1u) * nloc) {
            __builtin_amdgcn_fence(__ATOMIC_RELEASE, "agent");
            asm volatile("s_waitcnt vmcnt(0)" ::: "memory");
            const unsigned og = xb_add(&bar[XB_TOP], 1u);
            const unsigned tg = og / nx;
            if (og + 1u == (tg + 1u) * nx) xb_add(&bar[XB_TOPGEN], 1u);
            else XB_SPIN(xb_ld(&bar[XB_TOPGEN]) == tg, bar);
            __builtin_amdgcn_fence(__ATOMIC_ACQUIRE, "agent");
            xb_add(&bar[XB_XGEN(b.x)], 1u);
            asm volatile("s_waitcnt vmcnt(0)" ::: "memory");
        } else {
            XB_SPIN(xb_ld(&bar[XB_XGEN(b.x)]) == gen, bar);
            __builtin_amdgcn_fence(__ATOMIC_ACQUIRE, "agent");
            asm volatile("s_waitcnt vmcnt(0)" ::: "memory");
        }
    }
    __syncthreads();
}

struct Args {
    const float *x, *c, *ctx, *c_ctx, *ada_w, *ada_b, *norm_mix, *norm_ffn, *norm_final;
    const float *ab_w_in, *ab_conv_qkv, *ab_conv_sc, *ab_a_log, *ab_dt_bias, *ab_out_norm, *ab_w_out;
    const float *at_w_in, *at_sink, *at_w_out;
    const float *moe_w_group, *moe_w_expert, *moe_w1, *moe_w3, *moe_w2;
    float* out; unsigned char* ws;
    int ph_lo, ph_hi;
};
struct Ctx {
    LAS unsigned char* lds; int tid, lane, wave, G, bid, gw, ngw;
    int vcu;
};

__device__ __forceinline__ void transpose_item(const float* W, int ldw, int k0, int srccol, bf16* WT, int K, int dstrow0, bool il, LAS float* scr, int lane) {
    { float tv[32];
      const float* wp_ = W + (size_t)(k0 + (lane >> 5)) * ldw + srccol + (lane & 31);
#pragma unroll
      for (int i = 0; i < 32; ++i) tv[i] = wp_[(size_t)(2 * i) * ldw];
#pragma unroll
      for (int i = 0; i < 32; ++i) scr[(2 * i + (lane >> 5)) * 33 + (lane & 31)] = tv[i]; }
    asm volatile("s_waitcnt lgkmcnt(0)" ::: "memory");
    const int c = lane & 7;
#pragma unroll
    for (int j = 0; j < 4; ++j) { const int n = (lane >> 3) + 8 * j; const LAS float* s = scr + (8 * c) * 33 + n;
        u32x4 o; o.x = pk2(s[0 * 33], s[1 * 33]); o.y = pk2(s[2 * 33], s[3 * 33]); o.z = pk2(s[4 * 33], s[5 * 33]); o.w = pk2(s[6 * 33], s[7 * 33]);
        const int drow = dstrow0 + (il ? (8 * (n >> 2) + (n & 3)) : n);
        *(u32x4*)(WT + (size_t)drow * K + k0 + 8 * c) = o; }
    asm volatile("s_waitcnt lgkmcnt(0)" ::: "memory");
}
__device__ __forceinline__ void moe_convert(const Args& a, const Ctx& C, int l, int blk0) {
    LAS float* scr = (LAS float*)(C.lds + C.wave * 8448);
    bf16* WUP = (bf16*)(a.ws + WS_WUP); bf16* WDN = (bf16*)(a.ws + WS_WDN);
    if (C.bid < blk0) return;
    for (int it = (C.bid - blk0) * NWAVES + C.wave; it < 32 * 768; it += (C.G - blk0) * NWAVES) {
        const int e = it / 768, r = it % 768;
        if (r < 512) { const int rr = r & 255, kb = rr >> 4, nb = rr & 15; const float* src = (r < 256 ? a.moe_w1 : a.moe_w3) + (size_t)(l * 32 + e) * 1024 * 512;
            transpose_item(src, 512, 64 * kb, 32 * nb, WUP + (size_t)e * 1024 * 1024, 1024, 64 * nb + (r < 256 ? 0 : 4), true, scr, C.lane); }
        else { const int rr = r - 512, kb = rr >> 5, nb = rr & 31;
            transpose_item(a.moe_w2 + (size_t)(l * 32 + e) * 512 * 1024, 1024, 64 * kb, 32 * nb, WDN + (size_t)e * 1024 * 512, 512, 32 * nb, false, scr, C.lane); }
    }
}
__device__ __forceinline__ void norm_mod(const float* hrow, const float* nw, const float* shift, const float* scale, int lane, f32x4 (&v)[4]) {
    const f32x4* xr = (const f32x4*)hrow + lane; float s = 0.f;
#pragma unroll
    for (int j = 0; j < 4; ++j) { v[j] = xr[64 * j]; s += (v[j].x * v[j].x + v[j].y * v[j].y) + (v[j].z * v[j].z + v[j].w * v[j].w); }
    const float rstd = 1.0f / sqrtf(wave_sum(s) * (1.0f / D) + EPS);
#pragma unroll
    for (int j = 0; j < 4; ++j) { const f32x4 w = ((const f32x4*)nw)[lane + 64 * j], sc = ((const f32x4*)scale)[lane + 64 * j], sh = ((const f32x4*)shift)[lane + 64 * j];
        v[j] = v[j] * rstd * w * (sc + 1.0f) + sh; }
}
__device__ __forceinline__ void store_row_bf16(bf16* orow, int lane, const f32x4 (&v)[4]) {
    u32x2* o = (u32x2*)orow + lane;
#pragma unroll
    for (int j = 0; j < 4; ++j) { u32x2 w; w.x = pk2(v[j].x, v[j].y); w.y = pk2(v[j].z, v[j].w); o[64 * j] = w; }
}

__device__ __forceinline__ void phase_prologue(const Args& a, const Ctx& C) {
    LAS float* scr = (LAS float*)(C.lds + C.wave * 8448);
    bf16* WIN0 = (bf16*)(a.ws + WS_WIN0); bf16* WOUT0 = (bf16*)(a.ws + WS_WOUT0); bf16* WIN1 = (bf16*)(a.ws + WS_WIN1); bf16* WOUT1 = (bf16*)(a.ws + WS_WOUT1);
    for (int it0 = C.gw; it0 < 3584; it0 += C.ngw) {
        int it = it0;
        if (it < 1792) { const int kb = it / 112, nb = it % 112, n0 = 32 * nb; transpose_item(a.ab_w_in, 3600, 64 * kb, n0 < 2048 ? n0 : n0 + 16, WIN0, 1024, n0, false, scr, C.lane); continue; } it -= 1792;
        if (it < 512) { const int kb = it >> 5, nb = it & 31; transpose_item(a.ab_w_out, 1024, 64 * kb, 32 * nb, WOUT0, 1024, 32 * nb, false, scr, C.lane); continue; } it -= 512;
        if (it < 768) { const int kb = it / 48, nb = it % 48; transpose_item(a.at_w_in, 1536, 64 * kb, 32 * nb, WIN1, 1024, 32 * nb, false, scr, C.lane); continue; } it -= 768;
        { const int kb = it >> 5, nb = it & 31; transpose_item(a.at_w_out, 1024, 64 * kb, 32 * nb, WOUT1, 1024, 32 * nb, false, scr, C.lane); }
    }
    const int gt = (C.G - 1 - C.bid) * NTHR + C.tid, ngt = C.G * NTHR;
    float* ctab = (float*)(a.ws + WS_COS); float* stab = (float*)(a.ws + WS_SIN); float* wab = (float*)(a.ws + WS_WAB); float* wr = (float*)(a.ws + WS_WR);
    for (int i = gt; i < 1024; i += ngt) { const int pos = i >> 4, f = i & 15; const float inv = powf(10000.0f, -(float)f / 16.0f); const float ang = (float)pos * inv; ctab[i] = cosf(ang); stab[i] = sinf(ang); }
    for (int i = gt; i < 16384; i += ngt) { const int j = i >> 10, k = i & 1023; wab[i] = a.ab_w_in[(size_t)k * 3600 + 2048 + j]; }
    for (int i = gt; i < 2 * 49152; i += ngt) { const int l = i / 49152, r = i % 49152, k = r / 48, cc = r % 48;
        wr[i] = cc < 4 ? a.moe_w_group[(size_t)(l * 1024 + k) * 4 + cc] : (cc < 36 ? a.moe_w_expert[(size_t)(l * 1024 + k) * 32 + cc - 4] : 0.f); }
    __syncthreads();
    typedef float f32x16p __attribute__((ext_vector_type(16)));
    LAS float* sc = (LAS float*)C.lds;
    LAS float* red = (LAS float*)(C.lds + 70144);
    float* MOD = (float*)(a.ws + WS_MOD);
    if (C.bid < 192) {
        { f32x4 cv[9];
#pragma unroll
          for (int u = 0; u < 9; ++u) { const int i4 = C.tid + NTHR * u; cv[u] = i4 < 4096 ? ((const f32x4*)a.c)[i4] : (i4 < 4352 ? ((const f32x4*)a.c_ctx)[i4 - 4096] : (f32x4){0.f, 0.f, 0.f, 0.f}); }
#pragma unroll
          for (int u = 0; u < 9; ++u) { const int i4 = C.tid + NTHR * u; if (i4 < 4352) *(LAS f32x4*)(sc + (i4 >> 8) * 1028 + 4 * (i4 & 255)) = (f32x4){silu(cv[u].x), silu(cv[u].y), silu(cv[u].z), silu(cv[u].w)}; } }
        __syncthreads();
        for (int item = C.bid; item < 192; item += C.G) {
            const int l = item / 96, cg = item % 96, ks = C.wave, n = C.lane & 31, kh = C.lane >> 5, mrow = n < 17 ? n : 16;
            const float* wp = a.ada_w + (size_t)l * 1024 * 6144 + (size_t)(128 * ks + 64 * kh) * 6144 + cg * 64 + n;
            const LAS float* ap = sc + mrow * 1028 + 128 * ks + 64 * kh;
            f32x16p acc0, acc1;
#pragma unroll
            for (int i = 0; i < 16; ++i) { acc0[i] = 0.f; acc1[i] = 0.f; }
            float b0[2][16], b1[2][16];
#pragma unroll
            for (int u = 0; u < 16; ++u) { b0[0][u] = wp[(size_t)u * 6144]; b1[0][u] = wp[(size_t)u * 6144 + 32]; }
#pragma unroll
            for (int c4 = 0; c4 < 4; ++c4) { const int hs = 16 * c4, hn = c4 < 3 ? hs + 16 : hs;
                f32x4 av[4];
#pragma unroll
                for (int u = 0; u < 16; ++u) { b0[(c4 + 1) & 1][u] = wp[(size_t)(hn + u) * 6144]; b1[(c4 + 1) & 1][u] = wp[(size_t)(hn + u) * 6144 + 32]; }
#pragma unroll
                for (int j = 0; j < 4; ++j) av[j] = *(const LAS f32x4*)(ap + hs + 4 * j);
#pragma unroll
                for (int u = 0; u < 16; ++u) { acc0 = __builtin_amdgcn_mfma_f32_32x32x2f32(av[u >> 2][u & 3], b0[c4 & 1][u], acc0, 0, 0, 0); acc1 = __builtin_amdgcn_mfma_f32_32x32x2f32(av[u >> 2][u & 3], b1[c4 & 1][u], acc1, 0, 0, 0); }
            }
#pragma unroll
            for (int i = 0; i < 16; ++i) { const int row = 8 * (i >> 2) + 4 * kh + (i & 3); if (row < 17) { red[(ks * 17 + row) * 64 + n] = acc0[i]; red[(ks * 17 + row) * 64 + 32 + n] = acc1[i]; } }
            __syncthreads();
            for (int i = C.tid; i < 17 * 64; i += NTHR) { const int r = i >> 6, cc = i & 63; float s = 0.f;
#pragma unroll
                for (int q = 0; q < 8; ++q) s += red[(q * 17 + r) * 64 + cc];
                MOD[(size_t)(l * 17 + r) * 6144 + cg * 64 + cc] = s + a.ada_b[l * 6144 + cg * 64 + cc]; }
            __syncthreads();
        }
    }
}
__device__ __forceinline__ float reduce16(float (&p)[16], int lane) {
    float q8[8], q4[4], q2[2];
#pragma unroll
    for (int i = 0; i < 8; ++i) { const bool up = lane & 32; const float keep = up ? p[i + 8] : p[i], send = up ? p[i] : p[i + 8]; q8[i] = keep + lane_xor32(send, lane); }
#pragma unroll
    for (int i = 0; i < 4; ++i) { const bool up = lane & 16; const float keep = up ? q8[i + 4] : q8[i], send = up ? q8[i] : q8[i + 4]; q4[i] = keep + lane_xor16(send, lane); }
#pragma unroll
    for (int i = 0; i < 2; ++i) { const bool up = lane & 8; const float keep = up ? q4[i + 2] : q4[i], send = up ? q4[i] : q4[i + 2]; q2[i] = keep + dppf<DPP_ROR8>(send); }
    float r; { const bool up = lane & 4; const float keep = up ? q2[1] : q2[0], send = up ? q2[0] : q2[1]; r = keep + dppf<DPP_REV4>(dppf<DPP_HMIR>(send)); }
    r += dppf<DPP_XOR2>(r); r += dppf<DPP_XOR1>(r);
    return r;
}
__device__ __forceinline__ void phase_norm0(const Args& a, const Ctx& C) {
    LAS float* wab = (LAS float*)C.lds;
    const float* gw_ = (const float*)(a.ws + WS_WAB);
    { f32x4 wv[8];
#pragma unroll
      for (int u = 0; u < 8; ++u) wv[u] = ((const f32x4*)gw_)[C.tid + NTHR * u];
#pragma unroll
      for (int u = 0; u < 8; ++u) *(LAS f32x4*)(wab + 4 * (C.tid + NTHR * u)) = wv[u]; }
    __syncthreads();
    const float* MOD = (const float*)(a.ws + WS_MOD); bf16* A = (bf16*)(a.ws + WS_A); float* AB = (float*)(a.ws + WS_AB);
    const int per = (RT + C.ngw - 1) / C.ngw, mbeg = C.gw * per, mend = mbeg + per < RT ? mbeg + per : RT;
    if (mbeg >= mend) return;
    f32x4 nwv[4], scv[4], shv[4], raw[2][4]; int curmod = -1;
#pragma unroll
    for (int j = 0; j < 4; ++j) nwv[j] = ((const f32x4*)a.norm_mix)[C.lane + 64 * j];
#define N0_LOAD(k_, m_) do { const int mc_ = (m_) < mend ? (m_) : mend - 1; const float* src_ = mc_ < RC ? a.ctx + (size_t)mc_ * D : a.x + (size_t)(mc_ - RC) * D; \
        _Pragma("unroll") for (int j_ = 0; j_ < 4; ++j_) raw[k_][j_] = ((const f32x4*)src_)[C.lane + 64 * j_]; } while (0)
    N0_LOAD(0, mbeg); N0_LOAD(1, mbeg + 1);
    for (int mp = mbeg; mp < mend; mp += 2) {
        asm volatile("" ::: "memory");
        f32x4 v[2][4];
#pragma unroll
        for (int k = 0; k < 2; ++k) { const int m = mp + k < mend ? mp + k : mend - 1; int modrow, t, L; row_info(m, modrow, t, L);
            if (modrow != curmod) { curmod = modrow; const float* md = MOD + (size_t)modrow * 6144;
#pragma unroll
                for (int j = 0; j < 4; ++j) { shv[j] = ((const f32x4*)md)[C.lane + 64 * j]; scv[j] = ((const f32x4*)(md + 1024))[C.lane + 64 * j]; } }
            float ss = 0.f;
#pragma unroll
            for (int j = 0; j < 4; ++j) { v[k][j] = raw[k][j]; ss += (v[k][j].x * v[k][j].x + v[k][j].y * v[k][j].y) + (v[k][j].z * v[k][j].z + v[k][j].w * v[k][j].w); }
            N0_LOAD(k, mp + 2 + k);
            const float rstd = 1.0f / sqrtf(wave_sum(ss) * (1.0f / D) + EPS);
#pragma unroll
            for (int j = 0; j < 4; ++j) v[k][j] = v[k][j] * rstd * nwv[j] * (scv[j] + 1.0f) + shv[j];
            if (mp + k < mend) store_row_bf16(A + (size_t)m * D, C.lane, v[k]); }
        float p0[16], p1[16];
#pragma unroll
        for (int q = 0; q < 16; ++q) { float s0 = 0.f, s1 = 0.f;
#pragma unroll
            for (int j = 0; j < 4; ++j) { const f32x4 w = *(const LAS f32x4*)(wab + q * 1024 + 4 * C.lane + 256 * j);
                s0 += (v[0][j].x * w.x + v[0][j].y * w.y) + (v[0][j].z * w.z + v[0][j].w * w.w); s1 += (v[1][j].x * w.x + v[1][j].y * w.y) + (v[1][j].z * w.z + v[1][j].w * w.w); }
            p0[q] = s0; p1[q] = s1; }
        const float r0 = reduce16(p0, C.lane), r1 = reduce16(p1, C.lane);
        if ((C.lane & 3) == 0) { const int idx = ((C.lane >> 5) & 1) * 8 + ((C.lane >> 4) & 1) * 4 + ((C.lane >> 3) & 1) * 2 + ((C.lane >> 2) & 1);
            AB[(size_t)mp * 16 + idx] = r0; if (mp + 1 < mend) AB[(size_t)(mp + 1) * 16 + idx] = r1; }
    }
#undef N0_LOAD
}
__device__ __forceinline__ void phase_conv(const Args& a, const Ctx& C) {
    const bf16* Z = (const bf16*)(a.ws + WS_Z); bf16* QKV = (bf16*)a.out; bf16* MIX = (bf16*)(a.ws + WS_MIX);
    const float* AB = (const float*)(a.ws + WS_AB); float* LA = (float*)(a.ws + WS_LA); float* BT = (float*)(a.ws + WS_BT);
    const u32x4 zero4 = (u32x4){0u, 0u, 0u, 0u};
    const int lane = C.lane;
    for (int task = C.gw; task < (RT / 32) * 5; task += C.ngw) {
        const int strip = task / 5, sl = task % 5, m0 = strip * 32;
        int modrow, t0, L; row_info(m0, modrow, t0, L);
        if (sl == 3) {
            float abv[8];
#pragma unroll
            for (int u = 0; u < 8; ++u) abv[u] = AB[(size_t)m0 * 16 + lane + 64 * u];
            const float dtb = a.ab_dt_bias[lane & 7], alg = a.ab_a_log[lane & 7];
            for (int rb = 0; rb < 32; rb += 8) { u32x4 gg[8];
#pragma unroll
                for (int u = 0; u < 8; ++u) gg[u] = *(const u32x4*)(Z + (size_t)(m0 + rb + u) * NZ + 1536 + lane * 8);
#pragma unroll
                for (int u = 0; u < 8; ++u) { float g[8], y[8]; unpack8(gg[u], g);
#pragma unroll
                    for (int e = 0; e < 8; ++e) y[e] = silu(g[e]);
                    *(u32x4*)(MIX + (size_t)(m0 + rb + u) * D + lane * 8) = pack8(y); } }
#pragma unroll
            for (int u = 0; u < 8; ++u) { const int i = lane + 64 * u, m = m0 + (i >> 4), c = i & 15; const float xx = abv[u];
                if (c < 8) { const float x2 = xx + dtb; const float sp = x2 > 20.f ? x2 : log1pf(expf(x2)); LA[(size_t)m * 8 + c] = -expf(alg) * sp; }
                else BT[(size_t)m * 8 + c - 8] = 1.0f / (1.0f + expf(-xx)); }
            continue;
        }
        if (sl < 3) {
            const int col = sl * 512 + lane * 8; float w0[8], w1[8], w2[8];
#pragma unroll
            for (int e = 0; e < 8; ++e) { w0[e] = a.ab_conv_qkv[col + e]; w1[e] = a.ab_conv_qkv[1536 + col + e]; w2[e] = a.ab_conv_qkv[3072 + col + e]; }
            const bf16* zp = Z + (size_t)m0 * NZ + col;
            u32x4 prev = t0 > 0 ? *(const u32x4*)(zp - NZ) : zero4, cur = *(const u32x4*)zp;
            u32x4 nb[2][8];
#define CV_LOAD(set, rb_) do { _Pragma("unroll") for (int u_ = 0; u_ < 8; ++u_) { const bool in_ = t0 + (rb_) + u_ + 1 < L; nb[set][u_] = *(const u32x4*)(zp + (size_t)(in_ ? (rb_) + u_ + 1 : (rb_) + u_) * NZ); } } while (0)
#define CV_ROWS(set, rb_) do { _Pragma("unroll") for (int u_ = 0; u_ < 8; ++u_) { const bool in_ = t0 + (rb_) + u_ + 1 < L; const u32x4 nxt_ = in_ ? nb[set][u_] : zero4; \
                float fa[8], fc[8], fb[8], y[8]; unpack8(prev, fa); unpack8(cur, fc); unpack8(nxt_, fb); \
                float ss = 0.f; \
                _Pragma("unroll") for (int e = 0; e < 8; ++e) { const float s_ = fa[e] * w0[e] + fc[e] * w1[e] + fb[e] * w2[e]; y[e] = silu(s_); ss += y[e] * y[e]; } \
                if (sl < 2) { ss = row16_sum(ss); \
                    const float sc_ = __builtin_amdgcn_rsqf(ss + EPS) * (sl == 0 ? 0.08838834764831845f : 1.0f); \
                    _Pragma("unroll") for (int e = 0; e < 8; ++e) y[e] *= sc_; } \
                *(u32x4*)(QKV + (size_t)(m0 + (rb_) + u_) * 1536 + col) = pack8(y); \
                prev = cur; cur = nxt_; } } while (0)
            CV_LOAD(0, 0);
            CV_LOAD(1, 8);  CV_ROWS(0, 0);
            CV_LOAD(0, 16); CV_ROWS(1, 8);
            CV_LOAD(1, 24); CV_ROWS(0, 16);
            CV_ROWS(1, 24);
#undef CV_LOAD
#undef CV_ROWS
        } else {
            const int col = lane * 8; float w0[8], w1[8], w2[8];
#pragma unroll
            for (int e = 0; e < 8; ++e) { w0[e] = a.ab_conv_sc[col + e]; w1[e] = a.ab_conv_sc[512 + col + e]; w2[e] = a.ab_conv_sc[1024 + col + e]; }
            const bf16* zp = Z + (size_t)m0 * NZ + col;
            float pp[8], pc[8];
            { float c_[8], h_[8];
              if (t0 > 0) { unpack8(*(const u32x4*)(zp - NZ + 2560), c_); unpack8(*(const u32x4*)(zp - NZ + 3072), h_);
#pragma unroll
                  for (int e = 0; e < 8; ++e) pp[e] = c_[e] * h_[e]; }
              else {
#pragma unroll
                  for (int e = 0; e < 8; ++e) pp[e] = 0.f; }
              unpack8(*(const u32x4*)(zp + 2560), c_); unpack8(*(const u32x4*)(zp + 3072), h_);
#pragma unroll
              for (int e = 0; e < 8; ++e) pc[e] = c_[e] * h_[e]; }
            for (int rb = 0; rb < 32; rb += 4) { u32x4 lc[4], lh[4], lgt[4];
#pragma unroll
                for (int u = 0; u < 4; ++u) { const bool in = t0 + rb + u + 1 < L; const size_t ro = (size_t)(in ? rb + u + 1 : rb + u) * NZ;
                    lc[u] = *(const u32x4*)(zp + ro + 2560); lh[u] = *(const u32x4*)(zp + ro + 3072); lgt[u] = *(const u32x4*)(zp + (size_t)(rb + u) * NZ + 2048); }
#pragma unroll
                for (int u = 0; u < 4; ++u) { float c_[8], h_[8], bg[8], y[8], pn[8]; const bool in = t0 + rb + u + 1 < L;
                    unpack8(lc[u], c_); unpack8(lh[u], h_); unpack8(lgt[u], bg);
#pragma unroll
                    for (int e = 0; e < 8; ++e) { pn[e] = in ? c_[e] * h_[e] : 0.f; y[e] = bg[e] * (pp[e] * w0[e] + pc[e] * w1[e] + pn[e] * w2[e]); pp[e] = pc[e]; pc[e] = pn[e]; }
                    *(u32x4*)(MIX + (size_t)(m0 + rb + u) * D + 512 + col) = pack8(y); } }
        }
    }
}
__device__ __forceinline__ void phase_dn_combine(const Args& a, const Ctx& C) {
    const bf16* OF = (const bf16*)(a.ws + WS_QD); const bf16* OB = OF + (size_t)RT * 512; bf16* MIX = (bf16*)(a.ws + WS_MIX);
    float on[8];
#pragma unroll
    for (int e = 0; e < 8; ++e) on[e] = a.ab_out_norm[(C.lane & 15) * 8 + e];
    for (int mb = C.gw; mb < RT; mb += 2 * C.ngw) {
      u32x4 lf[2], lb[2], lg[2];
#pragma unroll
      for (int k = 0; k < 2; ++k) { const int m = (mb + k * C.ngw < RT) ? mb + k * C.ngw : mb; lf[k] = *(const u32x4*)(OF + (size_t)m * 512 + C.lane * 8); lb[k] = *(const u32x4*)(OB + (size_t)m * 512 + C.lane * 8); lg[k] = *(const u32x4*)(MIX + (size_t)m * D + C.lane * 8); }
#pragma unroll
      for (int k = 0; k < 2; ++k) { const int m = mb + k * C.ngw; if (m >= RT) continue;
        float f[8], b[8], g[8], y[8]; unpack8(lf[k], f); unpack8(lb[k], b); unpack8(lg[k], g);
        float ss = 0.f;
#pragma unroll
        for (int e = 0; e < 8; ++e) { f[e] += b[e]; ss += f[e] * f[e]; }
        ss = row16_sum(ss);
        const float rstd = 1.0f / sqrtf(ss * (1.0f / 128.0f) + EPS);
#pragma unroll
        for (int e = 0; e < 8; ++e) y[e] = f[e] * rstd * on[e] * g[e];
        *(u32x4*)(MIX + (size_t)m * D + C.lane * 8) = pack8(y);
      }
    }
}
typedef float f32x4v __attribute__((ext_vector_type(4)));
__device__ __forceinline__ void phase_ffn_norm_route(const Args& a, const Ctx& C, int l) {
    LAS float* fsb = (LAS float*)C.lds;
    LAS float* redb = (LAS float*)(C.lds + 131584);
    LAS float* lgw = (LAS float*)(C.lds + 156160);
    LAS int* le = (LAS int*)(C.lds + 159232);
    LAS int* lr = le + 320;
    LAS int* hist = lr + 320;
    LAS int* base = hist + 32;
    const float* MOD = (const float*)(a.ws + WS_MOD) + (size_t)l * 17 * 6144;
    const float* wr = (const float*)(a.ws + WS_WR) + (size_t)l * 49152;
    const float* nw = a.norm_ffn + l * D;
    float* hctx = (float*)(a.ws + WS_HCTX); bf16* F = (bf16*)(a.ws + WS_A); int* ASG = (int*)(a.ws + WS_ASG);
    unsigned* cnt = (unsigned*)(a.ws + WS_CTL) + CW_CNT + 64 * l;
    if (C.tid < 32) hist[C.tid] = 0;
    const int g0 = l == 0 ? 0 : RC / 16, ngroups = RT / 16;
    const int gper = (ngroups - g0 + C.G - 1) / C.G, gfirst = g0 + C.bid * gper;
    const int n = gfirst < ngroups ? (ngroups - gfirst < gper ? ngroups - gfirst : gper) : 0;
    __syncthreads();
    if (C.wave >= 4) {
        const int rw = C.wave - 4;
        f32x4 pr[4][4]; u32x2 py[4][4];
        f32x4 mg[4], msc[4], msh[4], nwv[4];
#pragma unroll
        for (int j = 0; j < 4; ++j) nwv[j] = ((const f32x4*)nw)[C.lane + 64 * j];
        int curmod = -1;
#define P8_LOAD(g_) do { { int mr_, t_, L_; row_info((g_) * 16, mr_, t_, L_); if (mr_ != curmod) { curmod = mr_; const float* md_ = MOD + (size_t)mr_ * 6144; \
        _Pragma("unroll") for (int j_ = 0; j_ < 4; ++j_) { mg[j_] = ((const f32x4*)(md_ + 2048))[C.lane + 64 * j_]; msc[j_] = ((const f32x4*)(md_ + 4096))[C.lane + 64 * j_]; msh[j_] = ((const f32x4*)(md_ + 3072))[C.lane + 64 * j_]; } } } \
        _Pragma("unroll") for (int q_ = 0; q_ < 4; ++q_) { const int m_ = (g_) * 16 + 4 * rw + q_; \
        const float* rsd_ = l == 0 ? (m_ < RC ? a.ctx + (size_t)m_ * D : a.x + (size_t)(m_ - RC) * D) : a.out + (size_t)(m_ - RC) * D; \
        const bf16* yrow_ = (const bf16*)(a.ws + WS_Y) + (size_t)(l == 0 ? m_ : m_ - RC) * D; \
        _Pragma("unroll") for (int j_ = 0; j_ < 4; ++j_) { pr[q_][j_] = ((const f32x4*)rsd_)[C.lane + 64 * j_]; py[q_][j_] = ((const u32x2*)yrow_)[C.lane + 64 * j_]; } } } while (0)
        if (n > 0) P8_LOAD(gfirst);
        for (int i = 0; i < n + 2; ++i) {
            if (i < n) { const int g = gfirst + i; LAS float* fs = fsb + (i & 1) * (16 * 1028);
#pragma unroll
                for (int q = 0; q < 4; ++q) { const int r = 4 * rw + q, m = g * 16 + r; int modrow, t, L; row_info(m, modrow, t, L);
                    float* hdst = m < RC ? (float*)hctx + (size_t)m * D : a.out + (size_t)(m - RC) * D;
                    f32x4 v[4]; float ss = 0.f;
#pragma unroll
                    for (int j = 0; j < 4; ++j) { const f32x4 r4 = pr[q][j], g4 = mg[j]; const u32x2 yy = py[q][j];
                        v[j] = r4 + g4 * (f32x4){bflo(yy.x), bfhi(yy.x), bflo(yy.y), bfhi(yy.y)}; ((f32x4*)hdst)[C.lane + 64 * j] = v[j];
                        ss += (v[j].x * v[j].x + v[j].y * v[j].y) + (v[j].z * v[j].z + v[j].w * v[j].w); }
                    { const float rstd = 1.0f / sqrtf(wave_sum(ss) * (1.0f / D) + EPS);
#pragma unroll
                      for (int j = 0; j < 4; ++j) v[j] = v[j] * rstd * nwv[j] * (msc[j] + 1.0f) + msh[j]; }
                    store_row_bf16(F + (size_t)m * D, C.lane, v);
#pragma unroll
                    for (int j = 0; j < 4; ++j) *(LAS f32x4*)(fs + r * 1028 + 4 * C.lane + 256 * j) = v[j]; }
                if (i + 1 < n) P8_LOAD(g + 1);
            }
            __syncthreads();
        }
#undef P8_LOAD
    } else {
        int ln_ = C.lane; asm volatile("" : "+v"(ln_));
        const int kk = ln_ >> 4, rr = ln_ & 15, w = C.wave;
        float Bf[3][64];
#pragma unroll
        for (int ct = 0; ct < 3; ++ct)
#pragma unroll
            for (int s = 0; s < 64; ++s) Bf[ct][s] = wr[(size_t)(256 * w + 64 * kk + s) * 48 + 16 * ct + rr];
        for (int i = 0; i < n + 2; ++i) {
            if (i >= 2) {
                const int gi = i - 2, g = gfirst + gi; const LAS float* red = redb + (gi & 1) * (4 * 16 * 48);
                { const int r4 = ln_ >> 4, c = ln_ & 15;
#pragma unroll
                  for (int ct = 0; ct < 3; ++ct) { const int col = 16 * ct + c; float sum = 0.f;
#pragma unroll
                      for (int w2 = 0; w2 < 4; ++w2) sum += red[(w2 * 16 + 4 * w + r4) * 48 + col];
                      lgw[(w * 4 + r4) * 48 + col] = sum; } }
                asm volatile("s_waitcnt lgkmcnt(0)" ::: "memory");
                if (ln_ < 4) { const int r = 4 * w + ln_, m = g * 16 + r; const LAS float* lp = lgw + (w * 4 + ln_) * 48;
                    int gs = 0; float gm = lp[0];
#pragma unroll
                    for (int i2 = 1; i2 < 4; ++i2) if (lp[i2] > gm) { gm = lp[i2]; gs = i2; }
                    float gsum = 0.f;
#pragma unroll
                    for (int i2 = 0; i2 < 4; ++i2) gsum += expf(lp[i2] - gm);
                    const float pg = 1.0f / gsum;
                    const LAS float* ep = lp + 4 + gs * 8; float em = ep[0];
#pragma unroll
                    for (int i2 = 1; i2 < 8; ++i2) em = fmaxf(em, ep[i2]);
                    float pe[8], esum = 0.f;
#pragma unroll
                    for (int i2 = 0; i2 < 8; ++i2) { pe[i2] = expf(ep[i2] - em); esum += pe[i2]; }
                    int t0 = 0; float p0 = pe[0] / esum;
                    float pn[8];
#pragma unroll
                    for (int i2 = 0; i2 < 8; ++i2) pn[i2] = pe[i2] / esum;
#pragma unroll
                    for (int i2 = 1; i2 < 8; ++i2) if (pn[i2] > p0) { p0 = pn[i2]; t0 = i2; }
                    int t1 = -1; float p1 = -1.f;
#pragma unroll
                    for (int i2 = 0; i2 < 8; ++i2) if (i2 != t0 && pn[i2] > p1) { p1 = pn[i2]; t1 = i2; }
                    if (t1 < 0) t1 = (t0 == 0) ? 1 : 0;
                    const float w0 = pg * p0 / (p0 + p1), w1 = pg * p1 / (p0 + p1);
                    const int e0 = gs * 8 + t0, e1 = gs * 8 + t1;
                    const int r0 = atomicAdd((int*)&hist[e0], 1), r1 = atomicAdd((int*)&hist[e1], 1);
                    le[(gi * 16 + r) * 2] = e0; le[(gi * 16 + r) * 2 + 1] = e1; lr[(gi * 16 + r) * 2] = r0; lr[(gi * 16 + r) * 2 + 1] = r1;
                    int* ag = ASG + (size_t)m * 8; ag[0] = e0; ag[1] = e1; ag[4] = __float_as_int(w0); ag[5] = __float_as_int(w1);
                }
            }
            if (i >= 1 && i <= n) {
                const int gi = i - 1; const LAS float* fs = fsb + (gi & 1) * (16 * 1028); LAS float* red = redb + (gi & 1) * (4 * 16 * 48);
                f32x4v acc[3];
#pragma unroll
                for (int ct = 0; ct < 3; ++ct) acc[ct] = (f32x4v){0.f, 0.f, 0.f, 0.f};
                const LAS float* ab = fs + rr * 1028 + 256 * w + 64 * kk;
#pragma unroll
                for (int s4 = 0; s4 < 16; ++s4) { const f32x4 a4 = *(const LAS f32x4*)(ab + 4 * s4);
#pragma unroll
                    for (int e = 0; e < 4; ++e)
#pragma unroll
                        for (int ct = 0; ct < 3; ++ct) acc[ct] = __builtin_amdgcn_mfma_f32_16x16x4f32(a4[e], Bf[ct][4 * s4 + e], acc[ct], 0, 0, 0); }
#pragma unroll
                for (int ct = 0; ct < 3; ++ct)
#pragma unroll
                    for (int q = 0; q < 4; ++q) red[(w * 16 + 4 * kk + q) * 48 + 16 * ct + rr] = acc[ct][q];
            }
            __syncthreads();
        }
    }
    const int li = n;
    __syncthreads();
    if (C.tid < 32) base[C.tid] = (int)__hip_atomic_fetch_add(cnt + C.tid, (unsigned)hist[C.tid], RLX_AGENT);
    __syncthreads();
    int* ROWSE = (int*)(a.ws + WS_ROWSE);
    for (int i = C.tid; i < li * 16; i += NTHR) { const int gi = i >> 4, r = i & 15, m = (gfirst + gi) * 16 + r; int* ag = ASG + (size_t)m * 8;
        const int e0 = le[i * 2], e1 = le[i * 2 + 1], p0 = base[e0] + lr[i * 2], p1 = base[e1] + lr[i * 2 + 1];
        ag[2] = p0; ag[3] = p1; ROWSE[(size_t)e0 * RT + p0] = m; ROWSE[(size_t)e1 * RT + p1] = m; }
}
__device__ __forceinline__ int moe_tables(const Args& a, const Ctx& C, int l, int tabofs) {
    LAS int* tab = (LAS int*)(C.lds + tabofs);
    const unsigned* cnt = (const unsigned*)(a.ws + WS_CTL) + CW_CNT + 64 * l;
    if (C.tid < 32) tab[C.tid] = (int)cnt[C.tid];
    __syncthreads();
    if (C.tid == 0) { int acc = 0; for (int e = 0; e < 32; ++e) { const int c = tab[e]; tab[32 + e] = acc; acc += (c + 255) & ~255; } tab[64] = acc; }
    __syncthreads();
    const int nT = tab[64] >> 8;
    for (int ti = C.tid; ti < nT; ti += NTHR) { int e = 0; for (int q = 0; q < 32; ++q) if (tab[32 + q] <= ti * 256 && ti * 256 < tab[32 + q] + ((tab[q] + 255) & ~255)) e = q; tab[128 + ti] = e; }
    __syncthreads();
    return nT;
}
struct CombAsg { int e0, e1, p0, p1, w0, w1; };
__device__ __forceinline__ void phase_moe_combine(const Args& a, const Ctx& C, int l) {
    const float* MOD = (const float*)(a.ws + WS_MOD); const bf16* YG = (const bf16*)(a.ws + WS_YG); const int* ASG = (const int*)(a.ws + WS_ASG);
    float* hctx = (float*)(a.ws + WS_HCTX); bf16* A = (bf16*)(a.ws + WS_A);
    const int m0 = l == 0 ? 0 : RC;
    (void)moe_tables(a, C, l, 0); const LAS int* tab = (const LAS int*)C.lds;
    const int per = (RT - m0 + C.ngw - 1) / C.ngw, mbeg = m0 + C.gw * per, mend = mbeg + per < RT ? mbeg + per : RT;
    if (mbeg >= mend) return;
    f32x4 g2v[4], nwv[4], scv[4], shv[4]; int curmod = -1;
#pragma unroll
    for (int j = 0; j < 4; ++j) nwv[j] = ((const f32x4*)(l == 0 ? a.norm_mix + D : a.norm_final))[C.lane + 64 * j];
    u32x2 y0[2][4], y1[2][4]; f32x4 hv[2][4]; float cw0[2], cw1[2];
    CombAsg q0, q1;
#define CB_ASG(dst, m_) do { const int mc_ = (m_) < mend ? (m_) : mend - 1; const int* ag_ = ASG + (size_t)mc_ * 8; dst.e0 = ag_[0]; dst.e1 = ag_[1]; dst.p0 = ag_[2]; dst.p1 = ag_[3]; dst.w0 = ag_[4]; dst.w1 = ag_[5]; } while (0)
#define CB_ROWS(set, src, m_) do { const int mc_ = (m_) < mend ? (m_) : mend - 1; const int d0_ = tab[32 + src.e0] + src.p0, d1_ = tab[32 + src.e1] + src.p1; cw0[set] = __int_as_float(src.w0); cw1[set] = __int_as_float(src.w1); \
        const float* hr_ = mc_ < RC ? hctx + (size_t)mc_ * D : a.out + (size_t)(mc_ - RC) * D; \
        _Pragma("unroll") for (int j_ = 0; j_ < 4; ++j_) { y0[set][j_] = ((const u32x2*)(YG + (size_t)d0_ * D))[C.lane + 64 * j_]; y1[set][j_] = ((const u32x2*)(YG + (size_t)d1_ * D))[C.lane + 64 * j_]; hv[set][j_] = ((const f32x4*)hr_)[C.lane + 64 * j_]; } } while (0)
#define CB_ROW(set, m_) do { const int m = (m_); int modrow, t_, L_; row_info(m, modrow, t_, L_); \
        if (modrow != curmod) { curmod = modrow; const float* g2_ = MOD + (size_t)(l * 17 + modrow) * 6144 + 5120; const float* md_ = MOD + (size_t)(17 + modrow) * 6144; \
            _Pragma("unroll") for (int j_ = 0; j_ < 4; ++j_) { g2v[j_] = ((const f32x4*)g2_)[C.lane + 64 * j_]; if (l == 0) { scv[j_] = ((const f32x4*)(md_ + 1024))[C.lane + 64 * j_]; shv[j_] = ((const f32x4*)md_)[C.lane + 64 * j_]; } } } \
        float* hrow = m < RC ? hctx + (size_t)m * D : a.out + (size_t)(m - RC) * D; const float w0 = cw0[set], w1 = cw1[set]; \
        f32x4 v[4]; float ss = 0.f; \
        _Pragma("unroll") for (int j = 0; j < 4; ++j) { const u32x2 p0 = y0[set][j], p1 = y1[set][j]; \
            f32x4 y; y.x = w0 * bflo(p0.x) + w1 * bflo(p1.x); y.y = w0 * bfhi(p0.x) + w1 * bfhi(p1.x); y.z = w0 * bflo(p0.y) + w1 * bflo(p1.y); y.w = w0 * bfhi(p0.y) + w1 * bfhi(p1.y); \
            v[j] = hv[set][j] + g2v[j] * y; ss += (v[j].x * v[j].x + v[j].y * v[j].y) + (v[j].z * v[j].z + v[j].w * v[j].w); } \
          \
        if (m + 2 < mend) { if (set == 0) { CB_ROWS(0, q0, m + 2); CB_ASG(q0, m + 4); } else { CB_ROWS(1, q1, m + 2); CB_ASG(q1, m + 4); } } \
        const float rstd = 1.0f / sqrtf(wave_sum(ss) * (1.0f / D) + EPS); \
        if (l == 0) { \
            if (m >= RC) { _Pragma("unroll") for (int j = 0; j < 4; ++j) ((f32x4*)hrow)[C.lane + 64 * j] = v[j]; } \
            _Pragma("unroll") for (int j = 0; j < 4; ++j) v[j] = v[j] * rstd * nwv[j] * (scv[j] + 1.0f) + shv[j]; \
            store_row_bf16(A + (size_t)m * D, C.lane, v); \
        } else { _Pragma("unroll") for (int j = 0; j < 4; ++j) ((f32x4*)hrow)[C.lane + 64 * j] = v[j] * rstd * nwv[j]; } } while (0)
    CB_ASG(q0, mbeg); CB_ASG(q1, mbeg + 1);
    CB_ROWS(0, q0, mbeg); CB_ROWS(1, q1, mbeg + 1);
    CB_ASG(q0, mbeg + 2); CB_ASG(q1, mbeg + 3);
    for (int mi = mbeg; mi < mend; mi += 2) {
        CB_ROW(0, mi);
        if (mi + 1 < mend) CB_ROW(1, mi + 1);
    }
#undef CB_ASG
#undef CB_ROWS
#undef CB_ROW
}
__device__ __forceinline__ void phase_attn_naive(const Args& a, const Ctx& C) {
    LAS float* ps = (LAS float*)(C.lds + C.wave * 9472);
    LAS float* qs = ps + 4 * 528;
    const bf16* Q1 = (const bf16*)(a.ws + WS_Q1); const bf16* K1 = (const bf16*)(a.ws + WS_K1); const bf16* V1 = (const bf16*)(a.ws + WS_V1); bf16* O1 = (bf16*)(a.ws + WS_O1);
    for (int task = C.gw; task < RL * 4; task += C.ngw) {
        const int kvh = task & 3, bt = task >> 2, b = bt >> 11, t = bt & 2047;
        { const u32x2 qv = *((const u32x2*)(Q1 + (size_t)bt * 1024 + kvh * 256) + C.lane); qs[4 * C.lane] = bflo(qv.x); qs[4 * C.lane + 1] = bfhi(qv.x); qs[4 * C.lane + 2] = bflo(qv.y); qs[4 * C.lane + 3] = bfhi(qv.y); }
        const int lo = t - 128 < 0 ? 0 : t - 128, hi = t + 128 > SEQ - 1 ? SEQ - 1 : t + 128, nk = 256 + hi - lo + 1;
        float sc[4][9];
#pragma unroll
        for (int i = 0; i < 9; ++i) { const int kx = C.lane + 64 * i;
            if (kx < nk) { const int row = kx < 256 ? b * 256 + kx : RC + b * SEQ + lo + (kx - 256); const u32x4* kp = (const u32x4*)(K1 + (size_t)row * 256 + kvh * 64);
                float s0 = 0.f, s1 = 0.f, s2 = 0.f, s3 = 0.f;
#pragma unroll
                for (int c8 = 0; c8 < 8; ++c8) { float kf[8]; unpack8(kp[c8], kf);
#pragma unroll
                    for (int e = 0; e < 8; ++e) { const int dd = c8 * 8 + e; s0 += qs[dd] * kf[e]; s1 += qs[64 + dd] * kf[e]; s2 += qs[128 + dd] * kf[e]; s3 += qs[192 + dd] * kf[e]; } }
                sc[0][i] = s0; sc[1][i] = s1; sc[2][i] = s2; sc[3][i] = s3; }
            else { sc[0][i] = -INFINITY; sc[1][i] = -INFINITY; sc[2][i] = -INFINITY; sc[3][i] = -INFINITY; } }
#pragma unroll
        for (int g = 0; g < 4; ++g) { const float sink = a.at_sink[kvh * 4 + g]; float mx = sc[g][0];
#pragma unroll
            for (int i = 1; i < 9; ++i) mx = fmaxf(mx, sc[g][i]);
            mx = fmaxf(wave_max(mx), sink); float sum = 0.f, p[9];
#pragma unroll
            for (int i = 0; i < 9; ++i) { p[i] = __expf(sc[g][i] - mx); sum += p[i]; }
            sum = wave_sum(sum) + __expf(sink - mx); const float inv = 1.0f / sum;
#pragma unroll
            for (int i = 0; i < 9; ++i) { const int kx = C.lane + 64 * i; if (kx < 528) ps[g * 528 + kx] = p[i] * inv; } }
        float o0 = 0.f, o1 = 0.f, o2 = 0.f, o3 = 0.f;
        for (int kx = 0; kx < nk; ++kx) { const int row = kx < 256 ? b * 256 + kx : RC + b * SEQ + lo + (kx - 256); const float v = bf2f(V1[(size_t)row * 256 + kvh * 64 + C.lane]);
            o0 += ps[kx] * v; o1 += ps[528 + kx] * v; o2 += ps[1056 + kx] * v; o3 += ps[1584 + kx] * v; }
        bf16* op = O1 + (size_t)bt * 1024 + kvh * 256 + C.lane;
        op[0] = (bf16)f2bf(o0); op[64] = (bf16)f2bf(o1); op[128] = (bf16)f2bf(o2); op[192] = (bf16)f2bf(o3);
    }
}
typedef float f32x16 __attribute__((ext_vector_type(16)));
typedef short s16x8 __attribute__((ext_vector_type(8)));
typedef short s16x4 __attribute__((ext_vector_type(4)));
template <bool MASK>
__device__ __forceinline__ void attn_tile(const s16x8 (&kf)[4], const s16x8 (&qf)[4], float& m_run, float& l_run, f32x16& Oa, f32x16& Ob, unsigned va, int start, int tq, int h) {
    f32x16 S = __builtin_amdgcn_mfma_f32_32x32x16_bf16(kf[0], qf[0], (f32x16){0.f, 0.f, 0.f, 0.f, 0.f, 0.f, 0.f, 0.f, 0.f, 0.f, 0.f, 0.f, 0.f, 0.f, 0.f, 0.f}, 0, 0, 0);
#pragma unroll
    for (int s = 1; s < 4; ++s) S = __builtin_amdgcn_mfma_f32_32x32x16_bf16(kf[s], qf[s], S, 0, 0, 0);
    if constexpr (MASK) {
#pragma unroll
        for (int i = 0; i < 16; ++i) { const int key = start + (i & 3) + 8 * (i >> 2) + 4 * h; const int dl = tq - key; if (dl > 128 || dl < -128) S[i] = -INFINITY; } }
    float tmax = S[0];
#pragma unroll
    for (int i = 1; i < 16; ++i) tmax = fmaxf(tmax, S[i]);
    tmax = xor32_max(tmax);
    const float m_new = fmaxf(m_run, tmax), alpha = __builtin_amdgcn_exp2f(m_run - m_new);
    float psum = 0.f;
#pragma unroll
    for (int i = 0; i < 16; ++i) { S[i] = __builtin_amdgcn_exp2f(S[i] - m_new); psum += S[i]; }
    psum = xor32_sum(psum);
    l_run = l_run * alpha + psum; m_run = m_new;
#pragma unroll
    for (int i = 0; i < 16; ++i) { Oa[i] *= alpha; Ob[i] *= alpha; }
    s16x8 pf[2];
#pragma unroll
    for (int s = 0; s < 2; ++s) { u32x4 w; w.x = pk2(S[8 * s], S[8 * s + 1]); w.y = pk2(S[8 * s + 2], S[8 * s + 3]); w.z = pk2(S[8 * s + 4], S[8 * s + 5]); w.w = pk2(S[8 * s + 6], S[8 * s + 7]); pf[s] = __builtin_bit_cast(s16x8, w); }
    u32x2 v000, v010, v100, v110, v001, v011, v101, v111;
    asm volatile("ds_read_b64_tr_b16 %0, %8\n\tds_read_b64_tr_b16 %1, %8 offset:1024\n\tds_read_b64_tr_b16 %2, %8 offset:2048\n\tds_read_b64_tr_b16 %3, %8 offset:3072\n\t"
                 "ds_read_b64_tr_b16 %4, %8 offset:64\n\tds_read_b64_tr_b16 %5, %8 offset:1088\n\tds_read_b64_tr_b16 %6, %8 offset:2112\n\tds_read_b64_tr_b16 %7, %8 offset:3136\n\ts_waitcnt lgkmcnt(0)"
                 : "=&v"(v000), "=&v"(v010), "=&v"(v100), "=&v"(v110), "=&v"(v001), "=&v"(v011), "=&v"(v101), "=&v"(v111) : "v"(va) : "memory");
    { u32x4 w; w.x = v000.x; w.y = v000.y; w.z = v010.x; w.w = v010.y; Oa = __builtin_amdgcn_mfma_f32_32x32x16_bf16(__builtin_bit_cast(s16x8, w), pf[0], Oa, 0, 0, 0); }
    { u32x4 w; w.x = v100.x; w.y = v100.y; w.z = v110.x; w.w = v110.y; Oa = __builtin_amdgcn_mfma_f32_32x32x16_bf16(__builtin_bit_cast(s16x8, w), pf[1], Oa, 0, 0, 0); }
    { u32x4 w; w.x = v001.x; w.y = v001.y; w.z = v011.x; w.w = v011.y; Ob = __builtin_amdgcn_mfma_f32_32x32x16_bf16(__builtin_bit_cast(s16x8, w), pf[0], Ob, 0, 0, 0); }
    { u32x4 w; w.x = v101.x; w.y = v101.y; w.z = v111.x; w.w = v111.y; Ob = __builtin_amdgcn_mfma_f32_32x32x16_bf16(__builtin_bit_cast(s16x8, w), pf[1], Ob, 0, 0, 0); }
}
__device__ __forceinline__ void phase_attn(const Args& a, const Ctx& C) {
    LAS unsigned char* vl = C.lds;
    LAS unsigned char* kl = C.lds + 73728;
    const unsigned vl_addr = (unsigned)(uintptr_t)vl;
    const bf16* Q1 = (const bf16*)(a.ws + WS_Q1); const bf16* K1 = (const bf16*)(a.ws + WS_K1); const bf16* V1 = (const bf16*)(a.ws + WS_V1); bf16* O1 = (bf16*)(a.ws + WS_O1);
    const int lane = C.lane, r = lane & 31, h = lane >> 5, g = C.wave >> 1, qh = C.wave & 1;
    const unsigned lane_off = (unsigned)((4 * h + ((lane & 15) >> 2)) * 128 + (16 * ((lane >> 4) & 1) + 4 * (lane & 3)) * 2);
    const LAS unsigned char* kbase = kl + r * 128; const int swz = (r >> 1) & 7;
    u32x4 vreg[9], kreg[9];
#define ATT_KVLOAD(u_) do { const int qb_ = (u_) & 31, kvh_ = ((u_) >> 5) & 3, b_ = (u_) >> 7, q0_ = qb_ * 64; _Pragma("unroll") for (int k_ = 0; k_ < 9; ++k_) { const int idx_ = C.tid + NTHR * k_, row_ = idx_ >> 3, ch_ = idx_ & 7; \
            int grow_; bool ok_ = true; if (row_ < 256) grow_ = b_ * 256 + row_; else { const int kp_ = q0_ - 128 + (row_ - 256); ok_ = kp_ >= 0 && kp_ < SEQ; grow_ = RC + b_ * SEQ + (ok_ ? kp_ : 0); } \
            vreg[k_] = *(const u32x4*)(V1 + (size_t)grow_ * 256 + kvh_ * 64 + ch_ * 8); kreg[k_] = *(const u32x4*)(K1 + (size_t)grow_ * 256 + kvh_ * 64 + ch_ * 8); } } while (0)
#define ATT_KVSTORE() do { _Pragma("unroll") for (int k_ = 0; k_ < 9; ++k_) { const int idx_ = C.tid + NTHR * k_, row_ = idx_ >> 3, ch_ = idx_ & 7; *(LAS u32x4*)(vl + row_ * 128 + ch_ * 16) = vreg[k_]; \
            *(LAS u32x4*)(kl + row_ * 128 + ((ch_ ^ ((row_ >> 1) & 7)) * 16)) = kreg[k_]; } } while (0)
    if (C.vcu < 2048) { ATT_KVLOAD(C.vcu); ATT_KVSTORE(); }
    __syncthreads();
    for (int unit = C.vcu; unit < 2048; unit += C.G) {
        const int qb = unit & 31, kvh = (unit >> 5) & 3, b = unit >> 7, q0 = qb * 64;
        if (unit + C.G < 2048) ATT_KVLOAD(unit + C.G);
        const int tq0 = q0 + 32 * qh, tq = tq0 + r, head = kvh * 4 + g;
        s16x8 qf[4];
        { const bf16* qp = Q1 + (size_t)(b * SEQ + tq) * 1024 + head * 64 + 8 * h;
#pragma unroll
          for (int s = 0; s < 4; ++s) qf[s] = *(const s16x8*)(qp + 16 * s); }
        float m_run = a.at_sink[head] * 1.4426950408889634f, l_run = 1.0f;
        f32x16 Oa, Ob;
#pragma unroll
        for (int i = 0; i < 16; ++i) { Oa[i] = 0.f; Ob[i] = 0.f; }
        const int i_lo = tq0 < 128 ? (128 - tq0) >> 5 : 0, i_hi = (SEQ - 32 - (tq0 - 128)) >> 5 > 8 ? 8 : (SEQ - 32 - (tq0 - 128)) >> 5, ntile = 8 + i_hi - i_lo + 1;
#define ATT_LT(tn_) ((tn_) < 8 ? (tn_) : 8 + i_lo + (tn_) - 8 + qh)
#define ATT_KLOAD(kf_, tn_) do { const LAS unsigned char* kp_ = kbase + ATT_LT(tn_) * 4096; _Pragma("unroll") for (int s_ = 0; s_ < 4; ++s_) kf_[s_] = *(const LAS s16x8*)(kp_ + (((h + 2 * s_) ^ swz) * 16)); } while (0)
#define ATT_TILE(kf_, tj_) do { const int tj__ = (tj_); const bool lat_ = tj__ >= 8; const int i_ = i_lo + tj__ - 8; const int start_ = lat_ ? tq0 - 128 + 32 * i_ : 0; const int ltile_ = lat_ ? 8 + i_ + qh : tj__; \
            const unsigned va_ = vl_addr + (unsigned)ltile_ * 4096u + lane_off; \
            if (lat_ && (i_ == 0 || i_ == 8)) attn_tile<true>(kf_, qf, m_run, l_run, Oa, Ob, va_, start_, tq, h); else attn_tile<false>(kf_, qf, m_run, l_run, Oa, Ob, va_, start_, tq, h); } while (0)
        s16x8 kA[4], kB[4];
        ATT_KLOAD(kA, 0);
        int tj = 0;
        for (; tj + 1 < ntile; tj += 2) {
            ATT_KLOAD(kB, tj + 1);
            ATT_TILE(kA, tj);
            if (tj + 2 < ntile) ATT_KLOAD(kA, tj + 2);
            ATT_TILE(kB, tj + 1);
        }
        if (tj < ntile) ATT_TILE(kA, tj);
#undef ATT_KLOAD
#undef ATT_TILE
#undef ATT_LT
        const float inv = 1.0f / l_run;
        bf16* ob = O1 + (size_t)(b * SEQ + tq) * 1024 + head * 64 + 8 * h;
#pragma unroll
        for (int j = 0; j < 2; ++j) {
            u32x2 a0, b0, a1, b1;
            a0.x = pk2(Oa[8 * j] * inv, Oa[8 * j + 1] * inv); a0.y = pk2(Oa[8 * j + 2] * inv, Oa[8 * j + 3] * inv); b0.x = pk2(Oa[8 * j + 4] * inv, Oa[8 * j + 5] * inv); b0.y = pk2(Oa[8 * j + 6] * inv, Oa[8 * j + 7] * inv);
            a1.x = pk2(Ob[8 * j] * inv, Ob[8 * j + 1] * inv); a1.y = pk2(Ob[8 * j + 2] * inv, Ob[8 * j + 3] * inv); b1.x = pk2(Ob[8 * j + 4] * inv, Ob[8 * j + 5] * inv); b1.y = pk2(Ob[8 * j + 6] * inv, Ob[8 * j + 7] * inv);
            const auto sx0 = __builtin_amdgcn_permlane32_swap(a0.x, b0.x, false, false), sy0 = __builtin_amdgcn_permlane32_swap(a0.y, b0.y, false, false);
            const auto sx1 = __builtin_amdgcn_permlane32_swap(a1.x, b1.x, false, false), sy1 = __builtin_amdgcn_permlane32_swap(a1.y, b1.y, false, false);
            *(u32x4*)(ob + 16 * j) = (u32x4){sx0[0], sy0[0], sx0[1], sy0[1]};
            *(u32x4*)(ob + 32 + 16 * j) = (u32x4){sx1[0], sy1[0], sx1[1], sy1[1]};
        }
        __syncthreads();
        if (unit + C.G < 2048) ATT_KVSTORE();
        __syncthreads();
    }
#undef ATT_KVLOAD
#undef ATT_KVSTORE
}
#define RMAP(tile, r) (32 * ((tile) >> 1) + 8 * ((r) >> 2) + ((r) & 3) + 4 * ((tile) & 1))
constexpr int SB_WN = 0, SB_QD = 17408, SB_KDT = 34816, SB_QK = 53248, SB_UT = 62464, SB_BYTES = 71680;
__device__ __forceinline__ s16x8 afrag16(const LAS unsigned char* p) { return *(const LAS s16x8*)p; }
__device__ __forceinline__ s16x8 afrag(const LAS unsigned char* p) { const u32x2 lo = *(const LAS u32x2*)p, hi = *(const LAS u32x2*)(p + 32); u32x4 w; w.x = lo.x; w.y = lo.y; w.z = hi.x; w.w = hi.y; return __builtin_bit_cast(s16x8, w); }
__device__ __forceinline__ s16x8 pack_acc2(const f32x4 a, const f32x4 b) { u32x4 w; w.x = pk2(a.x, a.y); w.y = pk2(a.z, a.w); w.z = pk2(b.x, b.y); w.w = pk2(b.z, b.w); return __builtin_bit_cast(s16x8, w); }
__device__ __forceinline__ int scan_unit(int step, int b, int h, int d, int& cg) { if (step < 4) cg = b * 4 + (d ? 3 - step : step); else { const int n = step - 4; cg = 64 + b * 32 + (d ? 31 - n : n); } return (cg * 4 + h) * 2 + d; }
__device__ __forceinline__ void phase_dn_scan(const Args& a, const Ctx& C) {
    const unsigned char* gW = a.ws + WS_W; const unsigned char* gQ = (const unsigned char*)a.out; const unsigned char* gQK = a.ws + WS_QK; const unsigned char* gU = a.ws + WS_U;
    const float* GL = (const float*)(a.ws + WS_GL);
    const float* GE = (const float*)(a.ws + WS_GE);
    bf16* OF = (bf16*)(a.ws + WS_QD); bf16* OB = OF + (size_t)RT * 512;
    const int tid = C.tid;
    const int lt = tid & 255;
    const unsigned sd_wq = (unsigned)((lt >> 4) * 272 + (lt & 15) * 16), sd_k = (unsigned)(((lt >> 4) >> 1) * 528 + ((lt >> 4) & 1) * 8 + ((lt >> 4) >> 3) * 64 + (lt & 15) * 32), sd_g = (unsigned)((lt >> 3) * 144 + (lt & 7) * 16);
    for (int work = C.vcu; work < 256; work += C.G) {
        const int half = work & 1, d = (work >> 1) & 1, h = (work >> 2) & 3, b = work >> 4;
        const int qoff0 = (d ? 63 - (lt >> 4) : (lt >> 4)) * 3072 + h * 256 + (lt & 15) * 16, qstep = d ? -16 * 3072 : 16 * 3072;
#define SCAN_LOAD(st, step_) do { int cg_; const size_t ub = (size_t)scan_unit((step_), b, h, d, cg_); \
            _Pragma("unroll") for (int i_ = 0; i_ < 4; ++i_) { st[i_] = *(const u32x4*)(gW + ub * 16384 + (size_t)(lt + 256 * i_) * 16); st[4 + i_] = *(const u32x4*)(gQ + (size_t)cg_ * (64 * 3072) + (unsigned)(qoff0 + i_ * qstep)); \
                st[8 + i_] = *(const u32x4*)(gQ + (size_t)cg_ * (64 * 3072) + (unsigned)(qoff0 + 1024 + i_ * qstep)); } \
            _Pragma("unroll") for (int i_ = 0; i_ < 2; ++i_) { st[12 + i_] = *(const u32x4*)(gQK + ub * 8192 + (size_t)(lt + 256 * i_) * 16); st[14 + i_] = *(const u32x4*)(gU + ub * 16384 + (size_t)half * 8192 + (size_t)(lt + 256 * i_) * 16); } } while (0)
#define SCAN_STORE(st, bufoff) do { _Pragma("unroll") for (int i_ = 0; i_ < 4; ++i_) { *(LAS u32x4*)(C.lds + (bufoff) + SB_WN + sd_wq + i_ * 4352) = st[i_]; *(LAS u32x4*)(C.lds + (bufoff) + SB_QD + sd_wq + i_ * 4352) = st[4 + i_]; \
                LAS unsigned char* kp_ = C.lds + (bufoff) + SB_KDT + sd_k + i_ * 4352; *(LAS u32x2*)kp_ = (u32x2){st[8 + i_].x, st[8 + i_].y}; *(LAS u32x2*)(kp_ + 16) = (u32x2){st[8 + i_].z, st[8 + i_].w}; } \
            _Pragma("unroll") for (int i_ = 0; i_ < 2; ++i_) { *(LAS u32x4*)(C.lds + (bufoff) + SB_QK + sd_g + i_ * 4608) = st[12 + i_]; *(LAS u32x4*)(C.lds + (bufoff) + SB_UT + sd_g + i_ * 4608) = st[14 + i_]; } } while (0)
#define SCAN_FLUSH(sp) do { int cgp_; (void)scan_unit((sp), b, h, d, cgp_); _Pragma("unroll") for (int k_ = 0; k_ < 2; ++k_) { const int c_ = lt + 256 * k_, rr_ = c_ >> 3, ch_ = c_ & 7; \
            const u32x4 v_ = *(const LAS u32x4*)(C.lds + 2 * SB_BYTES + ((sp) & 1) * 9216 + rr_ * 144 + ch_ * 16); const int m_ = cgp_ * 64 + (d ? 63 - rr_ : rr_); \
            *(u32x4*)((d ? OB : OF) + (size_t)m_ * 512 + h * 128 + half * 64 + ch_ * 8) = v_; } } while (0)
        if (C.wave >= 4) {
            u32x4 sa[16], sb[16];
            SCAN_LOAD(sa, 0); SCAN_STORE(sa, 0); SCAN_LOAD(sb, 1); SCAN_LOAD(sa, 2);
            __syncthreads();
            for (int step = 0; step < 36; step += 2) {
                SCAN_STORE(sb, SB_BYTES); if (step + 3 < 36) SCAN_LOAD(sb, step + 3);
                if (step > 0) SCAN_FLUSH(step - 1);
                __syncthreads();
                if (step + 2 < 36) SCAN_STORE(sa, 0); if (step + 4 < 36) SCAN_LOAD(sa, step + 4);
                SCAN_FLUSH(step);
                __syncthreads();
            }
            SCAN_FLUSH(35);
        } else {
        int ln_ = C.lane; asm volatile("" : "+v"(ln_)); const int fr = ln_ & 15, q = ln_ >> 4;
        f32x4 S[8];
#pragma unroll
        for (int t = 0; t < 8; ++t) S[t] = (f32x4){0.f, 0.f, 0.f, 0.f};
        f32x4 egn[4], gkn[4];
        { int cg0_; const int u0_ = scan_unit(0, b, h, d, cg0_);
#pragma unroll
          for (int i = 0; i < 4; ++i) { egn[i] = *(const f32x4*)(GE + (size_t)u0_ * 128 + RMAP(i, 4 * q)); gkn[i] = *(const f32x4*)(GE + (size_t)u0_ * 128 + 64 + RMAP(i, 4 * q)); } }
        const unsigned ktr_lane = (unsigned)(q * 2176 + (fr >> 3) * 528 + ((fr >> 2) & 1) * 8 + (fr & 3) * 32);
        __syncthreads();
        for (int step = 0; step < 36; ++step) {
            int cg; const int ucur = scan_unit(step, b, h, d, cg);
            {
                f32x4 eg[4], gk[4];
#pragma unroll
                for (int i = 0; i < 4; ++i) { eg[i] = egn[i]; gk[i] = gkn[i]; }
                if (step + 1 < 36) { int cgn_; const int un_ = scan_unit(step + 1, b, h, d, cgn_);
#pragma unroll
                    for (int i = 0; i < 4; ++i) { egn[i] = *(const f32x4*)(GE + (size_t)un_ * 128 + RMAP(i, 4 * q)); gkn[i] = *(const f32x4*)(GE + (size_t)un_ * 128 + 64 + RMAP(i, 4 * q)); } }

                const LAS unsigned char* B0 = C.lds + (step & 1) * SB_BYTES;
                const float gl = GL[ucur];
                s16x8 Sb[4];
#pragma unroll
                for (int s = 0; s < 4; ++s) Sb[s] = pack_acc2(S[2 * s], S[2 * s + 1]);
                f32x4 vn[4], o[4];
                s16x8 wf[2][4], qf[2][4];
#define SCAN_LDWQ(buf, i) do { _Pragma("unroll") for (int s_ = 0; s_ < 4; ++s_) { wf[buf][s_] = afrag16(B0 + SB_WN + RMAP(i, fr) * 272 + (32 * s_ + 8 * q) * 2); qf[buf][s_] = afrag16(B0 + SB_QD + RMAP(i, fr) * 272 + (32 * s_ + 8 * q) * 2); } } while (0)
                SCAN_LDWQ(0, 0);
#pragma unroll
                for (int i = 0; i < 4; ++i) {
                    const u32x2 uu = *(const LAS u32x2*)(B0 + SB_UT + (16 * C.wave + fr) * 144 + RMAP(i, 4 * q) * 2);
                    if (i < 3) { if (i & 1) SCAN_LDWQ(0, i + 1); else SCAN_LDWQ(1, i + 1); }
                    __builtin_amdgcn_sched_barrier(0);
                    vn[i] = (f32x4){bflo(uu.x), bfhi(uu.x), bflo(uu.y), bfhi(uu.y)}; o[i] = (f32x4){0.f, 0.f, 0.f, 0.f};
#pragma unroll
                    for (int s = 0; s < 4; ++s) { vn[i] = __builtin_amdgcn_mfma_f32_16x16x32_bf16(wf[i & 1][s], Sb[s], vn[i], 0, 0, 0); o[i] = __builtin_amdgcn_mfma_f32_16x16x32_bf16(qf[i & 1][s], Sb[s], o[i], 0, 0, 0); }
                    __builtin_amdgcn_sched_barrier(0);
                }
#undef SCAN_LDWQ
#pragma unroll
                for (int i = 0; i < 4; ++i) o[i] = o[i] * eg[i];
                s16x8 gf[2][4];
#define SCAN_LDG(buf, g) do { if ((g) < 2) { _Pragma("unroll") for (int j_ = 0; j_ < 4; ++j_) gf[buf][j_] = afrag16(B0 + SB_QK + RMAP(2 * (g) + (j_ >> 1), fr) * 144 + (32 * (j_ & 1) + 8 * q) * 2); } \
                    else { _Pragma("unroll") for (int j_ = 0; j_ < 4; ++j_) { const int t_ = 2 * ((g) - 2) + (j_ >> 1); const LAS unsigned char* p_ = B0 + SB_KDT + ktr_lane + (j_ & 1) * 8704 + (8 * (t_ >> 1) + (t_ & 1)) * 16; \
                        const s16x4 lo_ = __builtin_amdgcn_ds_read_tr16_b64_v4i16((LAS s16x4*)p_), hi_ = __builtin_amdgcn_ds_read_tr16_b64_v4i16((LAS s16x4*)(p_ + 1056)); \
                        gf[buf][j_] = __builtin_shufflevector(lo_, hi_, 0, 1, 2, 3, 4, 5, 6, 7); } } } while (0)
                SCAN_LDG(0, 0);
                s16x8 vb[2], vbk[2];
#pragma unroll
                for (int s = 0; s < 2; ++s) { vb[s] = pack_acc2(vn[2 * s], vn[2 * s + 1]); vbk[s] = pack_acc2(vn[2 * s] * gk[2 * s], vn[2 * s + 1] * gk[2 * s + 1]); }
#pragma unroll
                for (int g = 0; g < 6; ++g) {
                    if (g < 5) { if (g & 1) SCAN_LDG(0, g + 1); else SCAN_LDG(1, g + 1); }
                    __builtin_amdgcn_sched_barrier(0);
                    if (g < 2) {
#pragma unroll
                        for (int j = 0; j < 4; ++j) o[2 * g + (j >> 1)] = __builtin_amdgcn_mfma_f32_16x16x32_bf16(gf[g & 1][j], vb[j & 1], o[2 * g + (j >> 1)], 0, 0, 0);
                    } else {
#pragma unroll
                        for (int j = 0; j < 4; ++j) { const int t = 2 * (g - 2) + (j >> 1); if ((j & 1) == 0) S[t] = S[t] * gl; S[t] = __builtin_amdgcn_mfma_f32_16x16x32_bf16(gf[g & 1][j], vbk[j & 1], S[t], 0, 0, 0); }
                    }
                    __builtin_amdgcn_sched_barrier(0);
                }
#undef SCAN_LDG
                LAS bf16* ob = (LAS bf16*)(C.lds + 2 * SB_BYTES + (step & 1) * 9216) + 16 * C.wave + fr;
#pragma unroll
                for (int i = 0; i < 4; ++i)
#pragma unroll
                    for (int e = 0; e < 4; ++e) ob[RMAP(i, 4 * q + e) * 72] = (bf16)f2bf(o[i][e]);
            }
            __syncthreads();
        }
        }
#undef SCAN_LOAD
#undef SCAN_STORE
#undef SCAN_FLUSH
    }
}
constexpr int IN_AT = 0, IN_TILE = 18432, IN_G = 18432 + 19456, IN_WAVE = 18432 + 19456 + 1024;
__device__ __forceinline__ unsigned tile_row(int row) { return (unsigned)(row * 288 + (row >> 3) * 128); }
__device__ __forceinline__ void phase_dn_intra(const Args& a, const Ctx& C) {
    if (C.wave >= 4) return;
    LAS unsigned char* wb = C.lds + C.wave * IN_WAVE;
    LAS float* AT = (LAS float*)(wb + IN_AT); LAS unsigned char* TU = wb + IN_AT; LAS unsigned char* TW = wb + IN_AT + 9216; LAS unsigned char* TL = wb + IN_TILE;
    LAS float* gs = (LAS float*)(wb + IN_G); LAS float* bs = gs + 64; LAS float* es = gs + 128; LAS float* ks = gs + 192;
    const unsigned tl_addr = (unsigned)(uintptr_t)TL;
    const bf16* QKV = (const bf16*)a.out; const float* LA = (const float*)(a.ws + WS_LA); const float* BT = (const float*)(a.ws + WS_BT);
    bf16* UT = (bf16*)(a.ws + WS_U); bf16* WN = (bf16*)(a.ws + WS_W); bf16* QK = (bf16*)(a.ws + WS_QK);
    float* GL = (float*)(a.ws + WS_GL); float* GE = (float*)(a.ws + WS_GE);
    const int wid = C.bid * 4 + C.wave, nw = C.G * 4;
    for (int unit = wid; unit < NUNIT; unit += nw) {
        int lane = C.lane; asm volatile("" : "+v"(lane));
        const int cg = unit >> 3, h = (unit >> 1) & 3, d = unit & 1;
        const size_t ub = (size_t)unit;
        u32x4 kst[16]; float la_n, b_n;
        { const int m = cg * 64 + (d ? 63 - lane : lane); la_n = LA[(size_t)m * 8 + d * 4 + h]; b_n = BT[(size_t)m * 8 + d * 4 + h];
          const unsigned char* kb_ = (const unsigned char*)(QKV + (size_t)cg * 64 * 1536 + 512 + h * 128);
#pragma unroll
          for (int c = 0; c < 16; ++c) { const int ch = c * 64 + lane, row = ch >> 4, cc = ch & 15; const unsigned off = (unsigned)((d ? 63 - row : row) * 3072 + cc * 16); kst[c] = *(const u32x4*)(kb_ + off); } }
        s16x8 Qall[4][4];
        { const int fr0 = lane & 15, q0_ = lane >> 4; const unsigned char* qb_ = (const unsigned char*)(QKV + (size_t)cg * 64 * 1536 + h * 128);
#pragma unroll
          for (int it = 0; it < 4; ++it) { const int i = 16 * it + fr0; const unsigned off = (unsigned)((d ? 63 - i : i) * 3072 + q0_ * 16);
#pragma unroll
              for (int s = 0; s < 4; ++s) Qall[it][s] = *(const s16x8*)(qb_ + off + 64 * s); } }
        { float g = la_n;
#pragma unroll
          for (int o = 1; o < 64; o <<= 1) { const float t = __int_as_float(__builtin_amdgcn_ds_bpermute(((lane - o) & 63) << 2, __float_as_int(g))); if (lane >= o) g += t; }
          const float g63 = __int_as_float(__builtin_amdgcn_readlane(__float_as_int(g), 63));
          const float eg_ = expf(g); gs[lane] = g; bs[lane] = b_n; const float kd_ = expf(g63 - g); es[lane] = eg_; ks[lane] = kd_; GE[ub * 128 + lane] = eg_; GE[ub * 128 + 64 + lane] = kd_;
          if (lane == 63) GL[unit] = expf(g); }
        asm volatile("s_waitcnt lgkmcnt(0)" ::: "memory");
        { int ln_ = lane; asm volatile("" : "+v"(ln_)); const int fr = ln_ & 15, q = ln_ >> 4;
#pragma unroll
        for (int c = 0; c < 16; ++c) { const int ch = c * 64 + lane, row = ch >> 4, cc = ch & 15; *(LAS u32x4*)(TL + tile_row(row) + cc * 16) = kst[c]; }
        asm volatile("s_waitcnt lgkmcnt(0)" ::: "memory");
#pragma unroll
        for (int it = 0; it < 4; ++it) {
            s16x8 Qf[4];
            {
#pragma unroll
              for (int s = 0; s < 4; ++s) Qf[s] = Qall[it][s]; }
#pragma unroll
            for (int jt = 0; jt < 4; ++jt) {
                if (jt <= it) {
                    f32x4 dk = (f32x4){0.f, 0.f, 0.f, 0.f}, dq = (f32x4){0.f, 0.f, 0.f, 0.f};
#pragma unroll
                    for (int s = 0; s < 4; ++s) { const s16x8 ki = *(const LAS s16x8*)(TL + tile_row(16 * it + fr) + (32 * s + 8 * q) * 2), kj = *(const LAS s16x8*)(TL + tile_row(16 * jt + fr) + (32 * s + 8 * q) * 2);
                        dk = __builtin_amdgcn_mfma_f32_16x16x32_bf16(ki, kj, dk, 0, 0, 0);
                        dq = __builtin_amdgcn_mfma_f32_16x16x32_bf16(kj, Qf[s], dq, 0, 0, 0); }
                    { const int j = 16 * jt + fr; const float gj = gs[j]; f32x4 av; const f32x4 gi4 = *(const LAS f32x4*)(gs + 16 * it + 4 * q), bi4 = *(const LAS f32x4*)(bs + 16 * it + 4 * q);
#pragma unroll
                      for (int e = 0; e < 4; ++e) { const int i = 16 * it + 4 * q + e; const float v = dk[e] * bi4[e] * __expf(fminf(gi4[e] - gj, 0.f)); av[e] = (i > j) ? v : 0.f; }
                      *(LAS f32x4*)(AT + j * 64 + 16 * it + 4 * q) = av; }
                    { const int i = 16 * it + fr; const float gi = gs[i]; float qv[4]; const f32x4 gj4 = *(const LAS f32x4*)(gs + 16 * jt + 4 * q);
#pragma unroll
                      for (int e = 0; e < 4; ++e) { const int j = 16 * jt + 4 * q + e; const float v = dq[e] * __expf(fminf(gi - gj4[e], 0.f)); qv[e] = (i >= j) ? v : 0.f; }
                      u32x2 w; w.x = pk2(qv[0], qv[1]); w.y = pk2(qv[2], qv[3]); *(u32x2*)(QK + ub * 4096 + i * 64 + 16 * jt + 4 * q) = w; }
                } else { const int i = 16 * it + fr; *(u32x2*)(QK + ub * 4096 + i * 64 + 16 * jt + 4 * q) = (u32x2){0u, 0u};
                    *(LAS f32x4*)(AT + (16 * jt + fr) * 64 + 16 * it + 4 * q) = (f32x4){0.f, 0.f, 0.f, 0.f}; }
                    }
        }
        }
        asm volatile("s_waitcnt lgkmcnt(0)" ::: "memory");
        u32x4 vst[16];
        f32x4 a21[2][2];
        { int ln_ = lane; asm volatile("" : "+v"(ln_)); const int hb = ln_ >> 5, r = ln_ & 31;
          const LAS float* ATb = AT + hb * (32 * 64 + 32);
          LAS float* trow = (LAS float*)(TL + 5120) + ln_ * 36;
#pragma unroll
          for (int k = 0; k < 8; ++k) *(LAS f32x4*)(trow + 4 * k) = (f32x4){0.f, 0.f, 0.f, 0.f};
          trow[31] = (r == 31) ? 1.f : 0.f;
#pragma unroll 1
          for (int cc = 30; cc >= 0; --cc) { float acc0 = (r == cc) ? 1.f : 0.f, acc1 = 0.f; const LAS float* ap = ATb + cc * 64;
              float acc2 = 0.f, acc3 = 0.f;
#pragma unroll
              for (int hq = 0; hq < 2; ++hq) { f32x4 av[4], tv[4];
#pragma unroll
                  for (int jq = 0; jq < 4; ++jq) { av[jq] = *(const LAS f32x4*)(ap + 16 * hq + 4 * jq); tv[jq] = *(const LAS f32x4*)(trow + 16 * hq + 4 * jq); }
#pragma unroll
                  for (int jq = 0; jq < 4; ++jq) { acc0 -= av[jq][0] * tv[jq][0]; acc1 -= av[jq][1] * tv[jq][1]; acc2 -= av[jq][2] * tv[jq][2]; acc3 -= av[jq][3] * tv[jq][3]; } }
              trow[cc] = (acc0 + acc1) + (acc2 + acc3); }
          { const int fr = ln_ & 15, q = ln_ >> 4;
#pragma unroll
            for (int t = 0; t < 2; ++t)
#pragma unroll
                for (int jt = 0; jt < 2; ++jt) a21[t][jt] = *(const LAS f32x4*)(AT + (16 * jt + fr) * 64 + 32 + 16 * t + 4 * q); }
          asm volatile("s_waitcnt lgkmcnt(0)" ::: "memory");
          { LAS unsigned char* dst = TL + hb * 2560 + r * 80;
#pragma unroll 1
            for (int c8 = 0; c8 < 4; ++c8) { float f[8], fu[8], fw[8]; const f32x4 t0 = *(const LAS f32x4*)(trow + 8 * c8), t1 = *(const LAS f32x4*)(trow + 8 * c8 + 4);
                const LAS float* bp = bs + 32 * hb + 8 * c8; const LAS float* ep = es + 32 * hb + 8 * c8;
                const f32x4 b0 = *(const LAS f32x4*)bp, b1 = *(const LAS f32x4*)(bp + 4), e0 = *(const LAS f32x4*)ep, e1 = *(const LAS f32x4*)(ep + 4);
#pragma unroll
                for (int e = 0; e < 4; ++e) { f[e] = t0[e]; f[4 + e] = t1[e]; fu[e] = t0[e] * b0[e]; fu[4 + e] = t1[e] * b1[e]; fw[e] = fu[e] * e0[e]; fw[4 + e] = fu[4 + e] * e1[e]; }
                *(LAS u32x4*)(dst + c8 * 16) = pack8(f);
                *(LAS u32x4*)(TU + ln_ * 144 + (4 * hb + c8) * 16) = pack8(fu); *(LAS u32x4*)(TW + ln_ * 144 + (4 * hb + c8) * 16) = pack8(fw);
                *(LAS u32x4*)(TU + ln_ * 144 + (4 * (1 - hb) + c8) * 16) = (u32x4){0u, 0u, 0u, 0u}; *(LAS u32x4*)(TW + ln_ * 144 + (4 * (1 - hb) + c8) * 16) = (u32x4){0u, 0u, 0u, 0u}; } }
        }
        asm volatile("s_waitcnt lgkmcnt(0)" ::: "memory");
        { int ln_ = lane; asm volatile("" : "+v"(ln_)); const int fr = ln_ & 15, q = ln_ >> 4;
          s16x8 t22f[2];
#pragma unroll
          for (int rt = 0; rt < 2; ++rt) t22f[rt] = afrag(TL + 2560 + (16 * rt + fr) * 80 + 8 * q);
          f32x4 zt[2][2];
#pragma unroll
          for (int jt = 0; jt < 2; ++jt) { const s16x8 af = pack_acc2(a21[0][jt], a21[1][jt]);
#pragma unroll
              for (int rt = 0; rt < 2; ++rt) zt[jt][rt] = __builtin_amdgcn_mfma_f32_16x16x32_bf16(af, t22f[rt], (f32x4){0.f, 0.f, 0.f, 0.f}, 0, 0, 0); }
#pragma unroll
          for (int ct = 0; ct < 2; ++ct) { u32x2 lo_, hi_; const unsigned ad_ = tl_addr + (unsigned)((4 * q + (fr >> 2)) * 80 + (16 * ct + 4 * (fr & 3)) * 2);
              asm volatile("ds_read_b64_tr_b16 %0, %2\n\tds_read_b64_tr_b16 %1, %2 offset:1280\n\ts_waitcnt lgkmcnt(0)" : "=&v"(lo_), "=&v"(hi_) : "v"(ad_) : "memory");
              u32x4 w_; w_.x = lo_.x; w_.y = lo_.y; w_.z = hi_.x; w_.w = hi_.y; const s16x8 t11f = __builtin_bit_cast(s16x8, w_);
              const f32x4 b4 = *(const LAS f32x4*)(bs + 16 * ct + 4 * q), e4 = *(const LAS f32x4*)(es + 16 * ct + 4 * q);
#pragma unroll
              for (int rt = 0; rt < 2; ++rt) { const f32x4 dd = __builtin_amdgcn_mfma_f32_16x16x32_bf16(t11f, pack_acc2(zt[0][rt], zt[1][rt]), (f32x4){0.f, 0.f, 0.f, 0.f}, 0, 0, 0);
                  float fu[4], fw[4];
#pragma unroll
                  for (int e = 0; e < 4; ++e) { fu[e] = -dd[e] * b4[e]; fw[e] = fu[e] * e4[e]; }
                  u32x2 wu, ww; wu.x = pk2(fu[0], fu[1]); wu.y = pk2(fu[2], fu[3]); ww.x = pk2(fw[0], fw[1]); ww.y = pk2(fw[2], fw[3]);
                  *(LAS u32x2*)(TU + (32 + 16 * rt + fr) * 144 + (16 * ct + 4 * q) * 2) = wu; *(LAS u32x2*)(TW + (32 + 16 * rt + fr) * 144 + (16 * ct + 4 * q) * 2) = ww; } }
          asm volatile("s_waitcnt lgkmcnt(0)" ::: "memory");
#pragma unroll
          for (int c = 0; c < 16; ++c) { const int ch = c * 64 + ln_, row = ch >> 4, cc = ch & 15; *(LAS u32x4*)(TL + tile_row(row) + cc * 16) = kst[c]; }
        }
        asm volatile("s_waitcnt lgkmcnt(0)" ::: "memory");
        { const unsigned char* vb_ = (const unsigned char*)(QKV + (size_t)cg * 64 * 1536 + 1024 + h * 128);
#pragma unroll
        for (int c = 0; c < 16; ++c) { const int ch = c * 64 + lane, row = ch >> 4, cc = ch & 15; const unsigned off = (unsigned)((d ? 63 - row : row) * 3072 + cc * 16); vst[c] = *(const u32x4*)(vb_ + off); } }
        { int ln_ = lane; asm volatile("" : "+v"(ln_)); const int fr = ln_ & 15, q = ln_ >> 4;
        const unsigned tr_lane = (unsigned)(((fr >> 2)) * 288 + (4 * (fr & 3)) * 2);
#define TR_FRAG(dst, ct, s) do { u32x2 lo_, hi_; const unsigned ad_ = tl_addr + tile_row(32 * (s) + 8 * q) + tr_lane + (unsigned)(ct) * 32u; \
            asm volatile("ds_read_b64_tr_b16 %0, %2\n\tds_read_b64_tr_b16 %1, %2 offset:1152\n\ts_waitcnt lgkmcnt(0)" : "=&v"(lo_), "=&v"(hi_) : "v"(ad_) : "memory"); \
            u32x4 w_; w_.x = lo_.x; w_.y = lo_.y; w_.z = hi_.x; w_.w = hi_.y; dst = __builtin_bit_cast(s16x8, w_); } while (0)
        s16x8 Tf[4][2];
#pragma unroll
        for (int it = 0; it < 4; ++it)
#pragma unroll
            for (int s = 0; s < 2; ++s) Tf[it][s] = *(const LAS s16x8*)(TW + (16 * it + fr) * 144 + (32 * s + 8 * q) * 2);
        asm volatile("s_waitcnt lgkmcnt(0)" ::: "memory");
#pragma unroll 1
        for (int hf = 0; hf < 2; ++hf) {
            s16x8 kfr[4][2];
#pragma unroll
            for (int c4 = 0; c4 < 4; ++c4) { TR_FRAG(kfr[c4][0], 4 * hf + c4, 0); TR_FRAG(kfr[c4][1], 4 * hf + c4, 1); }
#pragma unroll
            for (int c4 = 0; c4 < 4; ++c4)
#pragma unroll
                for (int it = 0; it < 4; ++it) { f32x4 acc = (f32x4){0.f, 0.f, 0.f, 0.f};
                    acc = __builtin_amdgcn_mfma_f32_16x16x32_bf16(kfr[c4][0], Tf[it][0], acc, 0, 0, 0); acc = __builtin_amdgcn_mfma_f32_16x16x32_bf16(kfr[c4][1], Tf[it][1], acc, 0, 0, 0);
                    u32x2 w; w.x = pk2(-acc[0], -acc[1]); w.y = pk2(-acc[2], -acc[3]); *(LAS u32x2*)(TW + (16 * it + fr) * 144 + (16 * c4 + 4 * q) * 2) = w; }
            asm volatile("s_waitcnt lgkmcnt(0)" ::: "memory");
#pragma unroll 4
            for (int c = 0; c < 8; ++c) { const int idx = c * 64 + ln_; *(u32x4*)(WN + ub * 8192 + (idx >> 3) * 128 + hf * 64 + (idx & 7) * 8) = *(const LAS u32x4*)(TW + (idx >> 3) * 144 + (idx & 7) * 16); }
            asm volatile("s_waitcnt lgkmcnt(0)" ::: "memory");
        }
        }
        { int ln_ = lane; asm volatile("" : "+v"(ln_)); const int fr = ln_ & 15, q = ln_ >> 4;
        const unsigned tr_lane = (unsigned)(((fr >> 2)) * 288 + (4 * (fr & 3)) * 2);
#pragma unroll
        for (int c = 0; c < 16; ++c) { const int ch = c * 64 + lane, row = ch >> 4, cc = ch & 15; *(LAS u32x4*)(TL + tile_row(row) + cc * 16) = vst[c]; }
        asm volatile("s_waitcnt lgkmcnt(0)" ::: "memory");
        s16x8 Tf[4][2];
#pragma unroll
        for (int it = 0; it < 4; ++it)
#pragma unroll
            for (int s = 0; s < 2; ++s) Tf[it][s] = *(const LAS s16x8*)(TU + (16 * it + fr) * 144 + (32 * s + 8 * q) * 2);
        asm volatile("s_waitcnt lgkmcnt(0)" ::: "memory");
#pragma unroll
        for (int ct = 0; ct < 8; ++ct) { s16x8 vf0, vf1; TR_FRAG(vf0, ct, 0); TR_FRAG(vf1, ct, 1);
#pragma unroll
            for (int it = 0; it < 4; ++it) { f32x4 acc = (f32x4){0.f, 0.f, 0.f, 0.f};
                acc = __builtin_amdgcn_mfma_f32_16x16x32_bf16(Tf[it][0], vf0, acc, 0, 0, 0); acc = __builtin_amdgcn_mfma_f32_16x16x32_bf16(Tf[it][1], vf1, acc, 0, 0, 0);
                u32x2 w; w.x = pk2(acc[0], acc[1]); w.y = pk2(acc[2], acc[3]); *(LAS u32x2*)(TU + (16 * ct + fr) * 144 + (16 * it + 4 * q) * 2) = w; } }
        asm volatile("s_waitcnt lgkmcnt(0)" ::: "memory");
#pragma unroll 4
        for (int c = 0; c < 16; ++c) { const int idx = c * 64 + ln_; *(u32x4*)(UT + ub * 8192 + idx * 8) = *(const LAS u32x4*)(TU + (idx >> 3) * 144 + (idx & 7) * 16); }
        asm volatile("s_waitcnt lgkmcnt(0)" ::: "memory");
        }
#undef TR_FRAG
    }
}

#ifndef MK_N_LAUNCHES
#define MK_N_LAUNCHES 1
#endif
constexpr int NPH = 21;
constexpr int MOE_TAB_OFF = 131072 + 8192;
#ifndef PG8_SP2
#define PG8_SP2 true
#endif
#ifndef PG8_ALIGN
#define PG8_ALIGN true
#endif
__global__ void __launch_bounds__(NTHR, 2) fwd(Args a) {
    extern __shared__ __attribute__((aligned(16))) unsigned char lds_raw[];
    Ctx C; C.lds = (LAS unsigned char*)lds_raw; C.tid = threadIdx.x; C.lane = C.tid & 63; C.wave = __builtin_amdgcn_readfirstlane(C.tid >> 6);
    C.G = gridDim.x; C.bid = blockIdx.x; C.gw = C.bid * NWAVES + C.wave; C.ngw = C.G * NWAVES;
    C.vcu = (C.G % 8 == 0) ? (C.bid % 8) * (C.G / 8) + C.bid / 8 : C.bid;
#define FRESH(Cn) Ctx Cn; { int t_ = threadIdx.x; asm volatile("" : "+v"(t_)); Cn.lds = C.lds; Cn.tid = t_; Cn.lane = t_ & 63; Cn.wave = __builtin_amdgcn_readfirstlane(t_ >> 6); Cn.G = C.G; Cn.bid = C.bid; Cn.vcu = C.vcu; Cn.gw = Cn.bid * NWAVES + Cn.wave; Cn.ngw = C.ngw; }
    volatile LAS unsigned* MISC = (volatile LAS unsigned*)(C.lds + MISC_OFF);
    for (int u = C.tid; u < (LDS_BYTES - LDSCTL_OFF) / 4; u += NTHR) ((LAS unsigned*)(C.lds + LDSCTL_OFF))[u] = 0u;
    __syncthreads();
    const int lo = a.ph_lo, hi = a.ph_hi;
    unsigned* ctl = (unsigned*)(a.ws + WS_CTL);
    XcdBarrier bar; bar.bar = ctl + CW_BAR; bar.x = 0; bar.st = nullptr;
    if (hi - lo > 1) bar = xcd_barrier_post(ctl + CW_BAR, MISC + 8);
#define IN(k) (lo <= (k) && (k) < hi)
#define SEAM(k) do { if (IN(k) && (k) + 1 < hi) xcd_barrier(bar); } while (0)
    PG8_LAS unsigned char* ring = (PG8_LAS unsigned char*)(C.lds + RING_OFF);
    const float* MOD = (const float*)(a.ws + WS_MOD);

    if (IN(0)) { FRESH(Cp) phase_prologue(a, Cp); } SEAM(0);
    if (IN(1)) { FRESH(Cp) phase_norm0(a, Cp); } SEAM(1);
    if (IN(2)) {
        pg8::Gemm g{(const bf16*)(a.ws + WS_A), (const bf16*)(a.ws + WS_WIN0), RT, NZ, D}; pg8::StaticOrder S; S.init(RT, NZ, C.G, C.bid);
        pg8::EpiBf16N E{(bf16*)(a.ws + WS_Z), NZ, 0xffff};
        pg8::gemm_phase<pg8::EpiBf16N, pg8::StaticOrder, PG8_ALIGN, PG8_SP2>(ring, g, S, E);
    } SEAM(2);
    if (IN(3)) { FRESH(Cp) phase_conv(a, Cp); } SEAM(3);
    if (IN(4)) { FRESH(Cp) phase_dn_intra(a, Cp); } SEAM(4);
    if (IN(5)) { FRESH(Cp) phase_dn_scan(a, Cp); } SEAM(5);
    if (IN(6)) { FRESH(Cp) phase_dn_combine(a, Cp); } SEAM(6);
    if (IN(7)) {
        pg8::Gemm g{(const bf16*)(a.ws + WS_MIX), (const bf16*)(a.ws + WS_WOUT0), RT, D, D}; pg8::StaticOrder S; S.init(RT, D, C.G, C.bid);
        pg8::EpiBf16N E{(bf16*)(a.ws + WS_Y), D, 0xffff};
        pg8::gemm_phase<pg8::EpiBf16N, pg8::StaticOrder, PG8_ALIGN, PG8_SP2>(ring, g, S, E);
        { FRESH(Cp) moe_convert(a, Cp, 0, C.G == 256 ? 64 : 0); }
    } SEAM(7);
    if (IN(8)) { FRESH(Cp) phase_ffn_norm_route(a, Cp, 0); } SEAM(8);
    if (IN(10)) {
        int nT; { FRESH(Cp) nT = moe_tables(a, Cp, 0, MOE_TAB_OFF); }
        pg8::Gemm g{(const bf16*)(a.ws + WS_A), (const bf16*)(a.ws + WS_WUP), 0, 0, D}; pg8::MoeOrder S{(const PG8_LAS int*)(C.lds + MOE_TAB_OFF), nT, C.G, C.vcu, (const int*)(a.ws + WS_ROWSE), RT};
        pg8::EpiSwiGLU E{(bf16*)(a.ws + WS_HG)};
        pg8::gemm_phase<pg8::EpiSwiGLU, pg8::MoeOrder, PG8_ALIGN, PG8_SP2, true>(ring, g, S, E);
    } SEAM(10);
    if (IN(11)) {
        int nT; { FRESH(Cp) nT = moe_tables(a, Cp, 0, MOE_TAB_OFF); }
        pg8::Gemm g{(const bf16*)(a.ws + WS_HG), (const bf16*)(a.ws + WS_WDN), 0, 0, 512}; pg8::MoeOrder S{(const PG8_LAS int*)(C.lds + MOE_TAB_OFF), nT, C.G, C.vcu, nullptr, RT};
        pg8::EpiBf16N E{(bf16*)(a.ws + WS_YG), D, 3};
        pg8::gemm_phase<pg8::EpiBf16N, pg8::MoeOrder, PG8_ALIGN, PG8_SP2>(ring, g, S, E);
    } SEAM(11);
    if (IN(12)) { FRESH(Cp) phase_moe_combine(a, Cp, 0); } SEAM(12);
    if (IN(13)) {
        pg8::Gemm g{(const bf16*)(a.ws + WS_A), (const bf16*)(a.ws + WS_WIN1), RT, 1536, D}; pg8::QkvOrder S{C.G, C.vcu};
        pg8::EpiRope E{(bf16*)(a.ws + WS_Q1), (bf16*)(a.ws + WS_K1), (bf16*)(a.ws + WS_V1), (const float*)(a.ws + WS_COS), (const float*)(a.ws + WS_SIN)};
        pg8::gemm_phase<pg8::EpiRope, pg8::QkvOrder, PG8_ALIGN, PG8_SP2>(ring, g, S, E);
        { FRESH(Cp) Cp.bid = C.vcu; moe_convert(a, Cp, 1, C.G == 256 ? 32 : 0); }
    } SEAM(13);
    if (IN(14)) { FRESH(Cp) phase_attn(a, Cp); } SEAM(14);
    if (IN(15)) {
        pg8::Gemm g{(const bf16*)(a.ws + WS_O1), (const bf16*)(a.ws + WS_WOUT1), RL, D, D}; pg8::StaticOrder S; S.init(RL, D, C.G, C.bid);
        pg8::EpiBf16N E{(bf16*)(a.ws + WS_Y), D, 0xffff};
        pg8::gemm_phase<pg8::EpiBf16N, pg8::StaticOrder, PG8_ALIGN, PG8_SP2>(ring, g, S, E);
    } SEAM(15);
    if (IN(16)) { FRESH(Cp) phase_ffn_norm_route(a, Cp, 1); } SEAM(16);
    if (IN(18)) {
        int nT; { FRESH(Cp) nT = moe_tables(a, Cp, 1, MOE_TAB_OFF); }
        pg8::Gemm g{(const bf16*)(a.ws + WS_A), (const bf16*)(a.ws + WS_WUP), 0, 0, D}; pg8::MoeOrder S{(const PG8_LAS int*)(C.lds + MOE_TAB_OFF), nT, C.G, C.vcu, (const int*)(a.ws + WS_ROWSE), RT};
        pg8::EpiSwiGLU E{(bf16*)(a.ws + WS_HG)};
        pg8::gemm_phase<pg8::EpiSwiGLU, pg8::MoeOrder, PG8_ALIGN, PG8_SP2, true>(ring, g, S, E);
    } SEAM(18);
    if (IN(19)) {
        int nT; { FRESH(Cp) nT = moe_tables(a, Cp, 1, MOE_TAB_OFF); }
        pg8::Gemm g{(const bf16*)(a.ws + WS_HG), (const bf16*)(a.ws + WS_WDN), 0, 0, 512}; pg8::MoeOrder S{(const PG8_LAS int*)(C.lds + MOE_TAB_OFF), nT, C.G, C.vcu, nullptr, RT};
        pg8::EpiBf16N E{(bf16*)(a.ws + WS_YG), D, 3};
        pg8::gemm_phase<pg8::EpiBf16N, pg8::MoeOrder, PG8_ALIGN, PG8_SP2>(ring, g, S, E);
    } SEAM(19);
    if (IN(20)) { FRESH(Cp) phase_moe_combine(a, Cp, 1); }
#undef IN
#undef SEAM
}

extern "C" void kernel_launch(void* const* d_in, const int* in_sizes, int n_in, void* d_out, int out_size, void* d_ws, size_t ws_size, hipStream_t stream) {
    static int grid = 0;
    if (grid == 0) {
        if (n_in != 24 || in_sizes[0] != RL * D || out_size != RL * D || ws_size < WS_END) { fprintf(stderr, "kernel_launch: unexpected shapes: n_in %d in0 %d out %d ws %zu (need %zu)\n", n_in, n_in > 0 ? in_sizes[0] : -1, out_size, ws_size, (size_t)WS_END); grid = -1; return; }
        int dev = 0, cus = 0;
        if (hipGetDevice(&dev) != hipSuccess || hipDeviceGetAttribute(&cus, hipDeviceAttributeMultiprocessorCount, dev) != hipSuccess) { grid = -1; return; }
        if (hipFuncSetAttribute((const void*)fwd, hipFuncAttributeMaxDynamicSharedMemorySize, LDS_BYTES) != hipSuccess) { fprintf(stderr, "kernel_launch: hipFuncSetAttribute failed\n"); grid = -1; return; }
        int per_cu = 0;
        if (hipOccupancyMaxActiveBlocksPerMultiprocessor(&per_cu, (const void*)fwd, NTHR, LDS_BYTES) != hipSuccess || per_cu < 1) fprintf(stderr, "kernel_launch: occupancy query reports %d\n", per_cu);
        (void)hipGetLastError();
        grid = cus;
    }
    if (grid < 0) return;
    if (hipMemsetAsync((char*)d_ws + WS_CTL, 0, CTL_ZERO_BYTES, stream) != hipSuccess) return;
    Args a{};
    const float** f = (const float**)&a;
    for (int i = 0; i < 24; ++i) f[i] = (const float*)d_in[i];
    a.out = (float*)d_out; a.ws = (unsigned char*)d_ws;
    for (int li = 0; li < MK_N_LAUNCHES; ++li) {
        a.ph_lo = (MK_N_LAUNCHES == 1) ? 0 : li; a.ph_hi = (MK_N_LAUNCHES == 1) ? NPH : li + 1;
        hipLaunchKernelGGL(fwd, dim3(grid), dim3(NTHR), LDS_BYTES, stream, a);
    }
}
```
